# Optimizing an MI355X kernel written in HIP

```python
import math
import functools
import jax
import jax.numpy as jnp
from jax import lax
import numpy as np

D_MODEL = 2048
BATCH = 16
SEQ = 256
DEPTH = 4
DEC_BATCH = 4
DEC_SEQ = 1024
PAST_LEN = 256

GRID_W = 64
BRANCH_WIDTH = 512
N_BRANCH = 3
NA_HEADS = 4
NA_HEAD_DIM = 128
NA_WIDTH = NA_HEADS * NA_HEAD_DIM
NA_WIN_ROWS = 8
NA_WIN_COLS = 16
NA_QCOL_BLOCK = 16
NA_KCOL_BLOCK = NA_QCOL_BLOCK + NA_WIN_COLS
NA_REL_ROWS = 2 * NA_WIN_ROWS - 1
NA_REL_COLS = 2 * NA_WIN_COLS - 1
DIFF_HEADS = 4
DIFF_QK_DIM = 64
DIFF_V_DIM = 128
DIFF_QK_WIDTH = DIFF_HEADS * 2 * DIFF_QK_DIM
DIFF_V_WIDTH = DIFF_HEADS * DIFF_V_DIM
RWKV_HEADS = 8
RWKV_HEAD_DIM = 64
RWKV_WIDTH = RWKV_HEADS * RWKV_HEAD_DIM
RWKV_DECAY_RANK = 64
RWKV_ICL_RANK = 64
RWKV_GATE_RANK = 128
RWKV_SIZES = (RWKV_WIDTH, RWKV_WIDTH, RWKV_WIDTH, RWKV_DECAY_RANK, RWKV_DECAY_RANK, RWKV_ICL_RANK, RWKV_ICL_RANK, RWKV_GATE_RANK)
RWKV_FEAT = 3 * RWKV_WIDTH + 2 * RWKV_DECAY_RANK + 2 * RWKV_ICL_RANK + RWKV_GATE_RANK
RWKV_GN_EPS = 64e-5
IN_SIZES = (NA_WIDTH, NA_WIDTH, NA_WIDTH, DIFF_QK_WIDTH, DIFF_QK_WIDTH, DIFF_V_WIDTH, RWKV_FEAT, N_BRANCH * D_MODEL)
N_IN = 3 * NA_WIDTH + 2 * DIFF_QK_WIDTH + DIFF_V_WIDTH + RWKV_FEAT + N_BRANCH * D_MODEL
FFN_HIDDEN = -(-8 * D_MODEL // (3 * 256)) * 256
ROPE_THETA = 10000.0
Q_BLOCK = 128
LN_EPS = 1e-5

kernel_name = 'hybrid_diffusion_na_diff_rwkv7_step'


def _split(x, sizes):
    return jnp.split(x, np.cumsum(sizes)[:-1].tolist(), axis=-1)


def _normalize(x):
    xf = x.astype(jnp.float32)
    mu = jnp.mean(xf, axis=-1, keepdims=True)
    var = jnp.mean(jnp.square(xf - mu), axis=-1, keepdims=True)
    return (xf - mu) * lax.rsqrt(var + LN_EPS)


def _layer_norm(x, g, b):
    return (_normalize(x) * g + b).astype(x.dtype)


def _modulate(x, shift, scale):
    return (_normalize(x) * (1.0 + scale) + shift).astype(x.dtype)


def _adaln(cond, w_ada_l, b_ada_l):
    m = jax.nn.silu(cond) @ w_ada_l + b_ada_l
    m = m.reshape(m.shape[0], 1, 6, D_MODEL)
    return tuple(m[:, :, i] for i in range(6))


def _swiglu(h, w_in, w_out):
    gate, up = jnp.split(h @ w_in, 2, axis=-1)
    return (jax.nn.silu(gate) * up) @ w_out


def _dense_attend(q, k, v):
    b, t, h, d = q.shape
    qb = q.reshape(b, t // Q_BLOCK, Q_BLOCK, h, d).swapaxes(0, 1)
    def block(qi):
        s = jnp.einsum('bqhd,bkhd->bhqk', qi, k, preferred_element_type=jnp.float32) * (d ** -0.5)
        p = jax.nn.softmax(s, axis=-1).astype(v.dtype)
        return jnp.einsum('bhqk,bkhe->bqhe', p, v)
    o = lax.map(block, qb)
    return o.swapaxes(0, 1).reshape(b, t, h, v.shape[-1])


def _diff_attend(q, k, v, lam):
    b, t, h, _, d = q.shape
    qb = q.reshape(b, t // Q_BLOCK, Q_BLOCK, h, 2, d).swapaxes(0, 1)
    def block(qi):
        s = jnp.einsum('bqhcd,bkhcd->bhcqk', qi, k, preferred_element_type=jnp.float32) * (d ** -0.5)
        p = jax.nn.softmax(s, axis=-1)
        w = (p[:, :, 0] - lam * p[:, :, 1]).astype(v.dtype)
        return jnp.einsum('bhqk,bkhe->bqhe', w, v)
    o = lax.map(block, qb)
    return o.swapaxes(0, 1).reshape(b, t, h, v.shape[-1])


def _diff_lambda(lam_p, lam_init):
    lp = lam_p.astype(jnp.float32)
    return jnp.exp(jnp.sum(lp[0] * lp[1])) - jnp.exp(jnp.sum(lp[2] * lp[3])) + lam_init


def _diff_post(o, g, lam_init):
    b, t, h, e = o.shape
    of = o.astype(jnp.float32)
    of = of * lax.rsqrt(jnp.mean(jnp.square(of), axis=-1, keepdims=True) + LN_EPS)
    return (of.reshape(b, t, h * e) * g * (1.0 - lam_init)).astype(o.dtype)


def _axial_rope_tables(n_tokens):
    t = jnp.arange(n_tokens)
    rows = (t // GRID_W).astype(jnp.float32)
    cols = (t % GRID_W).astype(jnp.float32)
    half = DIFF_QK_DIM // 2
    inv = ROPE_THETA ** (-jnp.arange(0, half, 2, dtype=jnp.float32) / half)
    ang_r = rows[:, None] * inv
    ang_c = cols[:, None] * inv
    ang = jnp.concatenate([ang_r, ang_r, ang_c, ang_c], axis=-1)
    return jnp.cos(ang), jnp.sin(ang)


def _rotate_half(x):
    x1, x2 = jnp.split(x, 2, axis=-1)
    return jnp.concatenate([-x2, x1], axis=-1)


def _apply_axial_rope(x, cos, sin):
    half = x.shape[-1] // 2
    xf = x.astype(jnp.float32)
    rot = jnp.concatenate([_rotate_half(xf[..., :half]), _rotate_half(xf[..., half:])], axis=-1)
    return (xf * cos[:, None, None, :] + rot * sin[:, None, None, :]).astype(x.dtype)


def _na_static_indices(rows):
    win_r = min(NA_WIN_ROWS, rows)
    r = np.arange(rows)
    row_start = np.clip(r - win_r // 2, 0, rows - win_r)
    row_idx = row_start[:, None] + np.arange(win_r)[None, :]
    rel_r = row_idx - r[:, None]
    n_cb = GRID_W // NA_QCOL_BLOCK
    j = np.arange(n_cb)
    kcol_start = np.clip(j * NA_QCOL_BLOCK - NA_WIN_COLS // 2, 0, GRID_W - NA_KCOL_BLOCK)
    col_idx = kcol_start[:, None] + np.arange(NA_KCOL_BLOCK)[None, :]
    qcol = j[:, None] * NA_QCOL_BLOCK + np.arange(NA_QCOL_BLOCK)[None, :]
    win_c0 = np.clip(qcol - NA_WIN_COLS // 2, 0, GRID_W - NA_WIN_COLS)
    kc = col_idx[:, None, :]
    in_win = (kc >= win_c0[:, :, None]) & (kc < win_c0[:, :, None] + NA_WIN_COLS)
    rel_c = np.clip(kc - qcol[:, :, None], -(NA_WIN_COLS - 1), NA_WIN_COLS - 1)
    return row_idx, rel_r, col_idx, rel_c, in_win


def _na_latent(q, k, v, k_ctx, v_ctx, rpb):
    b, s, h, d = q.shape
    rows = s // GRID_W
    row_idx, rel_r, col_idx, rel_c, in_win = _na_static_indices(rows)
    wr = row_idx.shape[1]
    n_cb = GRID_W // NA_QCOL_BLOCK
    ri = row_idx[:, None, :, None]
    ci = col_idx[None, :, None, :]
    kb = k.reshape(b, rows, GRID_W, h, d)[:, ri, ci]
    vb = v.reshape(b, rows, GRID_W, h, d)[:, ri, ci]
    qb = q.reshape(b, rows, n_cb, NA_QCOL_BLOCK, h, d)
    scale = d ** -0.5
    bias = rpb.astype(jnp.float32)[:, (rel_r + NA_WIN_ROWS - 1)[:, None, None, :, None], (rel_c + NA_WIN_COLS - 1)[None, :, :, None, :]]
    s_loc = jnp.einsum('brjqhd,brjikhd->bhrjqik', qb, kb, preferred_element_type=jnp.float32) * scale + bias[None]
    s_loc = jnp.where(in_win[None, None, None, :, :, None, :], s_loc, -jnp.inf)
    n_loc = wr * NA_KCOL_BLOCK
    s_loc = s_loc.reshape(b, h, rows, n_cb, NA_QCOL_BLOCK, n_loc)
    s_ctx = jnp.einsum('brjqhd,blhd->bhrjql', qb, k_ctx, preferred_element_type=jnp.float32) * scale
    p = jax.nn.softmax(jnp.concatenate([s_loc, s_ctx], axis=-1), axis=-1).astype(v.dtype)
    p_loc = p[..., :n_loc].reshape(b, h, rows, n_cb, NA_QCOL_BLOCK, wr, NA_KCOL_BLOCK)
    p_ctx = p[..., n_loc:]
    o = jnp.einsum('bhrjqik,brjikhe->brjqhe', p_loc, vb) + jnp.einsum('bhrjql,blhe->brjqhe', p_ctx, v_ctx)
    return o.reshape(b, s, h, d)


def _token_shift(f, mix):
    prev = jnp.pad(f[:, :-1], ((0, 0), (1, 0), (0, 0)))
    nxt = jnp.pad(f[:, 1:], ((0, 0), (0, 1), (0, 0)))
    return f + mix[0] * (prev - f) + mix[1] * (nxt - f)


def _wkv_scan(s0, r, w, k, v, a, b, reverse):
    def step(state, xs):
        r_t, w_t, k_t, v_t, a_t, b_t = xs
        sa = jnp.einsum('bhvk,bhk->bhv', state, a_t)
        state = state * w_t[:, :, None, :] + sa[..., None] * b_t[:, :, None, :] + v_t[..., None] * k_t[:, :, None, :]
        return state, jnp.einsum('bhvk,bhk->bhv', state, r_t)
    xs = tuple(jnp.moveaxis(z, 1, 0) for z in (r, w, k, v, a, b))
    s_fin, y = lax.scan(step, s0, xs, reverse=reverse)
    return s_fin, jnp.moveaxis(y, 0, 1)


def _rwkv_mixer(f, s_f0, s_b0, lp):
    bsz, t, _ = f.shape
    f = _token_shift(f, lp['rwkv_mix'])
    r, k, v, wd_f, wd_b, ad_f, ad_b, gd = _split(f, RWKV_SIZES)
    def hd(z):
        return z.astype(jnp.float32).reshape(bsz, t, RWKV_HEADS, RWKV_HEAD_DIM)
    rh, kh, vh = hd(r), hd(k), hd(v)
    kk = kh * lp['rwkv_kk'].astype(jnp.float32).reshape(RWKV_HEADS, RWKV_HEAD_DIM)
    kk = kk / jnp.maximum(jnp.linalg.norm(kk, axis=-1, keepdims=True), 1e-12)
    ka = lp['rwkv_ka'].astype(jnp.float32).reshape(RWKV_HEADS, RWKV_HEAD_DIM)
    rk = lp['rwkv_rk'].astype(jnp.float32)
    ys, bonus, finals = [], [], []
    for d, (wd, ad, s0) in enumerate(((wd_f, ad_f, s_f0), (wd_b, ad_b, s_b0))):
        w_log = -jax.nn.softplus(-(lp['rwkv_w0'][d] + jnp.tanh(wd) @ lp['rwkv_w2'][d])) - 0.5
        decay = hd(jnp.exp(-jnp.exp(w_log.astype(jnp.float32))))
        a = hd(jax.nn.sigmoid(lp['rwkv_a0'][d] + ad @ lp['rwkv_a2'][d]))
        k_d = kh * (1.0 + (a - 1.0) * ka)
        s_fin, y_d = _wkv_scan(s0.astype(jnp.float32), rh, decay, k_d, vh, -kk, kk * a, reverse=(d == 1))
        ys.append(y_d)
        bonus.append(jnp.sum(rh * k_d * rk, axis=-1, keepdims=True) * vh)
        finals.append(s_fin.astype(f.dtype))
    y = ys[0] + ys[1]
    mu = jnp.mean(y, axis=-1, keepdims=True)
    var = jnp.mean(jnp.square(y - mu), axis=-1, keepdims=True)
    y = ((y - mu) * lax.rsqrt(var + RWKV_GN_EPS)).reshape(bsz, t, RWKV_WIDTH) * lp['rwkv_lnx_g'] + lp['rwkv_lnx_b']
    y = y + (bonus[0] + bonus[1]).reshape(bsz, t, RWKV_WIDTH)
    g = jax.nn.sigmoid(gd) @ lp['rwkv_g2']
    return (y * g).astype(f.dtype), finals[0], finals[1]


def _merge(gate_pre, oa, ob, oc, lp):
    o = jnp.stack([oa, ob, oc], axis=2)
    branches = jnp.einsum('btie,ied->btid', o, lp['w_branch'])
    g = jax.nn.sigmoid(gate_pre.reshape(gate_pre.shape[0], gate_pre.shape[1], N_BRANCH, D_MODEL))
    return jnp.sum(g * branches, axis=2) @ lp['w_out']


def _mixer_context(h, lp, lam_init):
    b, t, _ = h.shape
    na_q, na_k, na_v, df_q, df_k, df_v, rw, gate_pre = _split(h @ lp['w_in'], IN_SIZES)
    qa = na_q.reshape(b, t, NA_HEADS, NA_HEAD_DIM)
    ka = na_k.reshape(b, t, NA_HEADS, NA_HEAD_DIM)
    va = na_v.reshape(b, t, NA_HEADS, NA_HEAD_DIM)
    oa = _dense_attend(qa, ka, va).reshape(b, t, NA_WIDTH)
    qd = df_q.reshape(b, t, DIFF_HEADS, 2, DIFF_QK_DIM)
    kd = df_k.reshape(b, t, DIFF_HEADS, 2, DIFF_QK_DIM)
    vd = df_v.reshape(b, t, DIFF_HEADS, DIFF_V_DIM)
    lam = _diff_lambda(lp['diff_lambda'], lam_init)
    ob = _diff_post(_diff_attend(qd, kd, vd, lam), lp['diff_subln'], lam_init)
    zeros = jnp.zeros((b, RWKV_HEADS, RWKV_HEAD_DIM, RWKV_HEAD_DIM), jnp.float32)
    oc, s_f, s_b = _rwkv_mixer(rw, zeros, zeros, lp)
    return _merge(gate_pre, oa, ob, oc, lp), (ka, va, kd, vd, s_f, s_b)


def _mixer_latent(h, cache_l, lp, lam_init):
    k_na_ctx, v_na_ctx, k_df_ctx, v_df_ctx, s_f0, s_b0 = cache_l
    b, t, _ = h.shape
    na_q, na_k, na_v, df_q, df_k, df_v, rw, gate_pre = _split(h @ lp['w_in'], IN_SIZES)
    qa = na_q.reshape(b, t, NA_HEADS, NA_HEAD_DIM)
    ka = na_k.reshape(b, t, NA_HEADS, NA_HEAD_DIM)
    va = na_v.reshape(b, t, NA_HEADS, NA_HEAD_DIM)
    oa = _na_latent(qa, ka, va, k_na_ctx, v_na_ctx, lp['na_rpb']).reshape(b, t, NA_WIDTH)
    cos, sin = _axial_rope_tables(t)
    qd = _apply_axial_rope(df_q.reshape(b, t, DIFF_HEADS, 2, DIFF_QK_DIM), cos, sin)
    kd = _apply_axial_rope(df_k.reshape(b, t, DIFF_HEADS, 2, DIFF_QK_DIM), cos, sin)
    vd = df_v.reshape(b, t, DIFF_HEADS, DIFF_V_DIM)
    k_all = jnp.concatenate([kd, k_df_ctx.astype(kd.dtype)], axis=1)
    v_all = jnp.concatenate([vd, v_df_ctx.astype(vd.dtype)], axis=1)
    lam = _diff_lambda(lp['diff_lambda'], lam_init)
    ob = _diff_post(_diff_attend(qd, k_all, v_all, lam), lp['diff_subln'], lam_init)
    oc, _, _ = _rwkv_mixer(rw, s_f0, s_b0, lp)
    return _merge(gate_pre, oa, ob, oc, lp), None


def _block(x, cond, mixer, lp):
    alpha = (2.0 * DEPTH) ** 0.25
    sh1, sc1, g1, sh2, sc2, g2 = _adaln(cond, lp['w_ada'], lp['b_ada'])
    mixed, ctx_tensors = mixer(_modulate(x, sh1, sc1))
    x = _layer_norm(alpha * x + g1 * mixed, lp['ln1_g'], lp['ln1_b'])
    ff = _swiglu(_modulate(x, sh2, sc2), lp['w_ffn_in'], lp['w_ffn_out'])
    x = _layer_norm(alpha * x + g2 * ff, lp['ln2_g'], lp['ln2_b'])
    return x, ctx_tensors


def setup_inputs(seed: int = 0) -> dict:
    key = jax.random.key(seed)
    ks = iter(jax.random.split(key, 40))
    def nrm(shape, scale):
        return scale * jax.random.normal(next(ks), shape, jnp.float32)
    def uni(shape, lo, hi):
        return jax.random.uniform(next(ks), shape, jnp.float32, lo, hi)
    beta = (8.0 * DEPTH) ** -0.25
    L, D = DEPTH, D_MODEL
    return {
        'x_prompt': nrm((BATCH, SEQ, D), 1.0),
        'x_sample': nrm((DEC_BATCH, DEC_SEQ, D), 1.0),
        'cache_na_k': nrm((DEC_BATCH, L, PAST_LEN, NA_HEADS, NA_HEAD_DIM), 1.0),
        'cache_na_v': nrm((DEC_BATCH, L, PAST_LEN, NA_HEADS, NA_HEAD_DIM), 1.0),
        'cache_diff_k': nrm((DEC_BATCH, L, PAST_LEN, DIFF_HEADS, 2, DIFF_QK_DIM), 1.0),
        'cache_diff_v': nrm((DEC_BATCH, L, PAST_LEN, DIFF_HEADS, DIFF_V_DIM), 1.0),
        'state_rwkv_fwd': nrm((DEC_BATCH, L, RWKV_HEADS, RWKV_HEAD_DIM, RWKV_HEAD_DIM), 1.0),
        'state_rwkv_bwd': nrm((DEC_BATCH, L, RWKV_HEADS, RWKV_HEAD_DIM, RWKV_HEAD_DIM), 1.0),
        'c': nrm((DEC_BATCH, D), 1.0),
        'c_ctx': nrm((D,), 1.0),
        'w_ada': nrm((L, D, 6 * D), 0.5 * D ** -0.5),
        'b_ada': nrm((L, 6 * D), 0.01),
        'w_in': nrm((L, D, N_IN), D ** -0.5),
        'na_rpb': nrm((L, NA_HEADS, NA_REL_ROWS, NA_REL_COLS), 0.1),
        'diff_lambda': nrm((L, 4, DIFF_QK_DIM), 0.1),
        'diff_subln': 1.0 + nrm((L, DIFF_V_WIDTH), 0.02),
        'rwkv_mix': uni((L, 2, RWKV_FEAT), 0.0, 0.5),
        'rwkv_w0': uni((L, 2, RWKV_WIDTH), -5.5, -0.5),
        'rwkv_w2': nrm((L, 2, RWKV_DECAY_RANK, RWKV_WIDTH), 0.5 * RWKV_DECAY_RANK ** -0.5),
        'rwkv_a0': nrm((L, 2, RWKV_WIDTH), 0.1),
        'rwkv_a2': nrm((L, 2, RWKV_ICL_RANK, RWKV_WIDTH), 0.5 * RWKV_ICL_RANK ** -0.5),
        'rwkv_g2': nrm((L, RWKV_GATE_RANK, RWKV_WIDTH), RWKV_GATE_RANK ** -0.5),
        'rwkv_kk': 0.85 + nrm((L, RWKV_WIDTH), 0.05),
        'rwkv_ka': 1.0 + nrm((L, RWKV_WIDTH), 0.05),
        'rwkv_rk': nrm((L, RWKV_HEADS, RWKV_HEAD_DIM), 0.1),
        'rwkv_lnx_g': 1.0 + nrm((L, RWKV_WIDTH), 0.02),
        'rwkv_lnx_b': nrm((L, RWKV_WIDTH), 0.02),
        'w_branch': nrm((L, N_BRANCH, BRANCH_WIDTH, D), BRANCH_WIDTH ** -0.5),
        'w_out': nrm((L, D, D), beta * D ** -0.5),
        'ln1_g': 1.0 + nrm((L, D), 0.02),
        'ln1_b': nrm((L, D), 0.02),
        'w_ffn_in': nrm((L, D, 2 * FFN_HIDDEN), D ** -0.5),
        'w_ffn_out': nrm((L, FFN_HIDDEN, D), beta * FFN_HIDDEN ** -0.5),
        'ln2_g': 1.0 + nrm((L, D), 0.02),
        'ln2_b': nrm((L, D), 0.02),
    }


def reference(x_prompt, x_sample, cache_na_k, cache_na_v, cache_diff_k, cache_diff_v,
              state_rwkv_fwd, state_rwkv_bwd, c, c_ctx, w_ada, b_ada, w_in, na_rpb,
              diff_lambda, diff_subln, rwkv_mix, rwkv_w0, rwkv_w2, rwkv_a0, rwkv_a2,
              rwkv_g2, rwkv_kk, rwkv_ka, rwkv_rk, rwkv_lnx_g, rwkv_lnx_b, w_branch,
              w_out, ln1_g, ln1_b, w_ffn_in, w_ffn_out, ln2_g, ln2_b):
    x_ctx, x_lat = x_prompt, x_sample
    cond_ctx = c_ctx[None, :]
    new_t = ([], [], [], [], [], [])
    for l in range(DEPTH):
        lp = {
            'w_ada': w_ada[l], 'b_ada': b_ada[l], 'w_in': w_in[l], 'na_rpb': na_rpb[l],
            'diff_lambda': diff_lambda[l], 'diff_subln': diff_subln[l],
            'rwkv_mix': rwkv_mix[l], 'rwkv_w0': rwkv_w0[l], 'rwkv_w2': rwkv_w2[l],
            'rwkv_a0': rwkv_a0[l], 'rwkv_a2': rwkv_a2[l], 'rwkv_g2': rwkv_g2[l],
            'rwkv_kk': rwkv_kk[l], 'rwkv_ka': rwkv_ka[l], 'rwkv_rk': rwkv_rk[l],
            'rwkv_lnx_g': rwkv_lnx_g[l], 'rwkv_lnx_b': rwkv_lnx_b[l],
            'w_branch': w_branch[l], 'w_out': w_out[l],
            'ln1_g': ln1_g[l], 'ln1_b': ln1_b[l],
            'w_ffn_in': w_ffn_in[l], 'w_ffn_out': w_ffn_out[l],
            'ln2_g': ln2_g[l], 'ln2_b': ln2_b[l],
        }
        lam_init = 0.8 - 0.6 * math.exp(-0.3 * l)
        x_ctx, ctx_t = _block(x_ctx, cond_ctx, functools.partial(_mixer_context, lp=lp, lam_init=lam_init), lp)
        for store, tensor in zip(new_t, ctx_t):
            store.append(tensor)
        cache_l = (cache_na_k[:, l], cache_na_v[:, l], cache_diff_k[:, l], cache_diff_v[:, l],
                   state_rwkv_fwd[:, l], state_rwkv_bwd[:, l])
        x_lat, _ = _block(x_lat, c, functools.partial(_mixer_latent, cache_l=cache_l, lp=lp, lam_init=lam_init), lp)
    new_na_k = jnp.stack(new_t[0], axis=1)
    new_na_v = jnp.stack(new_t[1], axis=1)
    new_diff_k = jnp.stack(new_t[2], axis=1)
    new_diff_v = jnp.stack(new_t[3], axis=1)
    new_rwkv_fwd = jnp.stack(new_t[4], axis=1)
    new_rwkv_bwd = jnp.stack(new_t[5], axis=1)
    return (x_ctx, x_lat, new_na_k, new_na_v, new_diff_k, new_diff_v, new_rwkv_fwd, new_rwkv_bwd)
```

```cpp
#include <hip/hip_runtime.h>
#include <cstdio>
#include <cstdint>

#ifndef MK_SINGLE
#define MK_SINGLE 1
#endif

constexpr int D = 2048, MT = 8192, NCTX = 4096, NL = 4;
constexpr int NIN = 11136, NINP = 11264, FF = 5632, NFI = 11264;
constexpr int C_NAQ = 0, C_NAK = 512, C_NAV = 1024, C_DFQ = 1536, C_DFK = 2048, C_DFV = 2560, C_RW = 3072, C_GATE = 5120;
constexpr size_t OUT_YP = 0, OUT_NAK = 16777216, OUT_NAV = 25165824, OUT_DFK = 33554432, OUT_DFV = 41943040, OUT_RF = 50331648, OUT_RB = 52428800, OUT_TOTAL = 54525952;
constexpr float LN_EPS = 1e-5f;

namespace pg8 {
#define PG8_LAS __attribute__((address_space(3)))
typedef unsigned short bf16_t;
typedef short bf16x8 __attribute__((ext_vector_type(8)));
typedef float f32x4 __attribute__((ext_vector_type(4)));
typedef unsigned u32x4 __attribute__((ext_vector_type(4)));
constexpr int BM = 256, BK = 64, HALF = 128, HTB = HALF * BK * 2  , STAGE_BYTES = 8 * HTB, NXCD = 8, WGM = 8;

__host__ __device__ __forceinline__ int lds_byte(int r, int c) { const int st = (r >> 4) * 2 + (c >> 5), rr = r & 15, cc = c & 31, ob = rr * 64 + cc * 2; return st * 1024 + (ob ^ (((ob >> 9) & 1) << 5)); }
__host__ __device__ __forceinline__ void stage_rc(int b, int& R, int& C) { const int st = b / 1024, sb = b % 1024, swz = sb ^ (((sb >> 9) & 1) << 5); R = (st >> 1) * 16 + swz / 64; C = (st & 1) * 32 + (swz % 64) / 2; }
__host__ __device__ __forceinline__ int perm32(int rho) { const int n = rho >> 4, i = rho & 15; return 8 * (i >> 2) + 4 * n + (i & 3); }

struct Unit { int pm, pn; };
struct Gemm { const bf16_t* A; const bf16_t* Bt; int M, N, K; };

struct StaticOrder {
    int nM, nN, nwg, G, c;
    __host__ __device__ void init(int M, int N, int G_, int c_) { nM = M / BM; nN = N / BM; nwg = nM * nN; G = G_; c = c_; }
    __host__ __device__ bool next(int i, Unit& u) const {
        const long L = (long)i * G + c; if (L >= nwg) return false;
        int wgid = (int)L; { const int q = nwg / NXCD, r = nwg % NXCD, xcd = wgid % NXCD, off = wgid / NXCD; wgid = (xcd < r ? xcd * (q + 1) : r * (q + 1) + (xcd - r) * q) + off; }
        const int nig = WGM * nN, gid = wgid / nig, fm = gid * WGM, gsz = (nM - fm) < WGM ? (nM - fm) : WGM;
        u.pm = fm + ((wgid % nig) % gsz); u.pn = (wgid % nig) / gsz; return true;
    }
    __device__ __forceinline__ void a_ready(const Unit&) const {}
    __device__ __forceinline__ void done(const Unit&) const {}
};

__device__ __forceinline__ unsigned cvt_pk_bf16(float lo, float hi) { unsigned r; asm volatile("v_cvt_pk_f16_f32 %0, %1, %2" : "=v"(r) : "v"(lo), "v"(hi)); return r; }
typedef float f32x2 __attribute__((ext_vector_type(2)));
typedef unsigned u32x2 __attribute__((ext_vector_type(2)));
typedef _Float16 h16x2 __attribute__((ext_vector_type(2)));
typedef _Float16 h16x8 __attribute__((ext_vector_type(8)));
__device__ __forceinline__ float bf_lo(unsigned w) { return (float)__builtin_bit_cast(h16x2, w)[0]; }
__device__ __forceinline__ float bf_hi(unsigned w) { return (float)__builtin_bit_cast(h16x2, w)[1]; }
__device__ __forceinline__ float sigm(float x) { return 1.0f / (1.0f + __expf(-x)); }

struct EpiF {
    static constexpr bool PERM = true, AFTER_DRAIN = false;
    bf16_t* F; float* out; int layer;
    __device__ __forceinline__ void operator()(const f32x4 (&acc)[2][2][4][2], const Unit& u, int wr, int wc, int fr, int fq) const {
        const int row0 = u.pm * BM + wr * 64 + fr, col0 = u.pn * BM + wc * 32 + 8 * fq;
        float* ob = nullptr;
        if (u.pm < 16) { const int seg = u.pn >> 1;
            if (seg == 1) ob = out + OUT_NAK; else if (seg == 2) ob = out + OUT_NAV; else if (seg == 4) ob = out + OUT_DFK; else if (seg == 5) ob = out + OUT_DFV; }
        const int cseg = (u.pn & 1) * 256 + wc * 32 + 8 * fq;
#pragma unroll
        for (int ai = 0; ai < 2; ++ai)
#pragma unroll
            for (int m = 0; m < 4; ++m) { const int row = row0 + ai * HALF + m * 16; bf16_t* rowp = F + (size_t)row * NINP + col0;
#pragma unroll
                for (int bj = 0; bj < 2; ++bj) { const f32x4 v0 = acc[ai][bj][m][0], v1 = acc[ai][bj][m][1];
                    u32x4 w; w.x = cvt_pk_bf16(v0[0], v0[1]); w.y = cvt_pk_bf16(v0[2], v0[3]); w.z = cvt_pk_bf16(v1[0], v1[1]); w.w = cvt_pk_bf16(v1[2], v1[3]);
                    *(u32x4*)(rowp + bj * HALF) = w;
                    if (ob) { float* dst = ob + ((size_t)((row >> 8) * 4 + layer) * 256 + (row & 255)) * 512 + cseg + bj * HALF; *(f32x4*)dst = v0; *(f32x4*)(dst + 4) = v1; } } }
    }
};
struct EpiMerge {
    static constexpr bool PERM = true, AFTER_DRAIN = false;
    const bf16_t* F; float* Mbuf; bf16_t* merged;
    __device__ __forceinline__ void operator()(const f32x4 (&acc)[2][2][4][2], const Unit& u, int wr, int wc, int fr, int fq) const {
        const int i = u.pm >> 5, pm = u.pm & 31, pn = u.pn & 7;
        const int row0 = pm * BM + wr * 64 + fr, col0 = pn * BM + wc * 32 + 8 * fq;
#pragma unroll
        for (int ai = 0; ai < 2; ++ai)
#pragma unroll
            for (int m = 0; m < 4; ++m) { const int row = row0 + ai * HALF + m * 16;
#pragma unroll
                for (int bj = 0; bj < 2; ++bj) { const int col = col0 + bj * HALF;
                    const u32x4 gw = *(const u32x4*)(F + (size_t)row * NINP + C_GATE + i * D + col);
                    f32x4 g0, g1; g0[0] = sigm(bf_lo(gw.x)); g0[1] = sigm(bf_hi(gw.x)); g0[2] = sigm(bf_lo(gw.y)); g0[3] = sigm(bf_hi(gw.y));
                    g1[0] = sigm(bf_lo(gw.z)); g1[1] = sigm(bf_hi(gw.z)); g1[2] = sigm(bf_lo(gw.w)); g1[3] = sigm(bf_hi(gw.w));
                    f32x4 v0 = acc[ai][bj][m][0] * g0, v1 = acc[ai][bj][m][1] * g1;
                    float* mp = Mbuf + (size_t)row * D + col;
                    if (i == 0) { *(f32x4*)mp = v0; *(f32x4*)(mp + 4) = v1; }
                    else { v0 += *(const f32x4*)mp; v1 += *(const f32x4*)(mp + 4);
                        if (i == 1) { *(f32x4*)mp = v0; *(f32x4*)(mp + 4) = v1; }
                        else { u32x4 w; w.x = cvt_pk_bf16(v0[0], v0[1]); w.y = cvt_pk_bf16(v0[2], v0[3]); w.z = cvt_pk_bf16(v1[0], v1[1]); w.w = cvt_pk_bf16(v1[2], v1[3]);
                            *(u32x4*)(merged + (size_t)row * D + col) = w; } } } }
    }
};
struct MergeOrder {
    int G, c;
    __device__ __forceinline__ bool next(int i, Unit& u) const { const int j = i / 3, sub = i - 3 * j, t = c + G * j; if (t >= 256) return false;
        u.pm = sub * 32 + (t & 31); u.pn = sub * 8 + (t >> 5); return true; }
    __device__ __forceinline__ void a_ready(const Unit&) const {}
    __device__ __forceinline__ void done(const Unit&) const {}
};
struct EpiRes {
    static constexpr bool PERM = false, AFTER_DRAIN = false;
    const float* X; const float* gate; float* out; float alpha;
    __device__ __forceinline__ void operator()(const f32x4 (&acc)[2][2][4][2], const Unit& u, int wr, int wc, int fr, int fq) const {
        const int row0 = u.pm * BM + wr * 64 + fr, col0 = u.pn * BM + wc * 32 + 4 * fq;
        const int cidx = u.pm < 16 ? 0 : 1 + ((u.pm - 16) >> 2);
        const float* gp = gate + (size_t)cidx * 12288 + col0;
        f32x4 gv[2][2];
#pragma unroll
        for (int bj = 0; bj < 2; ++bj)
#pragma unroll
            for (int n = 0; n < 2; ++n) gv[bj][n] = *(const f32x4*)(gp + bj * HALF + n * 16);
#pragma unroll
        for (int ai = 0; ai < 2; ++ai)
#pragma unroll
            for (int m = 0; m < 4; ++m) { const size_t off = (size_t)(row0 + ai * HALF + m * 16) * D + col0;
#pragma unroll
                for (int bj = 0; bj < 2; ++bj)
#pragma unroll
                    for (int n = 0; n < 2; ++n) { const f32x4 x = *(const f32x4*)(X + off + bj * HALF + n * 16);
                        *(f32x4*)(out + off + bj * HALF + n * 16) = x * alpha + gv[bj][n] * acc[ai][bj][m][n]; } }
    }
};
struct EpiSwiglu {
    static constexpr bool PERM = true, AFTER_DRAIN = false;
    bf16_t* act;
    __device__ __forceinline__ void operator()(const f32x4 (&acc)[2][2][4][2], const Unit& u, int wr, int wc, int fr, int fq) const {
        const int row0 = u.pm * BM + wr * 64 + fr, col0 = u.pn * HALF + wc * 32 + 8 * fq;
#pragma unroll
        for (int ai = 0; ai < 2; ++ai)
#pragma unroll
            for (int m = 0; m < 4; ++m) { const int row = row0 + ai * HALF + m * 16;
                f32x4 r0, r1;
#pragma unroll
                for (int e = 0; e < 4; ++e) { const float g0 = acc[ai][0][m][0][e], g1 = acc[ai][0][m][1][e];
                    r0[e] = g0 * sigm(g0) * acc[ai][1][m][0][e]; r1[e] = g1 * sigm(g1) * acc[ai][1][m][1][e]; }
                u32x4 w; w.x = cvt_pk_bf16(r0[0], r0[1]); w.y = cvt_pk_bf16(r0[2], r0[3]); w.z = cvt_pk_bf16(r1[0], r1[1]); w.w = cvt_pk_bf16(r1[2], r1[3]);
                *(u32x4*)(act + (size_t)row * FF + col0) = w; }
    }
};

template <class Epi, class Sched, bool ALIGN_EPI = false, bool SP2 = false>
__device__ __forceinline__ void gemm_phase(PG8_LAS unsigned char* lds, const Gemm g, const Sched& S, const Epi& E, const int tid) {
    const int wid = __builtin_amdgcn_readfirstlane(tid >> 6), lane = tid & 63, wr = wid >> 2, wc = wid & 3, fr = lane & 15, fq = lane >> 4;
    const int K = g.K, nt = K / BK;
    unsigned voffA[2], voffB[2];
#pragma unroll
    for (int i = 0; i < 2; ++i) { int R, C; stage_rc(tid * 16 + i * 8192, R, C); const int Rb = Epi::PERM ? ((R & ~31) + perm32(R & 31)) : R;
        voffA[i] = (unsigned)(R * K + C) * 2u; voffB[i] = (unsigned)(Rb * K + C) * 2u; }
    const size_t kstep = (size_t)(BK * 2);
    const size_t hstep = (size_t)HALF * K * 2;
    const size_t tstep = 2 * hstep;
    const unsigned ldsw = (unsigned)wid * 1024u;
    const int aoff = lds_byte(wr * 64 + fr, fq * 8), boff = lds_byte(wc * 32 + fr, fq * 8);
#define PG8_SA(b, h) (((b) * 2 + (h)) * HTB)
#define PG8_SB(b, h) ((4 + (b) * 2 + (h)) * HTB)
#define PG8_STAGE(bufoff, gbase, voff) do { _Pragma("unroll") for (int _i = 0; _i < 2; ++_i) \
        __builtin_amdgcn_global_load_lds((const unsigned*)((const char*)(gbase) + (voff)[_i]), (PG8_LAS unsigned*)(lds + (bufoff) + ldsw + _i * 8192), 16, 0, 0); } while (0)
#define PG8_LDA(dst, b, h) do { _Pragma("unroll") for (int m = 0; m < 4; ++m) _Pragma("unroll") for (int k = 0; k < 2; ++k) dst[m][k] = *(const PG8_LAS bf16x8*)(lds + PG8_SA(b, h) + aoff + m * 2048 + k * 1024); } while (0)
#define PG8_LDB(dst, b, h) do { _Pragma("unroll") for (int n = 0; n < 2; ++n) _Pragma("unroll") for (int k = 0; k < 2; ++k) dst[n][k] = *(const PG8_LAS bf16x8*)(lds + PG8_SB(b, h) + boff + n * 2048 + k * 1024); } while (0)
#define PG8_MMA(ai, bj, At, Bt) do { __builtin_amdgcn_s_setprio(1); _Pragma("unroll") for (int m = 0; m < 4; ++m) _Pragma("unroll") for (int n = 0; n < 2; ++n) _Pragma("unroll") for (int k = 0; k < 2; ++k) \
        acc[ai][bj][m][n] = __builtin_amdgcn_mfma_f32_16x16x32_f16(__builtin_bit_cast(h16x8, Bt[n][k]), __builtin_bit_cast(h16x8, At[m][k]), acc[ai][bj][m][n], 0, 0, 0); __builtin_amdgcn_s_setprio(0); } while (0)
#define PG8_WAIT_V(n) asm volatile("s_waitcnt vmcnt(" #n ")" ::: "memory")
#define PG8_WAIT_L(n) asm volatile("s_waitcnt lgkmcnt(" #n ")" ::: "memory")
#define PG8_BAR __builtin_amdgcn_s_barrier()
#define PG8_SCHED __builtin_amdgcn_sched_barrier(0)
    Unit cur, nxt; int ui = 0;
    if (!S.next(0, cur)) return;
    f32x4 acc[2][2][4][2];
#pragma unroll
    for (int a = 0; a < 2; ++a)
#pragma unroll
        for (int b = 0; b < 2; ++b)
#pragma unroll
            for (int m = 0; m < 4; ++m)
#pragma unroll
                for (int n = 0; n < 2; ++n) acc[a][b][m][n] = (f32x4){0.f, 0.f, 0.f, 0.f};
    bf16x8 At[4][2], B0[2][2], B1[2][2];
    const char* cA = (const char*)g.A + (size_t)cur.pm * tstep; const char* cB = (const char*)g.Bt + (size_t)cur.pn * tstep;
    S.a_ready(cur);
    if constexpr (SP2) {
        PG8_STAGE(PG8_SB(0, 0), cB, voffB); PG8_STAGE(PG8_SB(0, 1), cB + hstep, voffB); PG8_STAGE(PG8_SA(0, 0), cA, voffA); PG8_STAGE(PG8_SA(0, 1), cA + hstep, voffA);
        if (wr == 1) PG8_BAR;
        PG8_WAIT_V(2); PG8_BAR;
        PG8_STAGE(PG8_SB(1, 0), cB + kstep, voffB); PG8_STAGE(PG8_SA(1, 0), cA + kstep, voffA); PG8_STAGE(PG8_SB(1, 1), cB + hstep + kstep, voffB);
        PG8_WAIT_V(6); PG8_BAR;
    } else {
        PG8_STAGE(PG8_SB(0, 0), cB, voffB); PG8_STAGE(PG8_SA(0, 0), cA, voffA); PG8_STAGE(PG8_SB(0, 1), cB + hstep, voffB); PG8_STAGE(PG8_SA(0, 1), cA + hstep, voffA);
        if (wr == 1) PG8_BAR;
        PG8_WAIT_V(4); PG8_BAR;
        PG8_STAGE(PG8_SB(1, 0), cB + kstep, voffB); PG8_STAGE(PG8_SA(1, 0), cA + kstep, voffA); PG8_STAGE(PG8_SB(1, 1), cB + hstep + kstep, voffB);
        PG8_WAIT_V(6); PG8_BAR;
    }
    for (;;) {
        const bool has_next = S.next(ui + 1, nxt);
        const char* nA = has_next ? (const char*)g.A + (size_t)nxt.pm * tstep : cA; const char* nB = has_next ? (const char*)g.Bt + (size_t)nxt.pn * tstep : cB;
        for (int t = 0; t < nt; t += 2) {
            const bool last = (t == nt - 2);
            const char* a1 = cA + (size_t)(t + 1) * kstep;
            const char* a2 = last ? nA : cA + (size_t)(t + 2) * kstep; const char* b2 = last ? nB : cB + (size_t)(t + 2) * kstep;
            const char* a3 = a2 + kstep; const char* b3 = b2 + kstep;
            if (last && has_next) S.a_ready(nxt);
            if constexpr (SP2) {
            PG8_LDB(B0, 0, 0); PG8_LDB(B1, 0, 1); PG8_SCHED; PG8_LDA(At, 0, 0); PG8_STAGE(PG8_SA(1, 1), a1 + hstep, voffA);
            PG8_WAIT_V(8); PG8_WAIT_L(0); PG8_BAR; PG8_MMA(0, 0, At, B0); PG8_MMA(0, 1, At, B1); PG8_BAR; PG8_SCHED;
            PG8_LDA(At, 0, 1); PG8_STAGE(PG8_SB(0, 0), b2, voffB); PG8_STAGE(PG8_SB(0, 1), b2 + hstep, voffB); PG8_STAGE(PG8_SA(0, 0), a2, voffA);
            PG8_WAIT_V(8); PG8_WAIT_L(0); PG8_BAR; PG8_MMA(1, 0, At, B0); PG8_MMA(1, 1, At, B1); PG8_BAR; PG8_SCHED;
            PG8_LDB(B0, 1, 0); PG8_LDB(B1, 1, 1); PG8_SCHED; PG8_LDA(At, 1, 0); PG8_STAGE(PG8_SA(0, 1), a2 + hstep, voffA);
            PG8_WAIT_V(8); PG8_WAIT_L(0); PG8_BAR; PG8_MMA(0, 0, At, B0); PG8_MMA(0, 1, At, B1); PG8_BAR; PG8_SCHED;
            PG8_LDA(At, 1, 1); PG8_STAGE(PG8_SB(1, 0), b3, voffB); PG8_STAGE(PG8_SB(1, 1), b3 + hstep, voffB); PG8_STAGE(PG8_SA(1, 0), a3, voffA);
            PG8_WAIT_V(8); PG8_WAIT_L(0); PG8_BAR; PG8_MMA(1, 0, At, B0); PG8_MMA(1, 1, At, B1); PG8_BAR; PG8_SCHED;
            } else {
            PG8_LDB(B0, 0, 0); PG8_SCHED; PG8_LDA(At, 0, 0); PG8_STAGE(PG8_SA(1, 1), a1 + hstep, voffA);
            PG8_WAIT_L(8); PG8_BAR; PG8_WAIT_L(0); PG8_MMA(0, 0, At, B0); PG8_BAR; PG8_SCHED;
            PG8_LDB(B1, 0, 1); PG8_STAGE(PG8_SB(0, 0), b2, voffB);
            PG8_BAR; PG8_WAIT_L(0); PG8_MMA(0, 1, At, B1); PG8_BAR;
            PG8_LDA(At, 0, 1); PG8_STAGE(PG8_SA(0, 0), a2, voffA);
            PG8_BAR; PG8_WAIT_L(0); PG8_MMA(1, 0, At, B0); PG8_BAR; PG8_SCHED;
            PG8_STAGE(PG8_SB(0, 1), b2 + hstep, voffB);
            PG8_WAIT_V(6); PG8_BAR; PG8_MMA(1, 1, At, B1); PG8_BAR;
            PG8_LDB(B0, 1, 0); PG8_SCHED; PG8_LDA(At, 1, 0); PG8_STAGE(PG8_SA(0, 1), a2 + hstep, voffA);
            PG8_WAIT_L(8); PG8_BAR; PG8_WAIT_L(0); PG8_MMA(0, 0, At, B0); PG8_BAR; PG8_SCHED;
            PG8_LDB(B1, 1, 1); PG8_STAGE(PG8_SB(1, 0), b3, voffB);
            PG8_BAR; PG8_WAIT_L(0); PG8_MMA(0, 1, At, B1); PG8_BAR;
            PG8_LDA(At, 1, 1); PG8_STAGE(PG8_SA(1, 0), a3, voffA);
            PG8_BAR; PG8_WAIT_L(0); PG8_MMA(1, 0, At, B0); PG8_BAR; PG8_SCHED;
            PG8_STAGE(PG8_SB(1, 1), b3 + hstep, voffB);
            PG8_WAIT_V(6); PG8_BAR; PG8_MMA(1, 1, At, B1); PG8_BAR;
            }
        }
        if constexpr (ALIGN_EPI) { if (wr == 0) PG8_BAR; }
        if constexpr (!Epi::AFTER_DRAIN) { E(acc, cur, wr, wc, fr, fq); S.done(cur); }
        if (!has_next) break;
#pragma unroll
        for (int a = 0; a < 2; ++a)
#pragma unroll
            for (int b = 0; b < 2; ++b)
#pragma unroll
                for (int m = 0; m < 4; ++m)
#pragma unroll
                    for (int n = 0; n < 2; ++n) acc[a][b][m][n] = (f32x4){0.f, 0.f, 0.f, 0.f};
        cur = nxt; cA = nA; cB = nB; ++ui;
        if constexpr (ALIGN_EPI) { if (wr == 1) PG8_BAR; }
    }
    PG8_WAIT_V(0);
    if constexpr (!ALIGN_EPI) { if (wr == 0) PG8_BAR; }
    PG8_BAR;
    if constexpr (Epi::AFTER_DRAIN) { E.fused(acc, cur, wr, wc, fr, fq, lds, wid, lane); S.done(cur); }
#undef PG8_SA
#undef PG8_SB
#undef PG8_STAGE
#undef PG8_LDA
#undef PG8_LDB
#undef PG8_MMA
#undef PG8_WAIT_V
#undef PG8_WAIT_L
#undef PG8_BAR
#undef PG8_SCHED
}
}

#define GAS __attribute__((address_space(1)))
#define LAS __attribute__((address_space(3)))
typedef unsigned short bf16;
typedef unsigned v4u __attribute__((ext_vector_type(4)));
typedef float f32x4 __attribute__((ext_vector_type(4)));
typedef short bf16x8 __attribute__((ext_vector_type(8)));
typedef GAS unsigned gu32;
typedef GAS unsigned long long gu64;
#define RLX_AGENT __ATOMIC_RELAXED, __HIP_MEMORY_SCOPE_AGENT
#define LDS_WAIT() asm volatile("s_waitcnt lgkmcnt(0)" ::: "memory")
#define VM_WAIT() asm volatile("s_waitcnt vmcnt(0)" ::: "memory")
__device__ __forceinline__ unsigned long long rt() { return __builtin_amdgcn_s_memrealtime(); }
__device__ __forceinline__ unsigned f2bf(float f) { unsigned u = __builtin_bit_cast(unsigned, f); return (u + 0x7fffu + ((u >> 16) & 1u)) >> 16; }
__device__ __forceinline__ unsigned pk2(float lo, float hi) { return f2bf(lo) | (f2bf(hi) << 16); }

#define XB_TMO      128
#define XB_XCNT(j)  (256  + 64 * (j))
#define XB_XSUB(j)  (1280 + 64 * (j))
#define XB_XGEN(j)  (2304 + 64 * (j))
#define XB_TOP      3328
#define XB_TOPGEN   3392
#define XCD_BAR_WORDS 3456
#define XB_SPIN_CAP (1u << 18)

__device__ __forceinline__ unsigned xb_ld(unsigned* p)              { return __hip_atomic_load(p, __ATOMIC_RELAXED, __HIP_MEMORY_SCOPE_AGENT); }
__device__ __forceinline__ unsigned xb_add(unsigned* p, unsigned v) { return __hip_atomic_fetch_add(p, v, __ATOMIC_RELAXED, __HIP_MEMORY_SCOPE_AGENT); }
__device__ __forceinline__ unsigned xb_xcc_id() { return (unsigned)__builtin_amdgcn_s_getreg((3 << 11) | 20) & 0xFu; }
#define XB_SPIN(cond, bar) do { unsigned _sp = 0; while (cond) { __builtin_amdgcn_s_sleep(1); \
    if ((++_sp & 255u) == 0u) { if (xb_ld(&(bar)[XB_TMO])) break; if (_sp > XB_SPIN_CAP) { atomicAdd(&(bar)[XB_TMO], 1u); break; } } } } while (0)

struct XcdBarrier {
    unsigned* bar; unsigned x;
    volatile LAS unsigned* st;
};

__device__ __forceinline__ XcdBarrier xcd_barrier_post(unsigned* bar, volatile LAS unsigned* st) {
    XcdBarrier b; b.bar = bar; b.x = xb_xcc_id(); b.st = st;
    if (threadIdx.x == 0) (void)xb_add(&bar[XB_XCNT(b.x)], 1u);
    return b;
}
__device__ __forceinline__ void xcd_barrier_complete(unsigned* bar, unsigned x, unsigned& nloc, unsigned& nx) {
    const unsigned G = gridDim.x * gridDim.y * gridDim.z;
    unsigned sum, cnt, mine, sp = 0u;
    for (;;) {
        sum = 0u; cnt = 0u; mine = 0u;
#pragma unroll
        for (unsigned j = 0; j < 16; ++j) { const unsigned c = xb_ld(&bar[XB_XCNT(j)]); sum += c; cnt += (c > 0u) ? 1u : 0u; mine = (j == x) ? c : mine; }
        if (sum == G) break;
        __builtin_amdgcn_s_sleep(1);
        if ((++sp & 255u) == 0u) { if (xb_ld(&bar[XB_TMO])) break; if (sp > XB_SPIN_CAP) { atomicAdd(&bar[XB_TMO], 1u); break; } }
    }
    nloc = mine > 0u ? mine : 1u; nx = cnt > 0u ? cnt : 1u;
}

__device__ __forceinline__ void xcd_barrier(const XcdBarrier& b) {
    asm volatile("s_waitcnt vmcnt(0)" ::: "memory");
    __syncthreads();
    if (threadIdx.x == 0) {
        unsigned* bar = b.bar;
        __builtin_amdgcn_s_waitcnt(0);
        unsigned nloc = b.st[0], nx = b.st[1];
        if (nloc == 0u) { xcd_barrier_complete(bar, b.x, nloc, nx); b.st[0] = nloc; b.st[1] = nx; }
        const unsigned old = xb_add(&bar[XB_XSUB(b.x)], 1u);
        const unsigned gen = old / nloc;
        if (old + 1u == (gen + 1u) * nloc) {
            __builtin_amdgcn_fence(__ATOMIC_RELEASE, "agent");
            asm volatile("s_waitcnt vmcnt(0)" ::: "memory");
            const unsigned og = xb_add(&bar[XB_TOP], 1u);
            const unsigned tg = og / nx;
            if (og + 1u == (tg + 1u) * nx) xb_add(&bar[XB_TOPGEN], 1u);
            else XB_SPIN(xb_ld(&bar[XB_TOPGEN]) == tg, bar);
            __builtin_amdgcn_fence(__ATOMIC_ACQUIRE, "agent");
            xb_add(&bar[XB_XGEN(b.x)], 1u);
            asm volatile("s_waitcnt vmcnt(0)" ::: "memory");
        } else {
            XB_SPIN(xb_ld(&bar[XB_XGEN(b.x)]) == gen, bar);
            __builtin_amdgcn_fence(__ATOMIC_ACQUIRE, "agent");
            asm volatile("s_waitcnt vmcnt(0)" ::: "memory");
        }
    }
    __syncthreads();
}

constexpr size_t MiB = 1u << 20;
constexpr size_t WS_CTL = 0, CTL_ZERO_BYTES = 1 * MiB;
constexpr size_t WS_MOD = 1 * MiB;
constexpr size_t WS_LAM = 2 * MiB, WS_ROPE = 2 * MiB + 4096, WS_W2T = 2 * MiB + 65536, WS_A2T = WS_W2T + 524288, WS_G2T = WS_A2T + 524288;
constexpr size_t WS_CKNA = 4 * MiB, WS_CVNA = 8 * MiB, WS_CKDF = 12 * MiB, WS_CVDF = 16 * MiB;
constexpr size_t WS_WIN = 20 * MiB, WS_WBR = 196 * MiB, WS_WO = 220 * MiB, WS_WFI = 252 * MiB, WS_WFO = 428 * MiB;
constexpr size_t WS_H = 516 * MiB;
constexpr size_t WS_F = 548 * MiB;
constexpr size_t WS_O3 = 724 * MiB;
constexpr size_t WS_MBUF = 748 * MiB;
constexpr size_t WS_MERGED = 812 * MiB;
constexpr size_t WS_X = 844 * MiB;
constexpr size_t WS_SI = 908 * MiB;
constexpr size_t WS_Y = 1100 * MiB;
constexpr size_t WS_G = 1132 * MiB;
constexpr size_t WS_BON = 1148 * MiB;
constexpr size_t WS_QR = 1149 * MiB, WS_KR = 1153 * MiB;
constexpr size_t WS_END = 1157 * MiB;
constexpr int CW_BAR = 4096, CW_MIXQ = 16384;

constexpr int RING_BYTES = 131072, MISC_OFF = RING_BYTES + 320, LDS_BYTES = 147456;
constexpr int NWAVES = 8;

struct Args { const float* in[35]; float* out; unsigned char* ws; int l_lo, l_hi, ph_lo, ph_hi; };
#define CAS __attribute__((address_space(4)))
typedef const CAS Args& ArgsRef;

typedef unsigned v2u __attribute__((ext_vector_type(2)));
typedef short s16x4 __attribute__((ext_vector_type(4)));
typedef short v4i16_t __attribute__((ext_vector_type(4)));
using pg8::cvt_pk_bf16; using pg8::bf_lo; using pg8::bf_hi; using pg8::sigm;

__device__ __forceinline__ bf16 f2h(float v) { return __builtin_bit_cast(unsigned short, (_Float16)v); }
template <int CTRL> __device__ __forceinline__ float dpp(float x) { return __builtin_bit_cast(float, __builtin_amdgcn_mov_dpp(__builtin_bit_cast(int, x), CTRL, 0xf, 0xf, true)); }
__device__ __forceinline__ float red8(float x) { x += dpp<0xB1>(x); x += dpp<0x4E>(x); x += dpp<0x141>(x); return x; }
__device__ __forceinline__ float xrow16_max(float x) {
    auto s = __builtin_amdgcn_permlane16_swap(__float_as_uint(x), __float_as_uint(x), false, false);
    x = fmaxf(__uint_as_float(s[0]), __uint_as_float(s[1]));
    auto t = __builtin_amdgcn_permlane32_swap(__float_as_uint(x), __float_as_uint(x), false, false);
    return fmaxf(__uint_as_float(t[0]), __uint_as_float(t[1]));
}
__device__ __forceinline__ float xrow16_sum(float x) {
    auto s = __builtin_amdgcn_permlane16_swap(__float_as_uint(x), __float_as_uint(x), false, false);
    x = __uint_as_float(s[0]) + __uint_as_float(s[1]);
    auto t = __builtin_amdgcn_permlane32_swap(__float_as_uint(x), __float_as_uint(x), false, false);
    return __uint_as_float(t[0]) + __uint_as_float(t[1]);
}
__device__ __forceinline__ float wave_sum(float v) {
#pragma unroll
    for (int o = 1; o < 64; o <<= 1) v += __shfl_xor(v, o);
    return v;
}
__device__ __forceinline__ s16x4 vtr(const LAS unsigned char* p) { return __builtin_bit_cast(s16x4, __builtin_amdgcn_ds_read_tr16_b64_v4i16((LAS v4i16_t*)p)); }
__device__ __forceinline__ f32x4 mfma16(bf16x8 a, bf16x8 b, f32x4 c) { return __builtin_amdgcn_mfma_f32_16x16x32_f16(__builtin_bit_cast(pg8::h16x8, a), __builtin_bit_cast(pg8::h16x8, b), c, 0, 0, 0); }

__device__ __forceinline__ void phase_ada(ArgsRef a, unsigned char* ws, LAS unsigned char* lds, int tid, int bid, int G) {
    LAS float* sc = (LAS float*)lds;
    LAS float* red = sc + 5 * 2048;
    const float* cvec = a.in[8]; const float* cctx = a.in[9];
    for (int i = tid; i < 5 * 2048; i += 512) { const int c = i >> 11, k = i & 2047; const float v = c == 0 ? cctx[k] : cvec[(c - 1) * 2048 + k]; sc[i] = v / (1.0f + expf(-v)); }
    __syncthreads();
    const int wave = tid >> 6, lane = tid & 63;
    float* MOD = (float*)(ws + WS_MOD);
    for (int unit = bid; unit < NL * 96; unit += G) {
        const int l = unit / 96, n0 = (unit % 96) * 128;
        const float* W = a.in[10] + (size_t)l * 2048 * 12288 + n0 + 2 * lane;
        float acc[5][2];
#pragma unroll
        for (int c = 0; c < 5; ++c) { acc[c][0] = 0.f; acc[c][1] = 0.f; }
        const int k0 = wave * 256;
        for (int kk = 0; kk < 256; kk += 8) {
            pg8::f32x2 w[8];
#pragma unroll
            for (int j = 0; j < 8; ++j) w[j] = *(const pg8::f32x2*)(W + (size_t)(k0 + kk + j) * 12288);
#pragma unroll
            for (int j = 0; j < 8; ++j)
#pragma unroll
                for (int c = 0; c < 5; ++c) { const float s = sc[c * 2048 + k0 + kk + j]; acc[c][0] += s * w[j].x; acc[c][1] += s * w[j].y; }
        }
#pragma unroll
        for (int c = 0; c < 5; ++c) { red[(wave * 5 + c) * 128 + 2 * lane] = acc[c][0]; red[(wave * 5 + c) * 128 + 2 * lane + 1] = acc[c][1]; }
        __syncthreads();
        for (int i = tid; i < 5 * 128; i += 512) { const int c = i >> 7, n = i & 127; float s = 0.f;
#pragma unroll
            for (int w = 0; w < 8; ++w) s += red[(w * 5 + c) * 128 + n];
            MOD[((size_t)l * 5 + c) * 12288 + n0 + n] = s + a.in[11][(size_t)l * 12288 + n0 + n]; }
        __syncthreads();
    }
}

__device__ __forceinline__ void transpose_item(const float* W, int K, int N, bf16* WT, int k0, int n0, int drow0, LAS float* scr, int lane) {
#pragma unroll 8
    for (int i = 0; i < 32; ++i) { const int kk = 2 * i + (lane >> 5); scr[kk * 33 + (lane & 31)] = W[(size_t)(k0 + kk) * N + n0 + (lane & 31)]; }
    LDS_WAIT(); asm volatile("" ::: "memory");
    const int c = lane & 7;
#pragma unroll
    for (int j = 0; j < 4; ++j) { const int n = (lane >> 3) + 8 * j; const LAS float* s = scr + (8 * c) * 33 + n;
        v4u o; o.x = cvt_pk_bf16(s[0 * 33], s[1 * 33]); o.y = cvt_pk_bf16(s[2 * 33], s[3 * 33]); o.z = cvt_pk_bf16(s[4 * 33], s[5 * 33]); o.w = cvt_pk_bf16(s[6 * 33], s[7 * 33]);
        *(v4u*)(WT + (size_t)(drow0 + n) * K + k0 + 8 * c) = o; }
    LDS_WAIT(); asm volatile("" ::: "memory");
}
constexpr int IT_WIN = 32 * 348, IT_WBR = 3 * 8 * 64, IT_WO = 32 * 64, IT_WFI = 32 * 352, IT_WFO = 88 * 64, IT_LAYER = IT_WIN + IT_WBR + IT_WO + IT_WFI + IT_WFO;
__device__ __forceinline__ void phase_cvt(ArgsRef a, unsigned char* ws, LAS unsigned char* lds, int tid, int bid, int G) {
    const int wave = tid >> 6, lane = tid & 63;
    LAS float* scr = (LAS float*)(lds + wave * 16384);
    const int gw = bid * NWAVES + wave, NGW = G * NWAVES;
    for (int it = gw; it < NL * IT_LAYER; it += NGW) {
        const int l = it / IT_LAYER; int r = it - l * IT_LAYER;
        if (r < IT_WIN) { const int kb = r / 348, nb = r - kb * 348, n0 = 32 * nb;
            transpose_item(a.in[12] + (size_t)l * D * NIN, D, NIN, (bf16*)(ws + WS_WIN) + (size_t)l * NINP * D, 64 * kb, n0, n0 + (n0 >= 4992 ? 128 : 0), scr, lane); continue; }
        r -= IT_WIN;
        if (r < IT_WBR) { const int i = r >> 9, rr = r & 511, kb = rr >> 6, nb = rr & 63;
            transpose_item(a.in[27] + (size_t)(l * 3 + i) * 512 * D, 512, D, (bf16*)(ws + WS_WBR) + (size_t)(l * 3 + i) * D * 512, 64 * kb, 32 * nb, 32 * nb, scr, lane); continue; }
        r -= IT_WBR;
        if (r < IT_WO) { const int kb = r >> 6, nb = r & 63;
            transpose_item(a.in[28] + (size_t)l * D * D, D, D, (bf16*)(ws + WS_WO) + (size_t)l * D * D, 64 * kb, 32 * nb, 32 * nb, scr, lane); continue; }
        r -= IT_WO;
        if (r < IT_WFI) { const int kb = r / 352, nb = r - kb * 352, n0 = 32 * nb;
            const int dr = n0 < FF ? (n0 >> 7) * 256 + (n0 & 127) : ((n0 - FF) >> 7) * 256 + 128 + ((n0 - FF) & 127);
            transpose_item(a.in[31] + (size_t)l * D * NFI, D, NFI, (bf16*)(ws + WS_WFI) + (size_t)l * NFI * D, 64 * kb, n0, dr, scr, lane); continue; }
        r -= IT_WFI;
        { const int kb = r >> 6, nb = r & 63;
            transpose_item(a.in[32] + (size_t)l * FF * D, FF, D, (bf16*)(ws + WS_WFO) + (size_t)l * D * FF, 64 * kb, 32 * nb, 32 * nb, scr, lane); }
    }
    const int gt = bid * 512 + tid, NGT = G * 512;
    for (int i = gt; i < 4 * 262144; i += NGT) { const int t = i >> 18, e = (i & 262143) * 8;
        const float* src = a.in[2 + t] + e; const f32x4 x0 = *(const f32x4*)src, x1 = *(const f32x4*)(src + 4);
        v4u o; o.x = cvt_pk_bf16(x0[0], x0[1]); o.y = cvt_pk_bf16(x0[2], x0[3]); o.z = cvt_pk_bf16(x1[0], x1[1]); o.w = cvt_pk_bf16(x1[2], x1[3]);
        *(v4u*)((bf16*)(ws + WS_CKNA + (size_t)t * 4 * MiB) + e) = o; }
    for (int i = gt; i < 3 * 262144; i += NGT) { const int t = i >> 18, e = i & 262143;
        if (t < 2) { const int j = e & 63, c = (e >> 6) & 511, ld = e >> 15;
            const float v = a.in[t == 0 ? 18 : 20][((size_t)ld * 64 + j) * 512 + c];
            ((bf16*)(ws + (t == 0 ? WS_W2T : WS_A2T)))[e] = f2h(v); }
        else { const int j = e & 127, c = (e >> 7) & 511, l = e >> 16;
            ((bf16*)(ws + WS_G2T))[e] = f2h(a.in[21][((size_t)l * 128 + j) * 512 + c]); } }
    for (int i = gt; i < 64 * 16; i += NGT) { const int pos = i >> 4, f = i & 15; const float inv = powf(10000.0f, -(float)f / 16.0f); const float ang = (float)pos * inv;
        float* rp = (float*)(ws + WS_ROPE) + 2 * i; rp[0] = cosf(ang); rp[1] = sinf(ang); }
    if (gw < NL) { const float* lp = a.in[14] + gw * 256; const float s1 = wave_sum(lp[lane] * lp[64 + lane]), s2 = wave_sum(lp[128 + lane] * lp[192 + lane]);
        const float li = gw == 0 ? 0.2f : gw == 1 ? 0.355509067590969f : gw == 2 ? 0.470713018343584f : 0.556058204155641f;
        if (lane == 0) ((float*)(ws + WS_LAM))[gw] = expf(s1) - expf(s2) + li; }
}
__device__ __forceinline__ float lam_init_of(int l) { return l == 0 ? 0.2f : l == 1 ? 0.355509067590969f : l == 2 ? 0.470713018343584f : 0.556058204155641f; }

template <int MODE> __device__ __forceinline__ void phase_ln(ArgsRef a, unsigned char* ws, int l, int gw, int NGW, int lane) {
    const float* MODp = (const float*)(ws + WS_MOD);
    float* X = (float*)(ws + WS_X); bf16* H = (bf16*)(ws + WS_H);
    const float* lg = MODE == 1 ? a.in[29] + l * D : a.in[33] + l * D; const float* lb = MODE == 1 ? a.in[30] + l * D : a.in[34] + l * D;
    const int ml = MODE == 2 ? l + 1 : l, mi = MODE == 1 ? 3 : 0;
    for (int row = gw; row < MT; row += NGW) {
        const float* src = MODE == 0 ? (row < NCTX ? a.in[0] + (size_t)row * D : a.in[1] + (size_t)(row - NCTX) * D) : (const float*)(ws + WS_MBUF) + (size_t)row * D;
        f32x4 v[8]; float s = 0.f;
#pragma unroll
        for (int j = 0; j < 8; ++j) { v[j] = *(const f32x4*)(src + 4 * lane + 256 * j); s += (v[j][0] + v[j][1]) + (v[j][2] + v[j][3]); }
        if (MODE != 0) {
            const float mean = wave_sum(s) * (1.f / D); float s2 = 0.f;
#pragma unroll
            for (int j = 0; j < 8; ++j) { v[j] = v[j] - mean; s2 += (v[j][0] * v[j][0] + v[j][1] * v[j][1]) + (v[j][2] * v[j][2] + v[j][3] * v[j][3]); }
            const float rstd = 1.0f / sqrtf(wave_sum(s2) * (1.f / D) + LN_EPS);
            s = 0.f;
#pragma unroll
            for (int j = 0; j < 8; ++j) { const f32x4 gg = *(const f32x4*)(lg + 4 * lane + 256 * j), bb = *(const f32x4*)(lb + 4 * lane + 256 * j);
                v[j] = v[j] * rstd * gg + bb; s += (v[j][0] + v[j][1]) + (v[j][2] + v[j][3]); }
        }
        float* xo = MODE == 3 ? a.out + (size_t)row * D : X + (size_t)row * D;
#pragma unroll
        for (int j = 0; j < 8; ++j) *(f32x4*)(xo + 4 * lane + 256 * j) = v[j];
        if (MODE != 3) {
            const float mean = wave_sum(s) * (1.f / D); float s2 = 0.f;
#pragma unroll
            for (int j = 0; j < 8; ++j) { v[j] = v[j] - mean; s2 += (v[j][0] * v[j][0] + v[j][1] * v[j][1]) + (v[j][2] * v[j][2] + v[j][3] * v[j][3]); }
            const float rstd = 1.0f / sqrtf(wave_sum(s2) * (1.f / D) + LN_EPS);
            const int cidx = row < NCTX ? 0 : 1 + ((row - NCTX) >> 10);
            const float* shp = MODp + ((size_t)ml * 5 + cidx) * 12288 + mi * D; const float* scp = shp + D;
#pragma unroll
            for (int j = 0; j < 8; ++j) { const f32x4 sh = *(const f32x4*)(shp + 4 * lane + 256 * j), sc = *(const f32x4*)(scp + 4 * lane + 256 * j);
                const f32x4 h = v[j] * rstd * (sc + 1.0f) + sh; v2u w; w.x = cvt_pk_bf16(h[0], h[1]); w.y = cvt_pk_bf16(h[2], h[3]);
                *(v2u*)(H + (size_t)row * D + 4 * lane + 256 * j) = w; }
        }
    }
}

__device__ __forceinline__ void shift8(const bf16* F, unsigned fo, bool hp, bool hn, const float* mix, unsigned mo, float (&o)[8]) {
    const v4u c = *(const v4u*)(F + fo); v4u p = {0u, 0u, 0u, 0u}, n = {0u, 0u, 0u, 0u};
    if (hp) p = *(const v4u*)(F + (fo - NINP)); if (hn) n = *(const v4u*)(F + (fo + NINP));
    const f32x4 m0a = *(const f32x4*)(mix + mo), m0b = *(const f32x4*)(mix + (mo + 4)), m1a = *(const f32x4*)(mix + (mo + 1920)), m1b = *(const f32x4*)(mix + (mo + 1924));
#pragma unroll
    for (int w = 0; w < 4; ++w) { const unsigned cw = c[w], pw = p[w], nw = n[w];
        const float f0 = bf_lo(cw), f1 = bf_hi(cw); const float m00 = w < 2 ? m0a[2 * w] : m0b[2 * w - 4], m01 = w < 2 ? m0a[2 * w + 1] : m0b[2 * w - 3];
        const float m10 = w < 2 ? m1a[2 * w] : m1b[2 * w - 4], m11 = w < 2 ? m1a[2 * w + 1] : m1b[2 * w - 3];
        o[2 * w] = f0 + m00 * (bf_lo(pw) - f0) + m10 * (bf_lo(nw) - f0); o[2 * w + 1] = f1 + m01 * (bf_hi(pw) - f1) + m11 * (bf_hi(nw) - f1); }
}
__device__ __forceinline__ f32x4 shift4(const bf16* F, unsigned fo, bool hp, bool hn, const float* mix, unsigned mo) {
    const v2u c = *(const v2u*)(F + fo); v2u p = {0u, 0u}, n = {0u, 0u};
    if (hp) p = *(const v2u*)(F + (fo - NINP)); if (hn) n = *(const v2u*)(F + (fo + NINP));
    const f32x4 m0 = *(const f32x4*)(mix + mo), m1 = *(const f32x4*)(mix + (mo + 1920));
    f32x4 f, pv, nv; f[0] = bf_lo(c.x); f[1] = bf_hi(c.x); f[2] = bf_lo(c.y); f[3] = bf_hi(c.y);
    pv[0] = bf_lo(p.x); pv[1] = bf_hi(p.x); pv[2] = bf_lo(p.y); pv[3] = bf_hi(p.y); nv[0] = bf_lo(n.x); nv[1] = bf_hi(n.x); nv[2] = bf_lo(n.y); nv[3] = bf_hi(n.y);
    return f + m0 * (pv - f) + m1 * (nv - f);
}
__device__ __forceinline__ float ftanh(float x) { return 1.0f - 2.0f / (1.0f + __expf(2.0f * x)); }
__device__ __forceinline__ bf16x8 pack8(const float (&o)[8]) { v4u w; w.x = cvt_pk_bf16(o[0], o[1]); w.y = cvt_pk_bf16(o[2], o[3]); w.z = cvt_pk_bf16(o[4], o[5]); w.w = cvt_pk_bf16(o[6], o[7]); return __builtin_bit_cast(bf16x8, w); }
__device__ __forceinline__ float logsigmoid(float z) { const float e = __expf(-fabsf(z)); return fminf(z, 0.f) - __logf(1.0f + e); }

__device__ __forceinline__ void phase_pre(ArgsRef a, unsigned char* ws, int l, int gw, int NGW, int lane) {
    const bf16* F = (const bf16*)(ws + WS_F);
    const float* mix = a.in[16] + (size_t)l * 2 * 1920;
    const float* w0 = a.in[17] + l * 1024; const float* a0 = a.in[19] + l * 1024;
    const float* kkw = a.in[22] + l * 512; const float* kaw = a.in[23] + l * 512; const float* rkw = a.in[24] + l * 512;
    const bf16* W2T = (const bf16*)(ws + WS_W2T) + (size_t)l * 2 * 512 * 64; const bf16* A2T = (const bf16*)(ws + WS_A2T) + (size_t)l * 2 * 512 * 64;
    const bf16* G2T = (const bf16*)(ws + WS_G2T) + (size_t)l * 512 * 128;
    float* SI = (float*)(ws + WS_SI); float* Gb = (float*)(ws + WS_G); float* BON = (float*)(ws + WS_BON);
    for (int u = gw; u < 4096 + 8192; u += NGW) {
        int q = lane & 15, g = lane >> 4; asm volatile("" : "+v"(q), "+v"(g));
        if (u < 4096) {
            const int tile = u >> 3, hh = u & 7, row = tile * 16 + q;
            const int T = row < NCTX ? 256 : 1024, pos = row & (T - 1); const bool hp = pos > 0, hn = pos < T - 1;
            const unsigned fo = (unsigned)row * NINP + C_RW;
            float t8[8]; f32x4 af[4], ab[4];
            const unsigned ao = (unsigned)(hh * 64 + q) * 64 + 8 * g, go = (unsigned)(hh * 64 + q) * 128 + 8 * g;
            const unsigned c40 = hh * 64 + 4 * g;
            const unsigned so = ((unsigned)hh * MT + row) * 384 + 4 * g;
#pragma unroll
            for (int d = 0; d < 2; ++d) { f32x4 acc[4];
#pragma unroll
                for (int rb = 0; rb < 4; ++rb) acc[rb] = (f32x4){0.f, 0.f, 0.f, 0.f};
#pragma unroll
                for (int ks = 0; ks < 2; ++ks) { const unsigned cb = 32 * ks + 8 * g; shift8(F, fo + 1536 + 64 * d + cb, hp, hn, mix, 1536 + 64 * d + cb, t8);
#pragma unroll
                    for (int e = 0; e < 8; ++e) t8[e] = ftanh(t8[e]);
                    const bf16x8 bop = pack8(t8);
#pragma unroll
                    for (int rb = 0; rb < 4; ++rb) acc[rb] = mfma16(*(const bf16x8*)(W2T + (ao + 32768 * d + 1024 * rb + 32 * ks)), bop, acc[rb]); }
#pragma unroll
                for (int rb = 0; rb < 4; ++rb) { const f32x4 wz = *(const f32x4*)(w0 + (512 * d + c40 + 16 * rb)); f32x4 dec;
#pragma unroll
                    for (int e = 0; e < 4; ++e) dec[e] = __expf(-__expf(logsigmoid(wz[e] + acc[rb][e]) - 0.5f));
                    *(f32x4*)(SI + (so + 8u * MT * 384u * d + 16 * rb + 64)) = dec; }
                asm volatile("" ::: "memory"); }
#pragma unroll
            for (int d = 0; d < 2; ++d) { f32x4 acc[4];
#pragma unroll
                for (int rb = 0; rb < 4; ++rb) acc[rb] = (f32x4){0.f, 0.f, 0.f, 0.f};
#pragma unroll
                for (int ks = 0; ks < 2; ++ks) { const unsigned cb = 32 * ks + 8 * g; shift8(F, fo + 1664 + 64 * d + cb, hp, hn, mix, 1664 + 64 * d + cb, t8);
                    const bf16x8 bop = pack8(t8);
#pragma unroll
                    for (int rb = 0; rb < 4; ++rb) acc[rb] = mfma16(*(const bf16x8*)(A2T + (ao + 32768 * d + 1024 * rb + 32 * ks)), bop, acc[rb]); }
#pragma unroll
                for (int rb = 0; rb < 4; ++rb) { const f32x4 az = *(const f32x4*)(a0 + (512 * d + c40 + 16 * rb));
#pragma unroll
                    for (int e = 0; e < 4; ++e) { const float v = sigm(az[e] + acc[rb][e]); if (d == 0) af[rb][e] = v; else ab[rb][e] = v; } }
                asm volatile("" ::: "memory"); }
            { f32x4 acc[4];
#pragma unroll
                for (int rb = 0; rb < 4; ++rb) acc[rb] = (f32x4){0.f, 0.f, 0.f, 0.f};
#pragma unroll
                for (int ks = 0; ks < 4; ++ks) { const unsigned cb = 32 * ks + 8 * g; shift8(F, fo + 1792 + cb, hp, hn, mix, 1792 + cb, t8);
#pragma unroll
                    for (int e = 0; e < 8; ++e) t8[e] = sigm(t8[e]);
                    const bf16x8 bop = pack8(t8);
#pragma unroll
                    for (int rb = 0; rb < 4; ++rb) acc[rb] = mfma16(*(const bf16x8*)(G2T + (go + 2048 * rb + 32 * ks)), bop, acc[rb]); }
#pragma unroll
                for (int rb = 0; rb < 4; ++rb) *(f32x4*)(Gb + ((unsigned)row * 512 + c40 + 16 * rb)) = acc[rb];
                asm volatile("" ::: "memory"); }
            float ss = 0.f;
#pragma unroll
            for (int rb = 0; rb < 4; ++rb) { const unsigned c4 = c40 + 16 * rb;
                const f32x4 kv = shift4(F, fo + 512 + c4, hp, hn, mix, 512 + c4) * *(const f32x4*)(kkw + c4); ss += (kv[0] * kv[0] + kv[1] * kv[1]) + (kv[2] * kv[2] + kv[3] * kv[3]); }
            ss = xrow16_sum(ss);
            const float kinv = 1.0f / fmaxf(sqrtf(ss), 1e-12f);
            float bonus = 0.f;
            asm volatile("" ::: "memory");
#pragma unroll
            for (int rb = 0; rb < 4; ++rb) { const unsigned c4 = c40 + 16 * rb;
                const f32x4 rr = shift4(F, fo + c4, hp, hn, mix, c4), kh = shift4(F, fo + 512 + c4, hp, hn, mix, 512 + c4), vv = shift4(F, fo + 1024 + c4, hp, hn, mix, 1024 + c4);
                const f32x4 kkv = kh * *(const f32x4*)(kkw + c4);
                const f32x4 kav = *(const f32x4*)(kaw + c4), rkv = *(const f32x4*)(rkw + c4);
                f32x4 kdf, kdb, bf, bb, nkk;
#pragma unroll
                for (int e = 0; e < 4; ++e) {
                    kdf[e] = kh[e] * (1.0f + (af[rb][e] - 1.0f) * kav[e]); kdb[e] = kh[e] * (1.0f + (ab[rb][e] - 1.0f) * kav[e]);
                    const float kn = kkv[e] * kinv; nkk[e] = -kn; bf[e] = kn * af[rb][e]; bb[e] = kn * ab[rb][e];
                    bonus += rr[e] * rkv[e] * (kdf[e] + kdb[e]); }
                const unsigned s0 = so + 16 * rb, s1 = s0 + 8u * MT * 384u;
                *(f32x4*)(SI + s0) = rr; *(f32x4*)(SI + (s0 + 128)) = kdf; *(f32x4*)(SI + (s0 + 192)) = vv; *(f32x4*)(SI + (s0 + 256)) = nkk; *(f32x4*)(SI + (s0 + 320)) = bf;
                *(f32x4*)(SI + s1) = rr; *(f32x4*)(SI + (s1 + 128)) = kdb; *(f32x4*)(SI + (s1 + 192)) = vv; *(f32x4*)(SI + (s1 + 256)) = nkk; *(f32x4*)(SI + (s1 + 320)) = bb;
                asm volatile("" ::: "memory"); }
            bonus = xrow16_sum(bonus);
            if (g == 0) BON[(size_t)row * 8 + hh] = bonus;
        } else {
            const int v = u - 4096, lr = v >> 1, isk = v & 1;
            const bf16* src = F + (size_t)(NCTX + lr) * NINP + (isk ? C_DFK : C_DFQ) + 8 * lane;
            const v4u x = *(const v4u*)src; v4u xp; xp.x = __shfl_xor(x.x, 2); xp.y = __shfl_xor(x.y, 2); xp.z = __shfl_xor(x.z, 2); xp.w = __shfl_xor(x.w, 2);
            const int seg = lane & 7, tpos = lr & 1023, pos = seg < 4 ? (tpos >> 6) : (tpos & 63); const bool second = (seg & 2) != 0;
            const float* rp = (const float*)(ws + WS_ROPE) + ((size_t)pos * 16 + 8 * (seg & 1)) * 2;
            float o[8];
#pragma unroll
            for (int w = 0; w < 4; ++w) { const unsigned xw = x[w], pw = xp[w];
                const float c0 = rp[4 * w], s0 = rp[4 * w + 1], c1 = rp[4 * w + 2], s1 = rp[4 * w + 3];
                o[2 * w] = second ? bf_lo(xw) * c0 + bf_lo(pw) * s0 : bf_lo(xw) * c0 - bf_lo(pw) * s0;
                o[2 * w + 1] = second ? bf_hi(xw) * c1 + bf_hi(pw) * s1 : bf_hi(xw) * c1 - bf_hi(pw) * s1; }
            v4u ow; ow.x = cvt_pk_bf16(o[0], o[1]); ow.y = cvt_pk_bf16(o[2], o[3]); ow.z = cvt_pk_bf16(o[4], o[5]); ow.w = cvt_pk_bf16(o[6], o[7]);
            *(v4u*)((bf16*)(ws + (isk ? WS_KR : WS_QR)) + (size_t)lr * 512 + 8 * lane) = ow;
        }
    }
}

__device__ __forceinline__ void phase_post(ArgsRef a, unsigned char* ws, int l, int gw, int NGW, int lane) {
    const float* Y = (const float*)(ws + WS_Y); const float* SI = (const float*)(ws + WS_SI); const float* Gb = (const float*)(ws + WS_G); const float* BON = (const float*)(ws + WS_BON);
    bf16* O3 = (bf16*)(ws + WS_O3) + (size_t)2 * MT * 512;
    const float* lng = a.in[25] + l * 512; const float* lnb = a.in[26] + l * 512;
    const int c = 8 * lane, hh = lane >> 3;
    for (int row = gw; row < MT; row += NGW) {
        const float* yf = Y + (size_t)row * 512 + c; const float* yb = Y + (size_t)(MT + row) * 512 + c;
        f32x4 y0 = *(const f32x4*)yf + *(const f32x4*)yb, y1 = *(const f32x4*)(yf + 4) + *(const f32x4*)(yb + 4);
        float s = (y0[0] + y0[1]) + (y0[2] + y0[3]) + (y1[0] + y1[1]) + (y1[2] + y1[3]); s = red8(s);
        const float mu = s * (1.f / 64.f); y0 = y0 - mu; y1 = y1 - mu;
        float s2 = (y0[0] * y0[0] + y0[1] * y0[1]) + (y0[2] * y0[2] + y0[3] * y0[3]) + (y1[0] * y1[0] + y1[1] * y1[1]) + (y1[2] * y1[2] + y1[3] * y1[3]); s2 = red8(s2);
        const float rstd = 1.0f / sqrtf(s2 * (1.f / 64.f) + 64e-5f);
        const float bon = BON[(size_t)row * 8 + hh];
        const float* vp = SI + ((size_t)hh * MT + row) * 384 + 192 + (c & 63);
        const f32x4 v0 = *(const f32x4*)vp, v1 = *(const f32x4*)(vp + 4), g0 = *(const f32x4*)(Gb + (size_t)row * 512 + c), g1 = *(const f32x4*)(Gb + (size_t)row * 512 + c + 4);
        const f32x4 o0 = (y0 * rstd * *(const f32x4*)(lng + c) + *(const f32x4*)(lnb + c) + v0 * bon) * g0;
        const f32x4 o1 = (y1 * rstd * *(const f32x4*)(lng + c + 4) + *(const f32x4*)(lnb + c + 4) + v1 * bon) * g1;
        v4u w; w.x = cvt_pk_bf16(o0[0], o0[1]); w.y = cvt_pk_bf16(o0[2], o0[3]); w.z = cvt_pk_bf16(o1[0], o1[1]); w.w = cvt_pk_bf16(o1[2], o1[3]);
        *(v4u*)(O3 + (size_t)row * 512 + c) = w;
    }
}

__device__ __forceinline__ void scan_unit(ArgsRef a, unsigned char* ws, int l, bool lat, int b, int head, int dir, LAS unsigned char* lds, int tid) {
    const int T = lat ? 1024 : 256, tokbase = lat ? NCTX + b * 1024 : b * 256, nch = T / 32;
    const int row = tid >> 3, kseg = tid & 7;
    const float* si = (const float*)(ws + WS_SI) + ((size_t)(dir * 8 + head) * MT + tokbase) * 384;
    float* Yo = (float*)(ws + WS_Y) + ((size_t)dir * MT + tokbase) * 512 + head * 64;
    float S[8];
    if (lat) { const float* sp = a.in[dir == 0 ? 6 : 7] + ((size_t)(b * 4 + l) * 8 + head) * 4096 + row * 64 + 8 * kseg;
        const f32x4 s0 = *(const f32x4*)sp, s1 = *(const f32x4*)(sp + 4); S[0] = s0[0]; S[1] = s0[1]; S[2] = s0[2]; S[3] = s0[3]; S[4] = s1[0]; S[5] = s1[1]; S[6] = s1[2]; S[7] = s1[3]; }
    else {
#pragma unroll
        for (int i = 0; i < 8; ++i) S[i] = 0.f; }
    LAS float* buf0 = (LAS float*)lds; LAS float* ybuf0 = (LAS float*)(lds + 98304);
    f32x4 pre[6];
    { const int tok0 = dir == 0 ? 0 : T - 32; const f32x4* s4 = (const f32x4*)(si + (size_t)tok0 * 384);
#pragma unroll
      for (int j = 0; j < 6; ++j) pre[j] = s4[tid + 512 * j]; }
    for (int c = 0; c < nch; ++c) {
        LAS float* buf = buf0 + (c & 1) * 12288; LAS float* yb = ybuf0 + (c & 1) * 2048;
#pragma unroll
        for (int j = 0; j < 6; ++j) *(LAS f32x4*)(buf + 4 * (tid + 512 * j)) = pre[j];
        __syncthreads();
        if (c > 0) { const int tp = dir == 0 ? 32 * (c - 1) : T - 32 * c; LAS float* ybp = ybuf0 + ((c - 1) & 1) * 2048;
            *(f32x4*)(Yo + (size_t)(tp + (tid >> 4)) * 512 + 4 * (tid & 15)) = *(LAS f32x4*)(ybp + 4 * tid); }
        if (c + 1 < nch) { const int tok0 = dir == 0 ? 32 * (c + 1) : T - 32 * (c + 2); const f32x4* s4 = (const f32x4*)(si + (size_t)tok0 * 384);
#pragma unroll
            for (int j = 0; j < 6; ++j) pre[j] = s4[tid + 512 * j]; }
#pragma unroll 2
        for (int s = 0; s < 32; ++s) {
            const int ti = dir == 0 ? s : 31 - s; const LAS float* rec = buf + ti * 384 + 8 * kseg;
            const f32x4 r0 = *(const LAS f32x4*)(rec), r1 = *(const LAS f32x4*)(rec + 4), w0 = *(const LAS f32x4*)(rec + 64), w1 = *(const LAS f32x4*)(rec + 68);
            const f32x4 k0 = *(const LAS f32x4*)(rec + 128), k1 = *(const LAS f32x4*)(rec + 132), a0 = *(const LAS f32x4*)(rec + 256), a1 = *(const LAS f32x4*)(rec + 260);
            const f32x4 b0 = *(const LAS f32x4*)(rec + 320), b1 = *(const LAS f32x4*)(rec + 324);
            const float vv = buf[ti * 384 + 192 + row];
            float sa = (S[0] * a0[0] + S[1] * a0[1]) + (S[2] * a0[2] + S[3] * a0[3]) + ((S[4] * a1[0] + S[5] * a1[1]) + (S[6] * a1[2] + S[7] * a1[3]));
            sa = red8(sa);
            S[0] = S[0] * w0[0] + sa * b0[0] + vv * k0[0]; S[1] = S[1] * w0[1] + sa * b0[1] + vv * k0[1]; S[2] = S[2] * w0[2] + sa * b0[2] + vv * k0[2]; S[3] = S[3] * w0[3] + sa * b0[3] + vv * k0[3];
            S[4] = S[4] * w1[0] + sa * b1[0] + vv * k1[0]; S[5] = S[5] * w1[1] + sa * b1[1] + vv * k1[1]; S[6] = S[6] * w1[2] + sa * b1[2] + vv * k1[2]; S[7] = S[7] * w1[3] + sa * b1[3] + vv * k1[3];
            float y = (S[0] * r0[0] + S[1] * r0[1]) + (S[2] * r0[2] + S[3] * r0[3]) + ((S[4] * r1[0] + S[5] * r1[1]) + (S[6] * r1[2] + S[7] * r1[3]));
            y = red8(y);
            if (kseg == 0) yb[ti * 64 + row] = y;
        }
    }
    __syncthreads();
    { const int tp = dir == 0 ? 32 * (nch - 1) : 0; LAS float* ybp = ybuf0 + ((nch - 1) & 1) * 2048;
      *(f32x4*)(Yo + (size_t)(tp + (tid >> 4)) * 512 + 4 * (tid & 15)) = *(LAS f32x4*)(ybp + 4 * tid); }
    if (!lat) { float* op = a.out + (dir == 0 ? OUT_RF : OUT_RB) + ((size_t)(b * 4 + l) * 8 + head) * 4096 + row * 64 + 8 * kseg;
        *(f32x4*)op = (f32x4){S[0], S[1], S[2], S[3]}; *(f32x4*)(op + 4) = (f32x4){S[4], S[5], S[6], S[7]}; }
    __syncthreads();
}

constexpr int ATT_KP = 272, ATT_VP = 288, ATT_BUF = 32 * ATT_KP + 32 * ATT_VP;
template <int MODE> __device__ __forceinline__ void att_src(ArgsRef a, unsigned char* ws, int l, int b, int h, int c, int j, int rg, int skey, int sseg, const bf16*& kp, const bf16*& vp) {
    const bf16* F = (const bf16*)(ws + WS_F);
    if (MODE == 0 || MODE == 2) { const size_t ro = (size_t)(b * 256 + 32 * c + skey) * NINP + h * 128 + sseg * 8; kp = F + ro + (MODE == 0 ? C_NAK : C_DFK); vp = F + ro + (MODE == 0 ? C_NAV : C_DFV); }
    else if (MODE == 3) {
        if (c < 32) { kp = (const bf16*)(ws + WS_KR) + (size_t)(b * 1024 + 32 * c + skey) * 512 + h * 128 + sseg * 8; vp = F + (size_t)(NCTX + b * 1024 + 32 * c + skey) * NINP + C_DFV + h * 128 + sseg * 8; }
        else { const size_t ro = ((size_t)(b * 4 + l) * 256 + 32 * (c - 32) + skey) * 512 + h * 128 + sseg * 8; kp = (const bf16*)(ws + WS_CKDF) + ro; vp = (const bf16*)(ws + WS_CVDF) + ro; }
    } else {
        const int nloc = rg ? 12 : 11;
        if (c < nloc) { const int kr = (rg ? 4 : 0) + c; int kc0 = 16 * j - 8; kc0 = kc0 < 0 ? 0 : (kc0 > 32 ? 32 : kc0);
            const size_t ro = (size_t)(NCTX + b * 1024 + kr * 64 + kc0 + skey) * NINP + h * 128 + sseg * 8; kp = F + ro + C_NAK; vp = F + ro + C_NAV; }
        else { const size_t ro = ((size_t)(b * 4 + l) * 256 + 32 * (c - nloc) + skey) * 512 + h * 128 + sseg * 8; kp = (const bf16*)(ws + WS_CKNA) + ro; vp = (const bf16*)(ws + WS_CVNA) + ro; }
    }
}
template <int MODE> __device__ __forceinline__ void attn_unit(ArgsRef a, unsigned char* ws, int l, int uidx, LAS unsigned char* lds, int tid) {
    constexpr bool DIFF = (MODE == 2 || MODE == 3); constexpr int NS = DIFF ? 2 : 1;
    const int wave = __builtin_amdgcn_readfirstlane(tid >> 6), lane = tid & 63, q = lane & 15, g = lane >> 4, skey = tid >> 4, sseg = tid & 15;
    const bf16* F = (const bf16*)(ws + WS_F);
    int b, h, j = 0, rg = 0, nchunks, orow; const bf16* Qp;
    if (MODE == 0 || MODE == 2) { b = uidx >> 3; h = (uidx >> 1) & 3; const int half = uidx & 1; orow = b * 256 + half * 128 + wave * 16 + q; Qp = F + (size_t)orow * NINP + (MODE == 0 ? C_NAQ : C_DFQ) + h * 128; nchunks = 8; }
    else if (MODE == 3) { b = uidx >> 5; h = (uidx >> 3) & 3; const int qb = uidx & 7; const int lr = b * 1024 + qb * 128 + wave * 16 + q; orow = NCTX + lr; Qp = (const bf16*)(ws + WS_QR) + (size_t)lr * 512 + h * 128; nchunks = 40; }
    else { b = uidx >> 5; h = (uidx >> 3) & 3; j = (uidx >> 1) & 3; rg = uidx & 1; const int r = rg * 8 + wave; orow = NCTX + b * 1024 + r * 64 + 16 * j + q; Qp = F + (size_t)orow * NINP + C_NAQ + h * 128; nchunks = (rg ? 12 : 11) + 8; }
    bf16x8 qf[4];
#pragma unroll
    for (int ks = 0; ks < 4; ++ks) qf[ks] = *(const bf16x8*)(Qp + 32 * ks + 8 * g);
    const float scale = DIFF ? 0.125f : 0.08838834764831845f;
    float m[NS], ls[NS]; f32x4 o[NS][8];
#pragma unroll
    for (int n = 0; n < NS; ++n) { m[n] = -__builtin_inff(); ls[n] = 0.f;
#pragma unroll
        for (int d = 0; d < 8; ++d) o[n][d] = (f32x4){0.f, 0.f, 0.f, 0.f}; }
    const int nloc = rg ? 12 : 11, r = rg * 8 + wave, qc = 16 * j + q;
    int rs = r - 4; rs = rs < 0 ? 0 : (rs > 8 ? 8 : rs);
    int kc0 = 16 * j - 8; kc0 = kc0 < 0 ? 0 : (kc0 > 32 ? 32 : kc0);
    int wc0 = qc - 8; wc0 = wc0 < 0 ? 0 : (wc0 > 48 ? 48 : wc0);
    const float* rpb = a.in[13] + (size_t)(l * 4 + h) * 15 * 31;
    v4u kreg, vreg;
    { const bf16 *kp, *vp; att_src<MODE>(a, ws, l, b, h, 0, j, rg, skey, sseg, kp, vp); kreg = *(const v4u*)kp; vreg = *(const v4u*)vp; }
    for (int c = 0; c < nchunks; ++c) {
        LAS unsigned char* Kl = lds + (c & 1) * ATT_BUF; LAS unsigned char* Vl = Kl + 32 * ATT_KP;
        *(LAS v4u*)(Kl + skey * ATT_KP + sseg * 16) = kreg; *(LAS v4u*)(Vl + skey * ATT_VP + sseg * 16) = vreg;
        __syncthreads();
        if (c + 1 < nchunks) { const bf16 *kp, *vp; att_src<MODE>(a, ws, l, b, h, c + 1, j, rg, skey, sseg, kp, vp); kreg = *(const v4u*)kp; vreg = *(const v4u*)vp; }
        bool active = true; int kr = 0;
        if (MODE == 1 && c < nloc) { kr = (rg ? 4 : 0) + c; active = (kr >= rs) && (kr < rs + 8); }
        if (active) {
            f32x4 s[NS][2];
#pragma unroll
            for (int n = 0; n < NS; ++n) { s[n][0] = (f32x4){0.f, 0.f, 0.f, 0.f}; s[n][1] = s[n][0]; }
#pragma unroll
            for (int t = 0; t < 2; ++t)
#pragma unroll
                for (int ks = 0; ks < 4; ++ks) { const bf16x8 ka = *(const LAS bf16x8*)(Kl + (16 * t + q) * ATT_KP + (32 * ks + 8 * g) * 2);
                    const int n = DIFF ? (ks >> 1) : 0; s[n][t] = mfma16(ka, qf[ks], s[n][t]); }
#pragma unroll
            for (int n = 0; n < NS; ++n) { s[n][0] = s[n][0] * scale; s[n][1] = s[n][1] * scale; }
            if (MODE == 1 && c < nloc) { const float* rrow = rpb + (kr - r + 7) * 31 + 15;
#pragma unroll
                for (int t = 0; t < 2; ++t)
#pragma unroll
                    for (int e = 0; e < 4; ++e) { const int kc = kc0 + 16 * t + 4 * g + e; int rel = kc - qc; rel = rel < -15 ? -15 : (rel > 15 ? 15 : rel);
                        const bool inw = (kc >= wc0) && (kc < wc0 + 16); s[0][t][e] = inw ? s[0][t][e] + rrow[rel] : -__builtin_inff(); } }
            bf16x8 pb[NS];
#pragma unroll
            for (int n = 0; n < NS; ++n) {
                float mx = fmaxf(fmaxf(fmaxf(s[n][0][0], s[n][0][1]), fmaxf(s[n][0][2], s[n][0][3])), fmaxf(fmaxf(s[n][1][0], s[n][1][1]), fmaxf(s[n][1][2], s[n][1][3])));
                mx = xrow16_max(mx);
                const float mnew = fmaxf(m[n], mx), muse = (mnew == -__builtin_inff()) ? 0.f : mnew;
                const float alpha = __expf(m[n] - muse); m[n] = mnew;
                float p[8]; float psum = 0.f;
#pragma unroll
                for (int e = 0; e < 4; ++e) { p[e] = __expf(s[n][0][e] - muse); p[4 + e] = __expf(s[n][1][e] - muse); psum += p[e] + p[4 + e]; }
                ls[n] = ls[n] * alpha + psum;
#pragma unroll
                for (int d = 0; d < 8; ++d) o[n][d] = o[n][d] * alpha;
                pb[n] = pack8(p);
            }
#pragma unroll
            for (int d = 0; d < 8; ++d) {
                const LAS unsigned char* va = Vl + (4 * g + (q >> 2)) * ATT_VP + (16 * d + 4 * (q & 3)) * 2;
                const s16x4 lo = vtr(va), hi = vtr(va + 16 * ATT_VP);
                const bf16x8 vt = {lo[0], lo[1], lo[2], lo[3], hi[0], hi[1], hi[2], hi[3]};
#pragma unroll
                for (int n = 0; n < NS; ++n) o[n][d] = mfma16(vt, pb[n], o[n][d]);
            }
        }
    }
    bf16* O3 = (bf16*)(ws + WS_O3) + (size_t)(DIFF ? 1 : 0) * MT * 512 + (size_t)orow * 512 + h * 128 + 4 * g;
    if constexpr (!DIFF) { const float inv = 1.0f / xrow16_sum(ls[0]);
#pragma unroll
        for (int d = 0; d < 8; ++d) { const f32x4 v = o[0][d] * inv; v2u w; w.x = cvt_pk_bf16(v[0], v[1]); w.y = cvt_pk_bf16(v[2], v[3]); *(v2u*)(O3 + 16 * d) = w; } }
    else { const float lam = ((const float*)(ws + WS_LAM))[l], li = lam_init_of(l);
        const float i0 = 1.0f / xrow16_sum(ls[0]), i1 = lam / xrow16_sum(ls[1]); float ss = 0.f;
#pragma unroll
        for (int d = 0; d < 8; ++d) { o[0][d] = o[0][d] * i0 - o[1][d] * i1; ss += (o[0][d][0] * o[0][d][0] + o[0][d][1] * o[0][d][1]) + (o[0][d][2] * o[0][d][2] + o[0][d][3] * o[0][d][3]); }
        ss = xrow16_sum(ss);
        const float rsn = (1.0f / sqrtf(ss * (1.f / 128.f) + LN_EPS)) * (1.0f - li);
        const float* sub = a.in[15] + l * 512 + h * 128 + 4 * g;
#pragma unroll
        for (int d = 0; d < 8; ++d) { const f32x4 v = o[0][d] * rsn * *(const f32x4*)(sub + 16 * d); v2u w; w.x = cvt_pk_bf16(v[0], v[1]); w.y = cvt_pk_bf16(v[2], v[3]); *(v2u*)(O3 + 16 * d) = w; } }
    __syncthreads();
}

constexpr int MIX_LS = 64, MIX_CS = MIX_LS + 256, MIX_A3 = MIX_CS + 128, MIX_A1 = MIX_A3 + 128, MIX_A0 = MIX_A1 + 128, MIX_A2 = MIX_A0 + 128;
__device__ __forceinline__ void phase_mix(ArgsRef a, unsigned char* ws, int l, LAS unsigned char* lds, int tid) {
    gu32* head = (gu32*)(ws + WS_CTL) + CW_MIXQ + 64 * l;
    volatile LAS int* slot = (volatile LAS int*)(lds + MISC_OFF + 64);
    for (;;) {
        if (tid == 0) slot[0] = (int)__hip_atomic_fetch_add(head, 1u, __ATOMIC_RELAXED, __HIP_MEMORY_SCOPE_AGENT);
        __syncthreads();
        const int u = __builtin_amdgcn_readfirstlane(slot[0]);
        __syncthreads();
        if (u >= MIX_A2) break;
        if (u < MIX_LS) scan_unit(a, ws, l, true, u >> 4, (u >> 1) & 7, u & 1, lds, tid);
        else if (u < MIX_CS) { const int v = u - MIX_LS; scan_unit(a, ws, l, false, v >> 4, (v >> 1) & 7, v & 1, lds, tid); }
        else if (u < MIX_A3) attn_unit<3>(a, ws, l, u - MIX_CS, lds, tid);
        else if (u < MIX_A1) attn_unit<1>(a, ws, l, u - MIX_A3, lds, tid);
        else if (u < MIX_A0) attn_unit<0>(a, ws, l, u - MIX_A1, lds, tid);
        else attn_unit<2>(a, ws, l, u - MIX_A0, lds, tid);
    }
}

__global__ void __launch_bounds__(NWAVES * 64, 2) fwd_kernel(Args args) {
    extern __shared__ __attribute__((aligned(16))) unsigned char lds_raw[];
    LAS unsigned char* lds = (LAS unsigned char*)lds_raw;
    const int tid = threadIdx.x; const int wave_s = __builtin_amdgcn_readfirstlane(tid >> 6);
    const int G = gridDim.x, bid = blockIdx.x, NGW = G * NWAVES;
    for (int u = tid; u < (LDS_BYTES - RING_BYTES) / 4; u += NWAVES * 64) ((LAS unsigned*)(lds + RING_BYTES))[u] = 0u;
    __syncthreads();
    unsigned* barw = (unsigned*)(args.ws + WS_CTL) + CW_BAR;
    XcdBarrier bar; bar.bar = barw; bar.x = 0; bar.st = nullptr;
    if (MK_SINGLE) bar = xcd_barrier_post(barw, (volatile LAS unsigned*)(lds + MISC_OFF) + 8);
    const int lo = args.ph_lo, hi = args.ph_hi;
#ifndef PH_MASK
#define PH_MASK 0xFFFFu
#endif
#define PM(i) (((PH_MASK) >> (i)) & 1u)
#define IN(k) (lo <= (k) && (k) < hi)
#define SEAM(k) do { if (MK_SINGLE && IN(k) && IN((k) + 1)) xcd_barrier(bar); } while (0)
#define FRESH() int tid_, bid_ = bid, G_ = G; asm volatile("v_mbcnt_lo_u32_b32 %0, -1, 0\n\tv_mbcnt_hi_u32_b32 %0, -1, %0" : "=v"(tid_)); tid_ += wave_s * 64; const CAS Args* ap_ = (const CAS Args*)__builtin_amdgcn_kernarg_segment_ptr(); asm volatile("" : "+v"(tid_), "+s"(ap_), "+s"(bid_), "+s"(G_)); ArgsRef A_ = *ap_; unsigned char* ws = A_.ws; const int lane_ = tid_ & 63, wave_ = __builtin_amdgcn_readfirstlane(tid_ >> 6), gw_ = bid_ * NWAVES + wave_, NGW_ = G_ * NWAVES; (void)lane_; (void)gw_; (void)NGW_
    if (PM(0) && IN(0)) { FRESH(); phase_ada(A_, ws, lds, tid_, bid_, G_); __syncthreads(); phase_cvt(A_, ws, lds, tid_, bid_, G_); }
    SEAM(0);
    if (PM(1) && IN(1)) { FRESH(); phase_ln<0>(A_, ws, 0, gw_, NGW_, lane_); }
    SEAM(1);
    for (int l = 0; l < NL; ++l) {
        const int pb = 2 + 10 * l;
        if (PM(2) && IN(pb + 0)) { FRESH(); pg8::Gemm g{(const pg8::bf16_t*)(ws + WS_H), (const pg8::bf16_t*)(ws + WS_WIN) + (size_t)l * NINP * D, MT, NINP, D}; pg8::StaticOrder S; S.init(MT, NINP, G_, bid_);
            pg8::EpiF E{(pg8::bf16_t*)(ws + WS_F), A_.out, l};
            pg8::gemm_phase<pg8::EpiF, pg8::StaticOrder, true, true>(lds, g, S, E, tid_); }
        SEAM(pb + 0);
        if (PM(3) && IN(pb + 1)) { FRESH(); phase_pre(A_, ws, l, gw_, NGW_, lane_); }
        SEAM(pb + 1);
        if (PM(4) && IN(pb + 2)) { FRESH(); phase_mix(A_, ws, l, lds, tid_); }
        SEAM(pb + 2);
        if (PM(5) && IN(pb + 3)) { FRESH(); phase_post(A_, ws, l, gw_, NGW_, lane_); }
        SEAM(pb + 3);
        if (PM(6) && IN(pb + 4)) { FRESH(); pg8::Gemm g{(const pg8::bf16_t*)(ws + WS_O3), (const pg8::bf16_t*)(ws + WS_WBR) + (size_t)l * 3 * D * 512, 3 * MT, 3 * D, 512}; pg8::MergeOrder S{G_, bid_};
            pg8::EpiMerge E{(const pg8::bf16_t*)(ws + WS_F), (float*)(ws + WS_MBUF), (pg8::bf16_t*)(ws + WS_MERGED)};
            pg8::gemm_phase<pg8::EpiMerge, pg8::MergeOrder, true, true>(lds, g, S, E, tid_); }
        SEAM(pb + 4);
        if (PM(7) && IN(pb + 5)) { FRESH(); pg8::Gemm g{(const pg8::bf16_t*)(ws + WS_MERGED), (const pg8::bf16_t*)(ws + WS_WO) + (size_t)l * D * D, MT, D, D}; pg8::StaticOrder S; S.init(MT, D, G_, bid_);
            pg8::EpiRes E{(const float*)(ws + WS_X), (const float*)(ws + WS_MOD) + (size_t)l * 5 * 12288 + 2 * D, (float*)(ws + WS_MBUF), 1.681792830507429f};
            pg8::gemm_phase<pg8::EpiRes, pg8::StaticOrder, true, true>(lds, g, S, E, tid_); }
        SEAM(pb + 5);
        if (PM(8) && IN(pb + 6)) { FRESH(); phase_ln<1>(A_, ws, l, gw_, NGW_, lane_); }
        SEAM(pb + 6);
        if (PM(9) && IN(pb + 7)) { FRESH(); pg8::Gemm g{(const pg8::bf16_t*)(ws + WS_H), (const pg8::bf16_t*)(ws + WS_WFI) + (size_t)l * NFI * D, MT, NFI, D}; pg8::StaticOrder S; S.init(MT, NFI, G_, bid_);
            pg8::EpiSwiglu E{(pg8::bf16_t*)(ws + WS_F)};
            pg8::gemm_phase<pg8::EpiSwiglu, pg8::StaticOrder, true, true>(lds, g, S, E, tid_); }
        SEAM(pb + 7);
        if (PM(10) && IN(pb + 8)) { FRESH(); pg8::Gemm g{(const pg8::bf16_t*)(ws + WS_F), (const pg8::bf16_t*)(ws + WS_WFO) + (size_t)l * D * FF, MT, D, FF}; pg8::StaticOrder S; S.init(MT, D, G_, bid_);
            pg8::EpiRes E{(const float*)(ws + WS_X), (const float*)(ws + WS_MOD) + (size_t)l * 5 * 12288 + 5 * D, (float*)(ws + WS_MBUF), 1.681792830507429f};
            pg8::gemm_phase<pg8::EpiRes, pg8::StaticOrder, true, true>(lds, g, S, E, tid_); }
        SEAM(pb + 8);
        if (PM(11) && IN(pb + 9)) { FRESH(); if (l < NL - 1) phase_ln<2>(A_, ws, l, gw_, NGW_, lane_); else phase_ln<3>(A_, ws, l, gw_, NGW_, lane_); }
        SEAM(pb + 9);
    }
#undef FRESH
#undef IN
#undef SEAM
}
constexpr int N_PHASES = 2 + 10 * NL;

extern "C" void kernel_launch(void* const* d_in, const int* in_sizes, int n_in, void* d_out, int out_size, void* d_ws, size_t ws_size, hipStream_t stream) {
    static int grid = 0;
    if (grid == 0) {
        if (n_in != 35 || out_size != (int)OUT_TOTAL || ws_size < WS_END) { fprintf(stderr, "kernel_launch: unexpected problem: n_in %d out %d ws %zu (need %zu)\n", n_in, out_size, ws_size, (size_t)WS_END); grid = -1; return; }
        int dev = 0, cus = 0, per_cu = 0;
        if (hipGetDevice(&dev) != hipSuccess || hipDeviceGetAttribute(&cus, hipDeviceAttributeMultiprocessorCount, dev) != hipSuccess) { grid = -1; return; }
        if (hipFuncSetAttribute((const void*)fwd_kernel, hipFuncAttributeMaxDynamicSharedMemorySize, LDS_BYTES) != hipSuccess) { fprintf(stderr, "kernel_launch: hipFuncSetAttribute failed\n"); grid = -1; return; }
        if (hipOccupancyMaxActiveBlocksPerMultiprocessor(&per_cu, (const void*)fwd_kernel, NWAVES * 64, LDS_BYTES) != hipSuccess || per_cu < 1) fprintf(stderr, "kernel_launch: occupancy query says %d\n", per_cu);
        (void)hipGetLastError();
        grid = cus;
    }
    if (grid < 0) return;
    (void)hipMemsetAsync((char*)d_ws + WS_CTL, 0, CTL_ZERO_BYTES, stream);
    Args a{};
    for (int i = 0; i < 35; ++i) a.in[i] = (const float*)d_in[i];
    a.out = (float*)d_out; a.ws = (unsigned char*)d_ws; a.l_lo = 0; a.l_hi = NL;
    if (MK_SINGLE) { a.ph_lo = 0; a.ph_hi = N_PHASES; hipLaunchKernelGGL(fwd_kernel, dim3(grid), dim3(NWAVES * 64), LDS_BYTES, stream, a); }
    else for (int p = 0; p < N_PHASES; ++p) { a.ph_lo = p; a.ph_hi = p + 1; hipLaunchKernelGGL(fwd_kernel, dim3(grid), dim3(NWAVES * 64), LDS_BYTES, stream, a); }
}
```

```cpp
#include <hip/hip_runtime.h>
#include <cstdio>
#include <cstdint>

#ifndef MK_SINGLE
#define MK_SINGLE 1
#endif

constexpr int D = 2048, MT = 8192, NCTX = 4096, NL = 4;
constexpr int NIN = 11136, NINP = 11264, FF = 5632, NFI = 11264;
constexpr int C_NAQ = 0, C_NAK = 512, C_NAV = 1024, C_DFQ = 1536, C_DFK = 2048, C_DFV = 2560, C_RW = 3072, C_GATE = 5120;
__host__ __device__ __forceinline__ constexpr unsigned gf_off(int i, int pm, int j, int wave) { return (unsigned)((((i * 32 + pm) * 8 + j) * 8 + wave) * 16) * 1024u; }
constexpr size_t OUT_YP = 0, OUT_NAK = 16777216, OUT_NAV = 25165824, OUT_DFK = 33554432, OUT_DFV = 41943040, OUT_RF = 50331648, OUT_RB = 52428800, OUT_TOTAL = 54525952;
constexpr float LN_EPS = 1e-5f;

namespace pg8 {
#define PG8_LAS __attribute__((address_space(3)))
typedef unsigned short bf16_t;
typedef short bf16x8 __attribute__((ext_vector_type(8)));
typedef float f32x4 __attribute__((ext_vector_type(4)));
typedef unsigned u32x4 __attribute__((ext_vector_type(4)));
constexpr int BM = 256, BK = 64, HALF = 128, HTB = HALF * BK * 2  , STAGE_BYTES = 8 * HTB, NXCD = 8, WGM = 8;

__host__ __device__ __forceinline__ int lds_byte(int r, int c) { const int st = (r >> 4) * 2 + (c >> 5), rr = r & 15, cc = c & 31, ob = rr * 64 + cc * 2; return st * 1024 + (ob ^ (((ob >> 9) & 1) << 5)); }
__host__ __device__ __forceinline__ void stage_rc(int b, int& R, int& C) { const int st = b / 1024, sb = b % 1024, swz = sb ^ (((sb >> 9) & 1) << 5); R = (st >> 1) * 16 + swz / 64; C = (st & 1) * 32 + (swz % 64) / 2; }
__host__ __device__ __forceinline__ int perm32(int rho) { const int n = rho >> 4, i = rho & 15; return 8 * (i >> 2) + 4 * n + (i & 3); }

struct Unit { int pm, pn; };
struct Gemm { const bf16_t* A; const bf16_t* Bt; int M, N, K; };

struct StaticOrder {
    int nM, nN, nwg, G, c;
    __host__ __device__ void init(int M, int N, int G_, int c_) { nM = M / BM; nN = N / BM; nwg = nM * nN; G = G_; c = c_; }
    __host__ __device__ bool next(int i, Unit& u) const {
        const long L = (long)i * G + c; if (L >= nwg) return false;
        int wgid = (int)L; { const int q = nwg / NXCD, r = nwg % NXCD, xcd = wgid % NXCD, off = wgid / NXCD; wgid = (xcd < r ? xcd * (q + 1) : r * (q + 1) + (xcd - r) * q) + off; }
        const int nig = WGM * nN, gid = wgid / nig, fm = gid * WGM, gsz = (nM - fm) < WGM ? (nM - fm) : WGM;
        u.pm = fm + ((wgid % nig) % gsz); u.pn = (wgid % nig) / gsz; return true;
    }
    __device__ __forceinline__ void a_ready(const Unit&) const {}
    __device__ __forceinline__ void done(const Unit&) const {}
};

typedef __attribute__((address_space(1))) unsigned gu32_;
typedef __attribute__((address_space(1))) unsigned long long gu64_;
__host__ __device__ __forceinline__ bool f_needed(int pn) { return (pn >= 6 && pn < 10) || (pn >= 12 && pn < 20); }
constexpr unsigned RB_NEED = 12u;
struct DepOrder : StaticOrder {
    gu32_* cnt; bool lead; mutable int pend;
    __device__ __forceinline__ void flush() const { if (pend >= 0 && lead) (void)__hip_atomic_fetch_add(cnt + 64 * pend, 1u, __ATOMIC_RELAXED, __HIP_MEMORY_SCOPE_AGENT); pend = -1; }
    __device__ __forceinline__ void done(const Unit& u) const { flush(); pend = f_needed(u.pn) ? u.pm : -1; }
};

__device__ __forceinline__ unsigned cvt_pk_bf16(float lo, float hi) { typedef _Float16 h2_ __attribute__((ext_vector_type(2))); typedef float f2_ __attribute__((ext_vector_type(2))); const f2_ v = {lo, hi}; return __builtin_bit_cast(unsigned, __builtin_convertvector(v, h2_)); }
typedef float f32x2 __attribute__((ext_vector_type(2)));
typedef unsigned u32x2 __attribute__((ext_vector_type(2)));
typedef _Float16 h16x2 __attribute__((ext_vector_type(2)));
typedef _Float16 h16x8 __attribute__((ext_vector_type(8)));
__device__ __forceinline__ float bf_lo(unsigned w) { return (float)__builtin_bit_cast(h16x2, w)[0]; }
__device__ __forceinline__ float bf_hi(unsigned w) { return (float)__builtin_bit_cast(h16x2, w)[1]; }
__device__ __forceinline__ float sigm(float x) { return __builtin_amdgcn_rcpf(1.0f + __expf(-x)); }

struct EpiF {
    static constexpr bool PERM = true, AFTER_DRAIN = false;
    bf16_t* F; float* out; int layer; unsigned char* GF;
    __device__ __forceinline__ void operator()(const f32x4 (&acc)[2][2][4][2], const Unit& u, int wr, int wc, int fr, int fq) const {
        const int row0 = u.pm * BM + wr * 64 + fr, col0 = u.pn * BM + wc * 32 + 8 * fq;
        float* ob = nullptr;
        if (u.pm < 16) { const int seg = u.pn >> 1;
            if (seg == 1) ob = out + OUT_NAK; else if (seg == 2) ob = out + OUT_NAV; else if (seg == 4) ob = out + OUT_DFK; else if (seg == 5) ob = out + OUT_DFV; }
        const __amdgpu_buffer_rsrc_t frs = __builtin_amdgcn_make_buffer_rsrc(F, 0, MT * NINP * 2, 0x00020000);
        const bool gt = u.pn >= 20; const unsigned gbase = gt ? gf_off((u.pn - 20) >> 3, u.pm, (u.pn - 20) & 7, wr * 4 + wc) + (unsigned)(fr + 16 * fq) * 16u : 0u;
        const bool wt = f_needed(u.pn);
        const int cseg = (u.pn & 1) * 256 + wc * 32 + 8 * fq;
#pragma unroll
        for (int ai = 0; ai < 2; ++ai)
#pragma unroll
            for (int m = 0; m < 4; ++m) { const int row = row0 + ai * HALF + m * 16; bf16_t* rowp = F + (size_t)row * NINP + col0;
#pragma unroll
                for (int bj = 0; bj < 2; ++bj) { const f32x4 v0 = acc[ai][bj][m][0], v1 = acc[ai][bj][m][1];
                    u32x4 w; w.x = cvt_pk_bf16(v0[0], v0[1]); w.y = cvt_pk_bf16(v0[2], v0[3]); w.z = cvt_pk_bf16(v1[0], v1[1]); w.w = cvt_pk_bf16(v1[2], v1[3]);
                    if (gt) *(u32x4*)(GF + gbase + (unsigned)(ai * 8 + m * 2 + bj) * 1024u) = w;
                    else if (wt) __builtin_amdgcn_raw_buffer_store_b128(w, frs, (unsigned)(((unsigned)row * NINP + col0 + bj * HALF) * 2u), 0,   16);
                    else *(u32x4*)(rowp + bj * HALF) = w;
                    if (ob) { float* dst = ob + ((size_t)((row >> 8) * 4 + layer) * 256 + (row & 255)) * 512 + cseg + bj * HALF; *(f32x4*)dst = v0; *(f32x4*)(dst + 4) = v1; } } }
    }
};
struct EpiMerge {
    static constexpr bool PERM = true, AFTER_DRAIN = false;
    const unsigned char* GF; bf16_t* merged;
    __device__ __forceinline__ static float egate(float x) { return __expf(-fminf(fmaxf(x, -30.f), 30.f)); }
    __device__ __forceinline__ void mid(f32x4 (&acc)[2][2][4][2], const Unit& u, int i, int wr, int wc, int fr, int fq) const {
        unsigned off0 = gf_off(i, u.pm, u.pn, wr * 4 + wc) + (unsigned)(fr + 16 * fq) * 16u;
        asm volatile("" : "+v"(off0));
        u32x4 ga[2][2], gb[2][2];
        { const unsigned char* gp = GF + off0;
#pragma unroll
          for (int bj = 0; bj < 2; ++bj) { ga[0][bj] = *(const u32x4*)(gp + bj * 1024); gb[0][bj] = *(const u32x4*)(gp + gf_off(1, 0, 0, 0) + bj * 1024); } }
#pragma unroll
        for (int k = 0; k < 8; ++k) { const int ai = k >> 2, m = k & 3, cb = k & 1, nb = cb ^ 1;
            if (k < 7) { const unsigned char* gp = GF + (off0 + (unsigned)((k + 1) * 2) * 1024u);
#pragma unroll
                for (int bj = 0; bj < 2; ++bj) { ga[nb][bj] = *(const u32x4*)(gp + bj * 1024); gb[nb][bj] = *(const u32x4*)(gp + gf_off(1, 0, 0, 0) + bj * 1024); } }
            asm volatile("" ::: "memory");
#pragma unroll
            for (int bj = 0; bj < 2; ++bj) { const u32x4 xa = ga[cb][bj], xb = gb[cb][bj];
                f32x4 r0, r1;
                r0[0] = (1.f + egate(bf_lo(xb.x))) * __builtin_amdgcn_rcpf(1.f + egate(bf_lo(xa.x))); r0[1] = (1.f + egate(bf_hi(xb.x))) * __builtin_amdgcn_rcpf(1.f + egate(bf_hi(xa.x)));
                r0[2] = (1.f + egate(bf_lo(xb.y))) * __builtin_amdgcn_rcpf(1.f + egate(bf_lo(xa.y))); r0[3] = (1.f + egate(bf_hi(xb.y))) * __builtin_amdgcn_rcpf(1.f + egate(bf_hi(xa.y)));
                r1[0] = (1.f + egate(bf_lo(xb.z))) * __builtin_amdgcn_rcpf(1.f + egate(bf_lo(xa.z))); r1[1] = (1.f + egate(bf_hi(xb.z))) * __builtin_amdgcn_rcpf(1.f + egate(bf_hi(xa.z)));
                r1[2] = (1.f + egate(bf_lo(xb.w))) * __builtin_amdgcn_rcpf(1.f + egate(bf_lo(xa.w))); r1[3] = (1.f + egate(bf_hi(xb.w))) * __builtin_amdgcn_rcpf(1.f + egate(bf_hi(xa.w)));
                acc[ai][bj][m][0] *= r0; acc[ai][bj][m][1] *= r1; }
            asm volatile("" ::: "memory"); }
    }
    __device__ __forceinline__ void operator()(const f32x4 (&acc)[2][2][4][2], const Unit& u, int wr, int wc, int fr, int fq) const {
        const int row0 = u.pm * BM + wr * 64 + fr, col0 = u.pn * BM + wc * 32 + 8 * fq;
#pragma unroll
        for (int ai = 0; ai < 2; ++ai) {
            u32x4 gin[4][2];
#pragma unroll
            for (int m = 0; m < 4; ++m)
#pragma unroll
                for (int bj = 0; bj < 2; ++bj) gin[m][bj] = *(const u32x4*)(GF + gf_off(2, u.pm, u.pn, wr * 4 + wc) + (unsigned)(fr + 16 * fq) * 16u + (unsigned)(ai * 8 + m * 2 + bj) * 1024u);
#pragma unroll
            for (int m = 0; m < 4; ++m) { const int row = row0 + ai * HALF + m * 16;
#pragma unroll
                for (int bj = 0; bj < 2; ++bj) { const int col = col0 + bj * HALF;
                    const u32x4 gw = gin[m][bj];
                    f32x4 g0, g1; g0[0] = __builtin_amdgcn_rcpf(1.f + egate(bf_lo(gw.x))); g0[1] = __builtin_amdgcn_rcpf(1.f + egate(bf_hi(gw.x))); g0[2] = __builtin_amdgcn_rcpf(1.f + egate(bf_lo(gw.y))); g0[3] = __builtin_amdgcn_rcpf(1.f + egate(bf_hi(gw.y)));
                    g1[0] = __builtin_amdgcn_rcpf(1.f + egate(bf_lo(gw.z))); g1[1] = __builtin_amdgcn_rcpf(1.f + egate(bf_hi(gw.z))); g1[2] = __builtin_amdgcn_rcpf(1.f + egate(bf_lo(gw.w))); g1[3] = __builtin_amdgcn_rcpf(1.f + egate(bf_hi(gw.w)));
                    const f32x4 v0 = acc[ai][bj][m][0] * g0, v1 = acc[ai][bj][m][1] * g1;
                    u32x4 w; w.x = cvt_pk_bf16(v0[0], v0[1]); w.y = cvt_pk_bf16(v0[2], v0[3]); w.z = cvt_pk_bf16(v1[0], v1[1]); w.w = cvt_pk_bf16(v1[2], v1[3]);
                    *(u32x4*)(merged + (size_t)row * D + col) = w; } } }
    }
};
struct EpiRes {
    static constexpr bool PERM = true, AFTER_DRAIN = false;
    const bf16_t* src; const float* st; const float* gam; const float* bet; const float* gate; bf16_t* out;
    __device__ __forceinline__ void operator()(const f32x4 (&acc)[2][2][4][2], const Unit& u, int wr, int wc, int fr, int fq) const {
        const int row0 = u.pm * BM + wr * 64 + fr, col0 = u.pn * BM + wc * 32 + 8 * fq;
        const int cidx = u.pm < 16 ? 0 : 1 + ((u.pm - 16) >> 2);
        const float* gp = gate + (size_t)cidx * 12288 + col0;
        f32x2 rs[2][4];
#pragma unroll
        for (int ai = 0; ai < 2; ++ai)
#pragma unroll
            for (int m = 0; m < 4; ++m) { rs[ai][m] = (f32x2){1.f, 0.f}; if (st) rs[ai][m] = *(const f32x2*)(st + 2 * (row0 + ai * HALF + m * 16)); }
#pragma unroll
        for (int bj = 0; bj < 2; ++bj) {
            const f32x4 g0 = *(const f32x4*)(gp + bj * HALF), g1 = *(const f32x4*)(gp + bj * HALF + 4);
            const f32x4 ga0 = *(const f32x4*)(gam + col0 + bj * HALF), ga1 = *(const f32x4*)(gam + col0 + bj * HALF + 4);
            const f32x4 be0 = *(const f32x4*)(bet + col0 + bj * HALF), be1 = *(const f32x4*)(bet + col0 + bj * HALF + 4);
            u32x4 xin[2][4];
            if (bj == 1) {
#pragma unroll
                for (int ai = 0; ai < 2; ++ai)
#pragma unroll
                    for (int m = 0; m < 4; ++m) xin[ai][m] = *(const u32x4*)(src + (size_t)(row0 + ai * HALF + m * 16) * D + col0 + bj * HALF); }
#pragma unroll
            for (int ai = 0; ai < 2; ++ai) {
                if (bj == 0) {
#pragma unroll
                    for (int m = 0; m < 4; ++m) xin[ai][m] = *(const u32x4*)(src + (size_t)(row0 + ai * HALF + m * 16) * D + col0 + bj * HALF); }
#pragma unroll
                for (int m = 0; m < 4; ++m) { const size_t off = (size_t)(row0 + ai * HALF + m * 16) * D + col0 + bj * HALF;
                    const u32x4 xw = xin[ai][m]; const float r = rs[ai][m][0], mr = rs[ai][m][1];
                    const f32x4 x0 = {bf_lo(xw.x), bf_hi(xw.x), bf_lo(xw.y), bf_hi(xw.y)}, x1 = {bf_lo(xw.z), bf_hi(xw.z), bf_lo(xw.w), bf_hi(xw.w)};
                    const f32x4 v0 = (x0 * r - mr) * ga0 + be0 + g0 * acc[ai][bj][m][0], v1 = (x1 * r - mr) * ga1 + be1 + g1 * acc[ai][bj][m][1];
                    u32x4 w; w.x = cvt_pk_bf16(v0[0], v0[1]); w.y = cvt_pk_bf16(v0[2], v0[3]); w.z = cvt_pk_bf16(v1[0], v1[1]); w.w = cvt_pk_bf16(v1[2], v1[3]);
                    *(u32x4*)(out + off) = w; } }
        }
    }
};
struct EpiSwiglu {
    static constexpr bool PERM = true, AFTER_DRAIN = false;
    bf16_t* act;
    __device__ __forceinline__ void operator()(const f32x4 (&acc)[2][2][4][2], const Unit& u, int wr, int wc, int fr, int fq) const {
        const int row0 = u.pm * BM + wr * 64 + fr, col0 = u.pn * HALF + wc * 32 + 8 * fq;
#pragma unroll
        for (int ai = 0; ai < 2; ++ai)
#pragma unroll
            for (int m = 0; m < 4; ++m) { const int row = row0 + ai * HALF + m * 16;
                f32x4 r0, r1;
#pragma unroll
                for (int e = 0; e < 4; ++e) { const float g0 = acc[ai][0][m][0][e], g1 = acc[ai][0][m][1][e];
                    r0[e] = g0 * sigm(g0) * acc[ai][1][m][0][e]; r1[e] = g1 * sigm(g1) * acc[ai][1][m][1][e]; }
                u32x4 w; w.x = cvt_pk_bf16(r0[0], r0[1]); w.y = cvt_pk_bf16(r0[2], r0[3]); w.z = cvt_pk_bf16(r1[0], r1[1]); w.w = cvt_pk_bf16(r1[2], r1[3]);
                *(u32x4*)(act + (size_t)row * FF + col0) = w; }
    }
};

template <class Epi, class Sched, bool ALIGN_EPI = false, bool SP2 = false, bool HOOK = false>
__device__ __forceinline__ void gemm_phase(PG8_LAS unsigned char* lds, const Gemm g, const Sched& S, const Epi& E, const int tid) {
    const int wid = __builtin_amdgcn_readfirstlane(tid >> 6), lane = tid & 63, wr = wid >> 2, wc = wid & 3, fr = lane & 15, fq = lane >> 4;
    const int K = g.K, nt = K / BK;
    unsigned voffA[2], voffB[2];
#pragma unroll
    for (int i = 0; i < 2; ++i) { int R, C; stage_rc(tid * 16 + i * 8192, R, C); const int Rb = Epi::PERM ? ((R & ~31) + perm32(R & 31)) : R;
        voffA[i] = (unsigned)(R * K + C) * 2u; voffB[i] = (unsigned)(Rb * K + C) * 2u; }
    const size_t kstep = (size_t)(BK * 2);
    const size_t hstep = (size_t)HALF * K * 2;
    const size_t tstep = 2 * hstep;
    const unsigned ldsw = (unsigned)wid * 1024u;
    const int aoff = lds_byte(wr * 64 + fr, fq * 8), boff = lds_byte(wc * 32 + fr, fq * 8);
#define PG8_SA(b, h) (((b) * 2 + (h)) * HTB)
#define PG8_SB(b, h) ((4 + (b) * 2 + (h)) * HTB)
#define PG8_STAGE(bufoff, gbase, voff) do { _Pragma("unroll") for (int _i = 0; _i < 2; ++_i) \
        __builtin_amdgcn_global_load_lds((const unsigned*)((const char*)(gbase) + (voff)[_i]), (PG8_LAS unsigned*)(lds + (bufoff) + ldsw + _i * 8192), 16, 0, 0); } while (0)
#define PG8_LDA(dst, b, h) do { _Pragma("unroll") for (int m = 0; m < 4; ++m) _Pragma("unroll") for (int k = 0; k < 2; ++k) dst[m][k] = *(const PG8_LAS bf16x8*)(lds + PG8_SA(b, h) + aoff + m * 2048 + k * 1024); } while (0)
#define PG8_LDB(dst, b, h) do { _Pragma("unroll") for (int n = 0; n < 2; ++n) _Pragma("unroll") for (int k = 0; k < 2; ++k) dst[n][k] = *(const PG8_LAS bf16x8*)(lds + PG8_SB(b, h) + boff + n * 2048 + k * 1024); } while (0)
#define PG8_MMA(ai, bj, At, Bt) do { __builtin_amdgcn_s_setprio(1); _Pragma("unroll") for (int m = 0; m < 4; ++m) _Pragma("unroll") for (int n = 0; n < 2; ++n) _Pragma("unroll") for (int k = 0; k < 2; ++k) \
        acc[ai][bj][m][n] = __builtin_amdgcn_mfma_f32_16x16x32_f16(__builtin_bit_cast(h16x8, Bt[n][k]), __builtin_bit_cast(h16x8, At[m][k]), acc[ai][bj][m][n], 0, 0, 0); __builtin_amdgcn_s_setprio(0); } while (0)
#define PG8_WAIT_V(n) asm volatile("s_waitcnt vmcnt(" #n ")" ::: "memory")
#define PG8_WAIT_L(n) asm volatile("s_waitcnt lgkmcnt(" #n ")" ::: "memory")
#define PG8_BAR __builtin_amdgcn_s_barrier()
#define PG8_SCHED __builtin_amdgcn_sched_barrier(0)
    Unit cur, nxt; int ui = 0;
    if (!S.next(0, cur)) return;
    f32x4 acc[2][2][4][2];
#pragma unroll
    for (int a = 0; a < 2; ++a)
#pragma unroll
        for (int b = 0; b < 2; ++b)
#pragma unroll
            for (int m = 0; m < 4; ++m)
#pragma unroll
                for (int n = 0; n < 2; ++n) acc[a][b][m][n] = (f32x4){0.f, 0.f, 0.f, 0.f};
    bf16x8 At[4][2], B0[2][2], B1[2][2];
    const char* cA = (const char*)g.A + (size_t)cur.pm * tstep; const char* cB = (const char*)g.Bt + (size_t)cur.pn * tstep;
    S.a_ready(cur);
    if constexpr (SP2) {
        PG8_STAGE(PG8_SB(0, 0), cB, voffB); PG8_STAGE(PG8_SB(0, 1), cB + hstep, voffB); PG8_STAGE(PG8_SA(0, 0), cA, voffA); PG8_STAGE(PG8_SA(0, 1), cA + hstep, voffA);
        PG8_STAGE(PG8_SB(1, 0), cB + kstep, voffB); PG8_STAGE(PG8_SA(1, 0), cA + kstep, voffA); PG8_STAGE(PG8_SB(1, 1), cB + hstep + kstep, voffB);
        if (wr == 1) PG8_BAR;
        PG8_WAIT_V(8); PG8_BAR;
        PG8_WAIT_V(6); PG8_BAR;
    } else {
        PG8_STAGE(PG8_SB(0, 0), cB, voffB); PG8_STAGE(PG8_SA(0, 0), cA, voffA); PG8_STAGE(PG8_SB(0, 1), cB + hstep, voffB); PG8_STAGE(PG8_SA(0, 1), cA + hstep, voffA);
        if (wr == 1) PG8_BAR;
        PG8_WAIT_V(4); PG8_BAR;
        PG8_STAGE(PG8_SB(1, 0), cB + kstep, voffB); PG8_STAGE(PG8_SA(1, 0), cA + kstep, voffA); PG8_STAGE(PG8_SB(1, 1), cB + hstep + kstep, voffB);
        PG8_WAIT_V(6); PG8_BAR;
    }
    for (;;) {
        const bool has_next = S.next(ui + 1, nxt);
        const char* nA = has_next ? (const char*)g.A + (size_t)nxt.pm * tstep : cA; const char* nB = has_next ? (const char*)g.Bt + (size_t)nxt.pn * tstep : cB;
        for (int t = 0; t < nt; t += 2) {
            if constexpr (HOOK) { if (t == 8 || t == 16) E.mid(acc, cur, (t >> 3) - 1, wr, wc, fr, fq); }
            const bool last = (t == nt - 2);
            const char* a1 = cA + (size_t)(t + 1) * kstep;
            const char* a2 = last ? nA : cA + (size_t)(t + 2) * kstep; const char* b2 = last ? nB : cB + (size_t)(t + 2) * kstep;
            const char* a3 = a2 + kstep; const char* b3 = b2 + kstep;
            if (last && has_next) S.a_ready(nxt);
            if constexpr (SP2) {
            PG8_LDB(B0, 0, 0); PG8_LDB(B1, 0, 1); PG8_SCHED; PG8_LDA(At, 0, 0); PG8_STAGE(PG8_SA(1, 1), a1 + hstep, voffA);
            PG8_WAIT_V(8); PG8_WAIT_L(0); PG8_BAR; PG8_MMA(0, 0, At, B0); PG8_MMA(0, 1, At, B1); PG8_BAR; PG8_SCHED;
            PG8_LDA(At, 0, 1); PG8_STAGE(PG8_SB(0, 0), b2, voffB); PG8_STAGE(PG8_SB(0, 1), b2 + hstep, voffB); PG8_STAGE(PG8_SA(0, 0), a2, voffA);
            PG8_WAIT_V(8); PG8_WAIT_L(0); PG8_BAR; PG8_MMA(1, 0, At, B0); PG8_MMA(1, 1, At, B1); PG8_BAR; PG8_SCHED;
            PG8_LDB(B0, 1, 0); PG8_LDB(B1, 1, 1); PG8_SCHED; PG8_LDA(At, 1, 0); PG8_STAGE(PG8_SA(0, 1), a2 + hstep, voffA);
            PG8_WAIT_V(8); PG8_WAIT_L(0); PG8_BAR; PG8_MMA(0, 0, At, B0); PG8_MMA(0, 1, At, B1); PG8_BAR; PG8_SCHED;
            PG8_LDA(At, 1, 1); PG8_STAGE(PG8_SB(1, 0), b3, voffB); PG8_STAGE(PG8_SB(1, 1), b3 + hstep, voffB); PG8_STAGE(PG8_SA(1, 0), a3, voffA);
            PG8_WAIT_V(8); PG8_WAIT_L(0); PG8_BAR; PG8_MMA(1, 0, At, B0); PG8_MMA(1, 1, At, B1); PG8_BAR; PG8_SCHED;
            } else {
            PG8_LDB(B0, 0, 0); PG8_SCHED; PG8_LDA(At, 0, 0); PG8_STAGE(PG8_SA(1, 1), a1 + hstep, voffA);
            PG8_WAIT_L(8); PG8_BAR; PG8_WAIT_L(0); PG8_MMA(0, 0, At, B0); PG8_BAR; PG8_SCHED;
            PG8_LDB(B1, 0, 1); PG8_STAGE(PG8_SB(0, 0), b2, voffB);
            PG8_BAR; PG8_WAIT_L(0); PG8_MMA(0, 1, At, B1); PG8_BAR;
            PG8_LDA(At, 0, 1); PG8_STAGE(PG8_SA(0, 0), a2, voffA);
            PG8_BAR; PG8_WAIT_L(0); PG8_MMA(1, 0, At, B0); PG8_BAR; PG8_SCHED;
            PG8_STAGE(PG8_SB(0, 1), b2 + hstep, voffB);
            PG8_WAIT_V(6); PG8_BAR; PG8_MMA(1, 1, At, B1); PG8_BAR;
            PG8_LDB(B0, 1, 0); PG8_SCHED; PG8_LDA(At, 1, 0); PG8_STAGE(PG8_SA(0, 1), a2 + hstep, voffA);
            PG8_WAIT_L(8); PG8_BAR; PG8_WAIT_L(0); PG8_MMA(0, 0, At, B0); PG8_BAR; PG8_SCHED;
            PG8_LDB(B1, 1, 1); PG8_STAGE(PG8_SB(1, 0), b3, voffB);
            PG8_BAR; PG8_WAIT_L(0); PG8_MMA(0, 1, At, B1); PG8_BAR;
            PG8_LDA(At, 1, 1); PG8_STAGE(PG8_SA(1, 0), a3, voffA);
            PG8_BAR; PG8_WAIT_L(0); PG8_MMA(1, 0, At, B0); PG8_BAR; PG8_SCHED;
            PG8_STAGE(PG8_SB(1, 1), b3 + hstep, voffB);
            PG8_WAIT_V(6); PG8_BAR; PG8_MMA(1, 1, At, B1); PG8_BAR;
            }
        }
        if constexpr (ALIGN_EPI) { if (wr == 0) PG8_BAR; }
        if constexpr (!Epi::AFTER_DRAIN) { E(acc, cur, wr, wc, fr, fq); S.done(cur); }
        if (!has_next) break;
#pragma unroll
        for (int a = 0; a < 2; ++a)
#pragma unroll
            for (int b = 0; b < 2; ++b)
#pragma unroll
                for (int m = 0; m < 4; ++m)
#pragma unroll
                    for (int n = 0; n < 2; ++n) acc[a][b][m][n] = (f32x4){0.f, 0.f, 0.f, 0.f};
        cur = nxt; cA = nA; cB = nB; ++ui;
        if constexpr (ALIGN_EPI) { if (wr == 1) PG8_BAR; }
    }
    PG8_WAIT_V(0);
    if constexpr (!ALIGN_EPI) { if (wr == 0) PG8_BAR; }
    PG8_BAR;
    if constexpr (Epi::AFTER_DRAIN) { E.fused(acc, cur, wr, wc, fr, fq, lds, wid, lane); S.done(cur); }
#undef PG8_SA
#undef PG8_SB
#undef PG8_STAGE
#undef PG8_LDA
#undef PG8_LDB
#undef PG8_MMA
#undef PG8_WAIT_V
#undef PG8_WAIT_L
#undef PG8_BAR
#undef PG8_SCHED
}
}

#define GAS __attribute__((address_space(1)))
#define LAS __attribute__((address_space(3)))
typedef unsigned short bf16;
typedef unsigned v4u __attribute__((ext_vector_type(4)));
typedef float f32x4 __attribute__((ext_vector_type(4)));
typedef short bf16x8 __attribute__((ext_vector_type(8)));
typedef GAS unsigned gu32;
typedef GAS unsigned long long gu64;
#define RLX_AGENT __ATOMIC_RELAXED, __HIP_MEMORY_SCOPE_AGENT
#define LDS_WAIT() asm volatile("s_waitcnt lgkmcnt(0)" ::: "memory")
#define VM_WAIT() asm volatile("s_waitcnt vmcnt(0)" ::: "memory")
__device__ __forceinline__ unsigned long long rt() { return __builtin_amdgcn_s_memrealtime(); }
__device__ __forceinline__ unsigned f2bf(float f) { unsigned u = __builtin_bit_cast(unsigned, f); return (u + 0x7fffu + ((u >> 16) & 1u)) >> 16; }
__device__ __forceinline__ unsigned pk2(float lo, float hi) { return f2bf(lo) | (f2bf(hi) << 16); }

#define XB_TMO      128
#define XB_XCNT(j)  (256  + 64 * (j))
#define XB_XSUB(j)  (1280 + 64 * (j))
#define XB_XGEN(j)  (2304 + 64 * (j))
#define XB_TOP      3328
#define XB_TOPGEN   3392
#define XCD_BAR_WORDS 3456
#define XB_SPIN_CAP (1u << 18)

__device__ __forceinline__ unsigned xb_ld(unsigned* p)              { return __hip_atomic_load(p, __ATOMIC_RELAXED, __HIP_MEMORY_SCOPE_AGENT); }
__device__ __forceinline__ unsigned xb_add(unsigned* p, unsigned v) { return __hip_atomic_fetch_add(p, v, __ATOMIC_RELAXED, __HIP_MEMORY_SCOPE_AGENT); }
__device__ __forceinline__ unsigned xb_xcc_id() { return (unsigned)__builtin_amdgcn_s_getreg((3 << 11) | 20) & 0xFu; }
#define XB_SPIN(cond, bar) do { unsigned _sp = 0; while (cond) { __builtin_amdgcn_s_sleep(1); \
    if ((++_sp & 255u) == 0u) { if (xb_ld(&(bar)[XB_TMO])) break; if (_sp > XB_SPIN_CAP) { atomicAdd(&(bar)[XB_TMO], 1u); break; } } } } while (0)

struct XcdBarrier {
    unsigned* bar; unsigned x;
    volatile LAS unsigned* st;
};

__device__ __forceinline__ XcdBarrier xcd_barrier_post(unsigned* bar, volatile LAS unsigned* st) {
    XcdBarrier b; b.bar = bar; b.x = xb_xcc_id(); b.st = st;
    if (threadIdx.x == 0) (void)xb_add(&bar[XB_XCNT(b.x)], 1u);
    return b;
}
__device__ __forceinline__ void xcd_barrier_complete(unsigned* bar, unsigned x, unsigned& nloc, unsigned& nx) {
    const unsigned G = gridDim.x * gridDim.y * gridDim.z;
    unsigned sum, cnt, mine, sp = 0u;
    for (;;) {
        sum = 0u; cnt = 0u; mine = 0u;
#pragma unroll
        for (unsigned j = 0; j < 16; ++j) { const unsigned c = xb_ld(&bar[XB_XCNT(j)]); sum += c; cnt += (c > 0u) ? 1u : 0u; mine = (j == x) ? c : mine; }
        if (sum == G) break;
        __builtin_amdgcn_s_sleep(1);
        if ((++sp & 255u) == 0u) { if (xb_ld(&bar[XB_TMO])) break; if (sp > XB_SPIN_CAP) { atomicAdd(&bar[XB_TMO], 1u); break; } }
    }
    nloc = mine > 0u ? mine : 1u; nx = cnt > 0u ? cnt : 1u;
}

__device__ __forceinline__ void xcd_barrier(const XcdBarrier& b) {
    asm volatile("s_waitcnt vmcnt(0)" ::: "memory");
    __syncthreads();
    if (threadIdx.x == 0) {
        unsigned* bar = b.bar;
        __builtin_amdgcn_s_waitcnt(0);
        unsigned nloc = b.st[0], nx = b.st[1];
        if (nloc == 0u) { xcd_barrier_complete(bar, b.x, nloc, nx); b.st[0] = nloc; b.st[1] = nx; }
        const unsigned old = xb_add(&bar[XB_XSUB(b.x)], 1u);
        const unsigned gen = old / nloc;
        if (old + 1u == (gen + 1u) * nloc) {
            __builtin_amdgcn_fence(__ATOMIC_RELEASE, "agent");
            asm volatile("s_waitcnt vmcnt(0)" ::: "memory");
            const unsigned og = xb_add(&bar[XB_TOP], 1u);
            const unsigned tg = og / nx;
            if (og + 1u == (tg + 1u) * nx) xb_add(&bar[XB_TOPGEN], 1u);
            else XB_SPIN(xb_ld(&bar[XB_TOPGEN]) == tg, bar);
            __builtin_amdgcn_fence(__ATOMIC_ACQUIRE, "agent");
            xb_add(&bar[XB_XGEN(b.x)], 1u);
            asm volatile("s_waitcnt vmcnt(0)" ::: "memory");
        } else {
            XB_SPIN(xb_ld(&bar[XB_XGEN(b.x)]) == gen, bar);
            __builtin_amdgcn_fence(__ATOMIC_ACQUIRE, "agent");
            asm volatile("s_waitcnt vmcnt(0)" ::: "memory");
        }
    }
    __syncthreads();
}

constexpr float DN_ALPHA = 1.681792830507429f;
constexpr size_t MiB = 1u << 20;
constexpr size_t WS_CTL = 0, CTL_ZERO_BYTES = 1 * MiB;
constexpr size_t WS_MOD = 1 * MiB;
constexpr size_t WS_LAM = 2 * MiB, WS_ROPE = 2 * MiB + 4096, WS_W2T = 2 * MiB + 65536, WS_A2T = WS_W2T + 524288, WS_G2T = WS_A2T + 524288;
constexpr size_t WS_CKNA = 4 * MiB, WS_CVNA = 8 * MiB, WS_CKDF = 12 * MiB, WS_CVDF = 16 * MiB;
constexpr size_t WS_WIN = 20 * MiB, WS_WBR = 196 * MiB, WS_WO = 220 * MiB, WS_WFI = 252 * MiB, WS_WFO = 428 * MiB;
constexpr size_t WS_H = 516 * MiB;
constexpr size_t WS_F = 548 * MiB;
constexpr size_t WS_O3 = 724 * MiB;
constexpr size_t WS_MBUF = 748 * MiB;
constexpr size_t WS_MERGED = 812 * MiB;
constexpr size_t WS_X = 844 * MiB;
constexpr size_t WS_ST1 = 876 * MiB, WS_ST2 = 877 * MiB;
constexpr size_t WS_GB = 878 * MiB;
constexpr size_t WS_GF = 920 * MiB;
constexpr size_t WS_SI = 908 * MiB;
constexpr size_t WS_Y = 1100 * MiB;
constexpr size_t WS_G = 1132 * MiB;
constexpr size_t WS_BON = 1148 * MiB;
constexpr size_t WS_QR = 1149 * MiB, WS_KR = 1153 * MiB;
constexpr size_t WS_END = 1245 * MiB;
constexpr int CW_BAR = 4096, CW_MIXQ = 16384, CW_RB = 32768, CW_PREQ = 49152;

constexpr int RING_BYTES = 131072, MISC_OFF = RING_BYTES + 320, LDS_BYTES = 147456;
constexpr int NWAVES = 8;

struct Args { const float* in[35]; float* out; unsigned char* ws; int l_lo, l_hi, ph_lo, ph_hi; };
#define CAS __attribute__((address_space(4)))
typedef const CAS Args& ArgsRef;

typedef unsigned v2u __attribute__((ext_vector_type(2)));
typedef short s16x4 __attribute__((ext_vector_type(4)));
typedef short v4i16_t __attribute__((ext_vector_type(4)));
using pg8::cvt_pk_bf16; using pg8::bf_lo; using pg8::bf_hi; using pg8::sigm;

__device__ __forceinline__ bf16 f2h(float v) { return __builtin_bit_cast(unsigned short, (_Float16)v); }
template <int CTRL> __device__ __forceinline__ float dpp(float x) { return __builtin_bit_cast(float, __builtin_amdgcn_mov_dpp(__builtin_bit_cast(int, x), CTRL, 0xf, 0xf, true)); }
template <int CTRL> __device__ __forceinline__ float dppf(float x) { return __builtin_bit_cast(float, __builtin_amdgcn_update_dpp(0x3f800000, __builtin_bit_cast(int, x), CTRL, 0xf, 0xf, false)); }
__device__ __forceinline__ float red8(float x) { x += dpp<0xB1>(x); x += dpp<0x4E>(x); x += dpp<0x141>(x); return x; }
__device__ __forceinline__ float xrow16_max(float x) { x = fmaxf(x, __shfl_xor(x, 16)); x = fmaxf(x, __shfl_xor(x, 32)); return x; }
__device__ __forceinline__ float xrow16_sum(float x) { x += __shfl_xor(x, 16); x += __shfl_xor(x, 32); return x; }
__device__ __forceinline__ float wave_sum(float v) {
#pragma unroll
    for (int o = 1; o < 64; o <<= 1) v += __shfl_xor(v, o);
    return v;
}
__device__ __forceinline__ s16x4 vtr(const LAS unsigned char* p) { return __builtin_bit_cast(s16x4, __builtin_amdgcn_ds_read_tr16_b64_v4i16((LAS v4i16_t*)p)); }
__device__ __forceinline__ f32x4 mfma16(bf16x8 a, bf16x8 b, f32x4 c) { return __builtin_amdgcn_mfma_f32_16x16x32_f16(__builtin_bit_cast(pg8::h16x8, a), __builtin_bit_cast(pg8::h16x8, b), c, 0, 0, 0); }

__device__ __forceinline__ void phase_ada(ArgsRef a, unsigned char* ws, LAS unsigned char* lds, int tid, int bid, int G) {
    LAS float* sc = (LAS float*)lds;
    LAS float* red = sc + 5 * 2048;
    const float* cvec = a.in[8]; const float* cctx = a.in[9];
    for (int i = tid; i < 5 * 2048; i += 512) { const int c = i >> 11, k = i & 2047; const float v = c == 0 ? cctx[k] : cvec[(c - 1) * 2048 + k]; sc[i] = v / (1.0f + expf(-v)); }
    __syncthreads();
    const int wave = tid >> 6, lane = tid & 63;
    float* MOD = (float*)(ws + WS_MOD);
    for (int unit = bid; unit < NL * 96; unit += G) {
        const int l = unit / 96, n0 = (unit % 96) * 128;
        const float* W = a.in[10] + (size_t)l * 2048 * 12288 + n0 + 2 * lane;
        float acc[5][2];
#pragma unroll
        for (int c = 0; c < 5; ++c) { acc[c][0] = 0.f; acc[c][1] = 0.f; }
        const int k0 = wave * 256;
        for (int kk = 0; kk < 256; kk += 8) {
            pg8::f32x2 w[8];
#pragma unroll
            for (int j = 0; j < 8; ++j) w[j] = *(const pg8::f32x2*)(W + (size_t)(k0 + kk + j) * 12288);
#pragma unroll
            for (int j = 0; j < 8; ++j)
#pragma unroll
                for (int c = 0; c < 5; ++c) { const float s = sc[c * 2048 + k0 + kk + j]; acc[c][0] += s * w[j].x; acc[c][1] += s * w[j].y; }
        }
#pragma unroll
        for (int c = 0; c < 5; ++c) { red[(wave * 5 + c) * 128 + 2 * lane] = acc[c][0]; red[(wave * 5 + c) * 128 + 2 * lane + 1] = acc[c][1]; }
        __syncthreads();
        for (int i = tid; i < 5 * 128; i += 512) { const int c = i >> 7, n = i & 127; float s = 0.f;
#pragma unroll
            for (int w = 0; w < 8; ++w) s += red[(w * 5 + c) * 128 + n];
            MOD[((size_t)l * 5 + c) * 12288 + n0 + n] = s + a.in[11][(size_t)l * 12288 + n0 + n]; }
        __syncthreads();
    }
}

__device__ __forceinline__ void transpose_item(const float* W, int K, int N, bf16* WT, int k0, int n0, int drow0, LAS float* scr, int lane, int ldk = 0) {
    if (ldk == 0) ldk = K;
    { f32x4 r[8];
#pragma unroll
      for (int i = 0; i < 8; ++i) r[i] = *(const f32x4*)(W + (size_t)(k0 + 8 * i + (lane >> 3)) * N + n0 + 4 * (lane & 7));
#pragma unroll
      for (int i = 0; i < 8; ++i) { LAS float* d = scr + (8 * i + (lane >> 3)) * 33 + 4 * (lane & 7); d[0] = r[i][0]; d[1] = r[i][1]; d[2] = r[i][2]; d[3] = r[i][3]; } }
    LDS_WAIT(); asm volatile("" ::: "memory");
    const int c = lane & 7;
#pragma unroll
    for (int j = 0; j < 4; ++j) { const int n = (lane >> 3) + 8 * j; const LAS float* s = scr + (8 * c) * 33 + n;
        v4u o; o.x = cvt_pk_bf16(s[0 * 33], s[1 * 33]); o.y = cvt_pk_bf16(s[2 * 33], s[3 * 33]); o.z = cvt_pk_bf16(s[4 * 33], s[5 * 33]); o.w = cvt_pk_bf16(s[6 * 33], s[7 * 33]);
        *(v4u*)(WT + (size_t)(drow0 + n) * ldk + k0 + 8 * c) = o; }
    LDS_WAIT(); asm volatile("" ::: "memory");
}
constexpr int IT_WIN = 32 * 348, IT_WBR = 3 * 8 * 64, IT_WO = 32 * 64, IT_WFI = 32 * 352, IT_WFO = 88 * 64, IT_LAYER = IT_WIN + IT_WBR + IT_WO + IT_WFI + IT_WFO;
__device__ __forceinline__ void phase_cvt(ArgsRef a, unsigned char* ws, LAS unsigned char* lds, int tid, int bid, int G) {
    const int wave = tid >> 6, lane = tid & 63;
    LAS float* scr = (LAS float*)(lds + wave * 16384);
    const int gw = bid * NWAVES + wave, NGW = G * NWAVES;
    constexpr int IT_ALL = NL * IT_LAYER, IT_EVEN = 56 * 2048;
    const bool skew = (G == 256);
    for (int it = gw, st2 = 0; ; ) {
        if (!skew) { if (it >= IT_ALL) break; }
        else if (!st2) { if (it >= IT_EVEN) { st2 = 1; if (bid < 128) break; it = IT_EVEN + (gw - 1024); continue; } }
        else if (it >= IT_ALL) break;
        const int it_next = it + ((skew && st2) ? 1024 : NGW);
        const int l = it / IT_LAYER; int r = it - l * IT_LAYER;
        if (r < IT_WIN) { const int kb = r / 348, nb = r - kb * 348, n0 = 32 * nb;
            transpose_item(a.in[12] + (size_t)l * D * NIN, D, NIN, (bf16*)(ws + WS_WIN) + (size_t)l * NINP * D, 64 * kb, n0, n0 + (n0 >= 4992 ? 128 : 0), scr, lane); it = it_next; continue; }
        r -= IT_WIN;
        if (r < IT_WBR) { const int i = r >> 9, rr = r & 511, kb = rr >> 6, nb = rr & 63;
            transpose_item(a.in[27] + (size_t)(l * 3 + i) * 512 * D, 512, D, (bf16*)(ws + WS_WBR) + (size_t)l * D * 1536 + i * 512, 64 * kb, 32 * nb, 32 * nb, scr, lane, 1536); it = it_next; continue; }
        r -= IT_WBR;
        if (r < IT_WO) { const int kb = r >> 6, nb = r & 63;
            transpose_item(a.in[28] + (size_t)l * D * D, D, D, (bf16*)(ws + WS_WO) + (size_t)l * D * D, 64 * kb, 32 * nb, 32 * nb, scr, lane); it = it_next; continue; }
        r -= IT_WO;
        if (r < IT_WFI) { const int kb = r / 352, nb = r - kb * 352, n0 = 32 * nb;
            const int dr = n0 < FF ? (n0 >> 7) * 256 + (n0 & 127) : ((n0 - FF) >> 7) * 256 + 128 + ((n0 - FF) & 127);
            transpose_item(a.in[31] + (size_t)l * D * NFI, D, NFI, (bf16*)(ws + WS_WFI) + (size_t)l * NFI * D, 64 * kb, n0, dr, scr, lane); it = it_next; continue; }
        r -= IT_WFI;
        { const int kb = r >> 6, nb = r & 63;
            transpose_item(a.in[32] + (size_t)l * FF * D, FF, D, (bf16*)(ws + WS_WFO) + (size_t)l * D * FF, 64 * kb, 32 * nb, 32 * nb, scr, lane); }
        it = it_next;
    }
    const int gt = bid * 512 + tid, NGT = G * 512;
    for (int i = gt; i < 4 * 262144; i += NGT) { const int t = i >> 18, e = (i & 262143) * 8;
        const float* src = a.in[2 + t] + e; const f32x4 x0 = *(const f32x4*)src, x1 = *(const f32x4*)(src + 4);
        v4u o; o.x = cvt_pk_bf16(x0[0], x0[1]); o.y = cvt_pk_bf16(x0[2], x0[3]); o.z = cvt_pk_bf16(x1[0], x1[1]); o.w = cvt_pk_bf16(x1[2], x1[3]);
        *(v4u*)((bf16*)(ws + WS_CKNA + (size_t)t * 4 * MiB) + e) = o; }
    for (int i = gt; i < 3 * 262144; i += NGT) { const int t = i >> 18, e = i & 262143;
        if (t < 2) { const int j = e & 63, c = (e >> 6) & 511, ld = e >> 15;
            const float v = a.in[t == 0 ? 18 : 20][((size_t)ld * 64 + j) * 512 + c];
            ((bf16*)(ws + (t == 0 ? WS_W2T : WS_A2T)))[e] = f2h(v); }
        else { const int j = e & 127, c = (e >> 7) & 511, l = e >> 16;
            ((bf16*)(ws + WS_G2T))[e] = f2h(a.in[21][((size_t)l * 128 + j) * 512 + c]); } }
    for (int i = gt; i < 64 * 16; i += NGT) { const int pos = i >> 4, f = i & 15; const float inv = powf(10000.0f, -(float)f / 16.0f); const float ang = (float)pos * inv;
        float* rp = (float*)(ws + WS_ROPE) + 2 * i; rp[0] = cosf(ang); rp[1] = sinf(ang); }
    for (int i = gt; i < 9 * D; i += NGT) { const int k = i / D, c = i - k * D; float gv = 1.f, bv = 0.f;
        if (k > 0) { const int l = (k - 1) >> 1; if ((k - 1) & 1) { gv = a.in[33][l * D + c]; bv = a.in[34][l * D + c]; } else { gv = a.in[29][l * D + c]; bv = a.in[30][l * D + c]; } }
        float* gb = (float*)(ws + WS_GB) + (size_t)k * 2 * D; gb[c] = DN_ALPHA * gv; gb[D + c] = DN_ALPHA * bv; }
    if (gw < NL) { const float* lp = a.in[14] + gw * 256; const float s1 = wave_sum(lp[lane] * lp[64 + lane]), s2 = wave_sum(lp[128 + lane] * lp[192 + lane]);
        const float li = gw == 0 ? 0.2f : gw == 1 ? 0.355509067590969f : gw == 2 ? 0.470713018343584f : 0.556058204155641f;
        if (lane == 0) ((float*)(ws + WS_LAM))[gw] = expf(s1) - expf(s2) + li; }
}
__device__ __forceinline__ float lam_init_of(int l) { return l == 0 ? 0.2f : l == 1 ? 0.355509067590969f : l == 2 ? 0.470713018343584f : 0.556058204155641f; }

template <int MODE> __device__ __forceinline__ void phase_ln(ArgsRef a, unsigned char* ws, int l, int gw, int NGW, int lane) {
    const float* MODp = (const float*)(ws + WS_MOD);
    bf16* X = (bf16*)(ws + WS_X); bf16* H = (bf16*)(ws + WS_H);
    const float* lg = MODE == 1 ? a.in[29] + l * D : a.in[33] + l * D; const float* lb = MODE == 1 ? a.in[30] + l * D : a.in[34] + l * D;
    const int ml = MODE == 2 ? l + 1 : l, mi = MODE == 1 ? 3 : 0;
    for (int row = gw; row < MT; row += NGW) {
        f32x4 v[8]; float s = 0.f;
        if (MODE == 0) { const float* src = (row < NCTX ? a.in[0] + (size_t)row * D : a.in[1] + (size_t)(row - NCTX) * D) + 8 * lane;
#pragma unroll
            for (int j = 0; j < 4; ++j) { v[2 * j] = *(const f32x4*)(src + 512 * j); v[2 * j + 1] = *(const f32x4*)(src + 512 * j + 4); } }
        else { const bf16* src = (const bf16*)(ws + WS_MBUF) + (size_t)row * D + 8 * lane;
#pragma unroll
            for (int j = 0; j < 4; ++j) { const v4u w = *(const v4u*)(src + 512 * j);
                v[2 * j] = (f32x4){bf_lo(w.x), bf_hi(w.x), bf_lo(w.y), bf_hi(w.y)}; v[2 * j + 1] = (f32x4){bf_lo(w.z), bf_hi(w.z), bf_lo(w.w), bf_hi(w.w)}; } }
#pragma unroll
        for (int j = 0; j < 8; ++j) s += (v[j][0] + v[j][1]) + (v[j][2] + v[j][3]);
        if (MODE != 0) {
            const float mean = wave_sum(s) * (1.f / D); float s2 = 0.f;
#pragma unroll
            for (int j = 0; j < 8; ++j) { v[j] = v[j] - mean; s2 += (v[j][0] * v[j][0] + v[j][1] * v[j][1]) + (v[j][2] * v[j][2] + v[j][3] * v[j][3]); }
            const float rstd = __builtin_amdgcn_rsqf(wave_sum(s2) * (1.f / D) + LN_EPS);
            if (MODE != 3 && lane == 0) *(pg8::f32x2*)((float*)(ws + (MODE == 1 ? WS_ST1 : WS_ST2)) + 2 * row) = (pg8::f32x2){rstd, mean * rstd};
            s = 0.f;
#pragma unroll
            for (int j = 0; j < 8; ++j) { const int co = 8 * lane + 512 * (j >> 1) + 4 * (j & 1); const f32x4 gg = *(const f32x4*)(lg + co), bb = *(const f32x4*)(lb + co);
                v[j] = v[j] * rstd * gg + bb; s += (v[j][0] + v[j][1]) + (v[j][2] + v[j][3]); }
        }
        if (MODE == 3) { float* xo = a.out + (size_t)row * D + 8 * lane;
#pragma unroll
            for (int j = 0; j < 4; ++j) { *(f32x4*)(xo + 512 * j) = v[2 * j]; *(f32x4*)(xo + 512 * j + 4) = v[2 * j + 1]; } }
        else if (MODE == 0) { bf16* xo = X + (size_t)row * D + 8 * lane;
#pragma unroll
            for (int j = 0; j < 4; ++j) { v4u w; w.x = cvt_pk_bf16(v[2 * j][0], v[2 * j][1]); w.y = cvt_pk_bf16(v[2 * j][2], v[2 * j][3]); w.z = cvt_pk_bf16(v[2 * j + 1][0], v[2 * j + 1][1]); w.w = cvt_pk_bf16(v[2 * j + 1][2], v[2 * j + 1][3]);
                *(v4u*)(xo + 512 * j) = w; } }
        if (MODE != 3) {
            const float mean = wave_sum(s) * (1.f / D); float s2 = 0.f;
#pragma unroll
            for (int j = 0; j < 8; ++j) { v[j] = v[j] - mean; s2 += (v[j][0] * v[j][0] + v[j][1] * v[j][1]) + (v[j][2] * v[j][2] + v[j][3] * v[j][3]); }
            const float rstd = __builtin_amdgcn_rsqf(wave_sum(s2) * (1.f / D) + LN_EPS);
            const int cidx = row < NCTX ? 0 : 1 + ((row - NCTX) >> 10);
            const float* shp = MODp + ((size_t)ml * 5 + cidx) * 12288 + mi * D; const float* scp = shp + D;
            bf16* ho = H + (size_t)row * D + 8 * lane;
#pragma unroll
            for (int j = 0; j < 4; ++j) { const int co = 8 * lane + 512 * j;
                const f32x4 h0 = v[2 * j] * rstd * (*(const f32x4*)(scp + co) + 1.0f) + *(const f32x4*)(shp + co), h1 = v[2 * j + 1] * rstd * (*(const f32x4*)(scp + co + 4) + 1.0f) + *(const f32x4*)(shp + co + 4);
                v4u w; w.x = cvt_pk_bf16(h0[0], h0[1]); w.y = cvt_pk_bf16(h0[2], h0[3]); w.z = cvt_pk_bf16(h1[0], h1[1]); w.w = cvt_pk_bf16(h1[2], h1[3]);
                *(v4u*)(ho + 512 * j) = w; }
        }
    }
}

__device__ __forceinline__ void shift8(const bf16* F, unsigned fo, bool hp, bool hn, const float* mix, unsigned mo, float (&o)[8]) {
    const v4u c = *(const v4u*)(F + fo); v4u p = {0u, 0u, 0u, 0u}, n = {0u, 0u, 0u, 0u};
    if (hp) p = *(const v4u*)(F + (fo - NINP)); if (hn) n = *(const v4u*)(F + (fo + NINP));
    const f32x4 m0a = *(const f32x4*)(mix + mo), m0b = *(const f32x4*)(mix + (mo + 4)), m1a = *(const f32x4*)(mix + (mo + 1920)), m1b = *(const f32x4*)(mix + (mo + 1924));
#pragma unroll
    for (int w = 0; w < 4; ++w) { const unsigned cw = c[w], pw = p[w], nw = n[w];
        const float f0 = bf_lo(cw), f1 = bf_hi(cw); const float m00 = w < 2 ? m0a[2 * w] : m0b[2 * w - 4], m01 = w < 2 ? m0a[2 * w + 1] : m0b[2 * w - 3];
        const float m10 = w < 2 ? m1a[2 * w] : m1b[2 * w - 4], m11 = w < 2 ? m1a[2 * w + 1] : m1b[2 * w - 3];
        o[2 * w] = f0 + m00 * (bf_lo(pw) - f0) + m10 * (bf_lo(nw) - f0); o[2 * w + 1] = f1 + m01 * (bf_hi(pw) - f1) + m11 * (bf_hi(nw) - f1); }
}
__device__ __forceinline__ f32x4 shift4(const bf16* F, unsigned fo, bool hp, bool hn, const float* mix, unsigned mo) {
    const v2u c = *(const v2u*)(F + fo); v2u p = {0u, 0u}, n = {0u, 0u};
    if (hp) p = *(const v2u*)(F + (fo - NINP)); if (hn) n = *(const v2u*)(F + (fo + NINP));
    const f32x4 m0 = *(const f32x4*)(mix + mo), m1 = *(const f32x4*)(mix + (mo + 1920));
    f32x4 f, pv, nv; f[0] = bf_lo(c.x); f[1] = bf_hi(c.x); f[2] = bf_lo(c.y); f[3] = bf_hi(c.y);
    pv[0] = bf_lo(p.x); pv[1] = bf_hi(p.x); pv[2] = bf_lo(p.y); pv[3] = bf_hi(p.y); nv[0] = bf_lo(n.x); nv[1] = bf_hi(n.x); nv[2] = bf_lo(n.y); nv[3] = bf_hi(n.y);
    return f + m0 * (pv - f) + m1 * (nv - f);
}
__device__ __forceinline__ float ftanh(float x) { return 1.0f - 2.0f * __builtin_amdgcn_rcpf(1.0f + __expf(2.0f * x)); }
__device__ __forceinline__ bf16x8 pack8(const float (&o)[8]) { v4u w; w.x = cvt_pk_bf16(o[0], o[1]); w.y = cvt_pk_bf16(o[2], o[3]); w.z = cvt_pk_bf16(o[4], o[5]); w.w = cvt_pk_bf16(o[6], o[7]); return __builtin_bit_cast(bf16x8, w); }
__device__ __forceinline__ float logsigmoid(float z) { const float e = __expf(-fabsf(z)); return fminf(z, 0.f) - __logf(1.0f + e); }

__device__ __forceinline__ void phase_pre(ArgsRef a, unsigned char* ws, int l, int gw, int NGW, int lane) {
    const bf16* F = (const bf16*)(ws + WS_F);
    const float* mix = a.in[16] + (size_t)l * 2 * 1920;
    const float* w0 = a.in[17] + l * 1024; const float* a0 = a.in[19] + l * 1024;
    const float* kkw = a.in[22] + l * 512; const float* kaw = a.in[23] + l * 512; const float* rkw = a.in[24] + l * 512;
    const bf16* W2T = (const bf16*)(ws + WS_W2T) + (size_t)l * 2 * 512 * 64; const bf16* A2T = (const bf16*)(ws + WS_A2T) + (size_t)l * 2 * 512 * 64;
    const bf16* G2T = (const bf16*)(ws + WS_G2T) + (size_t)l * 512 * 128;
    float* SI = (float*)(ws + WS_SI); float* Gb = (float*)(ws + WS_G); float* BON = (float*)(ws + WS_BON);
    for (int u = 4096 + gw; u < 4096 + 8192; u += NGW) {
        int q = lane & 15, g = lane >> 4; asm volatile("" : "+v"(q), "+v"(g));
        if (u < 4096) {
            const int tile = u >> 3, hh = u & 7, row = tile * 16 + q;
            const int T = row < NCTX ? 256 : 1024, pos = row & (T - 1); const bool hp = pos > 0, hn = pos < T - 1;
            const unsigned fo = (unsigned)row * NINP + C_RW;
            float t8[8]; f32x4 af[4], ab[4];
            const unsigned ao = (unsigned)(hh * 64 + q) * 64 + 8 * g, go = (unsigned)(hh * 64 + q) * 128 + 8 * g;
            const unsigned c40 = hh * 64 + 4 * g;
            const unsigned so = ((unsigned)hh * MT + row) * 384 + 4 * g;
#pragma unroll
            for (int d = 0; d < 2; ++d) { f32x4 acc[4];
#pragma unroll
                for (int rb = 0; rb < 4; ++rb) acc[rb] = (f32x4){0.f, 0.f, 0.f, 0.f};
#pragma unroll
                for (int ks = 0; ks < 2; ++ks) { const unsigned cb = 32 * ks + 8 * g; shift8(F, fo + 1536 + 64 * d + cb, hp, hn, mix, 1536 + 64 * d + cb, t8);
#pragma unroll
                    for (int e = 0; e < 8; ++e) t8[e] = ftanh(t8[e]);
                    const bf16x8 bop = pack8(t8);
#pragma unroll
                    for (int rb = 0; rb < 4; ++rb) acc[rb] = mfma16(*(const bf16x8*)(W2T + (ao + 32768 * d + 1024 * rb + 32 * ks)), bop, acc[rb]); }
#pragma unroll
                for (int rb = 0; rb < 4; ++rb) { const f32x4 wz = *(const f32x4*)(w0 + (512 * d + c40 + 16 * rb)); f32x4 dec;
#pragma unroll
                    for (int e = 0; e < 4; ++e) dec[e] = __expf(-__expf(logsigmoid(wz[e] + acc[rb][e]) - 0.5f));
                    *(f32x4*)(SI + (so + 8u * MT * 384u * d + 16 * rb + 64)) = dec; }
                asm volatile("" ::: "memory"); }
#pragma unroll
            for (int d = 0; d < 2; ++d) { f32x4 acc[4];
#pragma unroll
                for (int rb = 0; rb < 4; ++rb) acc[rb] = (f32x4){0.f, 0.f, 0.f, 0.f};
#pragma unroll
                for (int ks = 0; ks < 2; ++ks) { const unsigned cb = 32 * ks + 8 * g; shift8(F, fo + 1664 + 64 * d + cb, hp, hn, mix, 1664 + 64 * d + cb, t8);
                    const bf16x8 bop = pack8(t8);
#pragma unroll
                    for (int rb = 0; rb < 4; ++rb) acc[rb] = mfma16(*(const bf16x8*)(A2T + (ao + 32768 * d + 1024 * rb + 32 * ks)), bop, acc[rb]); }
#pragma unroll
                for (int rb = 0; rb < 4; ++rb) { const f32x4 az = *(const f32x4*)(a0 + (512 * d + c40 + 16 * rb));
#pragma unroll
                    for (int e = 0; e < 4; ++e) { const float v = sigm(az[e] + acc[rb][e]); if (d == 0) af[rb][e] = v; else ab[rb][e] = v; } }
                asm volatile("" ::: "memory"); }
            { f32x4 acc[4];
#pragma unroll
                for (int rb = 0; rb < 4; ++rb) acc[rb] = (f32x4){0.f, 0.f, 0.f, 0.f};
#pragma unroll
                for (int ks = 0; ks < 4; ++ks) { const unsigned cb = 32 * ks + 8 * g; shift8(F, fo + 1792 + cb, hp, hn, mix, 1792 + cb, t8);
#pragma unroll
                    for (int e = 0; e < 8; ++e) t8[e] = sigm(t8[e]);
                    const bf16x8 bop = pack8(t8);
#pragma unroll
                    for (int rb = 0; rb < 4; ++rb) acc[rb] = mfma16(*(const bf16x8*)(G2T + (go + 2048 * rb + 32 * ks)), bop, acc[rb]); }
#pragma unroll
                for (int rb = 0; rb < 4; ++rb) *(f32x4*)(Gb + ((unsigned)row * 512 + c40 + 16 * rb)) = acc[rb];
                asm volatile("" ::: "memory"); }
            float ss = 0.f;
#pragma unroll
            for (int rb = 0; rb < 4; ++rb) { const unsigned c4 = c40 + 16 * rb;
                const f32x4 kv = shift4(F, fo + 512 + c4, hp, hn, mix, 512 + c4) * *(const f32x4*)(kkw + c4); ss += (kv[0] * kv[0] + kv[1] * kv[1]) + (kv[2] * kv[2] + kv[3] * kv[3]); }
            ss = xrow16_sum(ss);
            const float kinv = __builtin_amdgcn_rcpf(fmaxf(__builtin_amdgcn_sqrtf(ss), 1e-12f));
            float bonus = 0.f;
            asm volatile("" ::: "memory");
#pragma unroll
            for (int rb = 0; rb < 4; ++rb) { const unsigned c4 = c40 + 16 * rb;
                const f32x4 rr = shift4(F, fo + c4, hp, hn, mix, c4), kh = shift4(F, fo + 512 + c4, hp, hn, mix, 512 + c4), vv = shift4(F, fo + 1024 + c4, hp, hn, mix, 1024 + c4);
                const f32x4 kkv = kh * *(const f32x4*)(kkw + c4);
                const f32x4 kav = *(const f32x4*)(kaw + c4), rkv = *(const f32x4*)(rkw + c4);
                f32x4 kdf, kdb, bf, bb, nkk;
#pragma unroll
                for (int e = 0; e < 4; ++e) {
                    kdf[e] = kh[e] * (1.0f + (af[rb][e] - 1.0f) * kav[e]); kdb[e] = kh[e] * (1.0f + (ab[rb][e] - 1.0f) * kav[e]);
                    const float kn = kkv[e] * kinv; nkk[e] = -kn; bf[e] = kn * af[rb][e]; bb[e] = kn * ab[rb][e];
                    bonus += rr[e] * rkv[e] * (kdf[e] + kdb[e]); }
                const unsigned s0 = so + 16 * rb, s1 = s0 + 8u * MT * 384u;
                *(f32x4*)(SI + s0) = rr; *(f32x4*)(SI + (s0 + 128)) = kdf; *(f32x4*)(SI + (s0 + 192)) = vv; *(f32x4*)(SI + (s0 + 256)) = nkk; *(f32x4*)(SI + (s0 + 320)) = bf;
                *(f32x4*)(SI + s1) = rr; *(f32x4*)(SI + (s1 + 128)) = kdb; *(f32x4*)(SI + (s1 + 192)) = vv; *(f32x4*)(SI + (s1 + 256)) = nkk; *(f32x4*)(SI + (s1 + 320)) = bb;
                asm volatile("" ::: "memory"); }
            bonus = xrow16_sum(bonus);
            if (g == 0) BON[(size_t)row * 8 + hh] = bonus;
        } else {
            const int v = u - 4096, lr = v >> 1, isk = v & 1;
            const bf16* src = F + (size_t)(NCTX + lr) * NINP + (isk ? C_DFK : C_DFQ) + 8 * lane;
            const v4u x = *(const v4u*)src; v4u xp; xp.x = __shfl_xor(x.x, 2); xp.y = __shfl_xor(x.y, 2); xp.z = __shfl_xor(x.z, 2); xp.w = __shfl_xor(x.w, 2);
            const int seg = lane & 7, tpos = lr & 1023, pos = seg < 4 ? (tpos >> 6) : (tpos & 63); const bool second = (seg & 2) != 0;
            const float* rp = (const float*)(ws + WS_ROPE) + ((size_t)pos * 16 + 8 * (seg & 1)) * 2;
            float o[8];
#pragma unroll
            for (int w = 0; w < 4; ++w) { const unsigned xw = x[w], pw = xp[w];
                const float c0 = rp[4 * w], s0 = rp[4 * w + 1], c1 = rp[4 * w + 2], s1 = rp[4 * w + 3];
                o[2 * w] = second ? bf_lo(xw) * c0 + bf_lo(pw) * s0 : bf_lo(xw) * c0 - bf_lo(pw) * s0;
                o[2 * w + 1] = second ? bf_hi(xw) * c1 + bf_hi(pw) * s1 : bf_hi(xw) * c1 - bf_hi(pw) * s1; }
            v4u ow; ow.x = cvt_pk_bf16(o[0], o[1]); ow.y = cvt_pk_bf16(o[2], o[3]); ow.z = cvt_pk_bf16(o[4], o[5]); ow.w = cvt_pk_bf16(o[6], o[7]);
            *(v4u*)((bf16*)(ws + (isk ? WS_KR : WS_QR)) + (size_t)lr * 512 + 8 * lane) = ow;
        }
    }
}

__device__ __forceinline__ void phase_rope(unsigned char* ws, int gw, int NGW, int lane) {
    const bf16* F = (const bf16*)(ws + WS_F); const float* ropet = (const float*)(ws + WS_ROPE);
    const int seg = lane & 7; const bool second = (seg & 2) != 0;
    for (int u0 = gw; u0 < 8192; u0 += 4 * NGW) {
        v4u x[4]; f32x4 t[4][4];
#pragma unroll
        for (int i = 0; i < 4; ++i) { const int v = u0 + i * NGW; if (v < 8192) { const int lr = v >> 1, isk = v & 1, tpos = lr & 1023, pos = seg < 4 ? (tpos >> 6) : (tpos & 63);
                x[i] = *(const v4u*)(F + (size_t)(NCTX + lr) * NINP + (isk ? C_DFK : C_DFQ) + 8 * lane);
                const float* rp = ropet + ((size_t)pos * 16 + 8 * (seg & 1)) * 2;
#pragma unroll
                for (int w = 0; w < 4; ++w) t[i][w] = *(const f32x4*)(rp + 4 * w); } }
#pragma unroll
        for (int i = 0; i < 4; ++i) { const int v = u0 + i * NGW; if (v < 8192) { const int lr = v >> 1, isk = v & 1;
                v4u xp; xp.x = __shfl_xor(x[i].x, 2); xp.y = __shfl_xor(x[i].y, 2); xp.z = __shfl_xor(x[i].z, 2); xp.w = __shfl_xor(x[i].w, 2);
                v4u ow;
#pragma unroll
                for (int w = 0; w < 4; ++w) { const unsigned xw = x[i][w], pw = xp[w]; const f32x4 cs = t[i][w];
                    const float o0 = second ? bf_lo(xw) * cs[0] + bf_lo(pw) * cs[1] : bf_lo(xw) * cs[0] - bf_lo(pw) * cs[1];
                    const float o1 = second ? bf_hi(xw) * cs[2] + bf_hi(pw) * cs[3] : bf_hi(xw) * cs[2] - bf_hi(pw) * cs[3];
                    ow[w] = cvt_pk_bf16(o0, o1); }
                *(v4u*)((bf16*)(ws + (isk ? WS_KR : WS_QR)) + (size_t)lr * 512 + 8 * lane) = ow; } }
    }
}

constexpr size_t WS_OPS = 1157 * MiB; constexpr int OPS_BLOCK = 21 * 512, N_CHUNKS = 8192;
#define IMO(i) ((((i) >> 1) * 1024) + (((i) & 1) * 8))
typedef _Float16 h16x4 __attribute__((ext_vector_type(4)));
__device__ __forceinline__ f32x4 mfma16k(v2u a, v2u b, f32x4 c) { return __builtin_amdgcn_mfma_f32_16x16x16f16(__builtin_bit_cast(h16x4, a), __builtin_bit_cast(h16x4, b), c, 0, 0, 0); }
__device__ __forceinline__ v2u pk4(f32x4 v) { v2u r; r.x = cvt_pk_bf16(v[0], v[1]); r.y = cvt_pk_bf16(v[2], v[3]); return r; }
__device__ __forceinline__ unsigned short h1(float v) { return __builtin_bit_cast(unsigned short, (_Float16)v); }
struct ChunkId { int dh, T, tokbase, c; };
__device__ __forceinline__ ChunkId chunk_decode(int cu) { ChunkId k; k.dh = cu >> 9; const int cid = cu & 511;
    if (cid < 256) { k.T = 256; k.tokbase = (cid >> 4) * 256; k.c = cid & 15; } else { k.T = 1024; k.tokbase = NCTX + ((cid - 256) >> 6) * 1024; k.c = (cid - 256) & 63; } return k; }
constexpr size_t WS_V = WS_SI;
constexpr int FT_PITCH = 3856, MX_OFF = 18 * FT_PITCH, BO_OFF = MX_OFF + 2 * 1920 * 4, PRE_LDS = BO_OFF + 12 * 1024;
static_assert(MX_OFF % 16 == 0 && PRE_LDS <= RING_BYTES, "pre-pass LDS map");
__device__ __forceinline__ void shift8_lds(const LAS unsigned char* ft  , const LAS float* mx  , float (&o)[8]) {
    const v4u c = *(const LAS v4u*)ft, p = *(const LAS v4u*)(ft - FT_PITCH), n = *(const LAS v4u*)(ft + FT_PITCH);
    const f32x4 m0a = *(const LAS f32x4*)mx, m0b = *(const LAS f32x4*)(mx + 4), m1a = *(const LAS f32x4*)(mx + 1920), m1b = *(const LAS f32x4*)(mx + 1924);
#pragma unroll
    for (int w = 0; w < 4; ++w) { const unsigned cw = c[w], pw = p[w], nw = n[w];
        const float f0 = bf_lo(cw), f1 = bf_hi(cw); const float m00 = w < 2 ? m0a[2 * w] : m0b[2 * w - 4], m01 = w < 2 ? m0a[2 * w + 1] : m0b[2 * w - 3];
        const float m10 = w < 2 ? m1a[2 * w] : m1b[2 * w - 4], m11 = w < 2 ? m1a[2 * w + 1] : m1b[2 * w - 3];
        o[2 * w] = f0 + m00 * (bf_lo(pw) - f0) + m10 * (bf_lo(nw) - f0); o[2 * w + 1] = f1 + m01 * (bf_hi(pw) - f1) + m11 * (bf_hi(nw) - f1); }
}
__device__ __forceinline__ f32x4 shift4_lds(const LAS unsigned char* ft, const LAS float* mx) {
    const v2u c = *(const LAS v2u*)ft, p = *(const LAS v2u*)(ft - FT_PITCH), n = *(const LAS v2u*)(ft + FT_PITCH);
    const f32x4 m0 = *(const LAS f32x4*)mx, m1 = *(const LAS f32x4*)(mx + 1920);
    f32x4 f, pv, nv; f[0] = bf_lo(c.x); f[1] = bf_hi(c.x); f[2] = bf_lo(c.y); f[3] = bf_hi(c.y);
    pv[0] = bf_lo(p.x); pv[1] = bf_hi(p.x); pv[2] = bf_lo(p.y); pv[3] = bf_hi(p.y); nv[0] = bf_lo(n.x); nv[1] = bf_hi(n.x); nv[2] = bf_lo(n.y); nv[3] = bf_hi(n.y);
    return f + m0 * (pv - f) + m1 * (nv - f);
}
__device__ __forceinline__ void pre_tile(ArgsRef a, unsigned char* ws, int l, int tile, LAS unsigned char* lds, int tid) {
    const bf16* F = (const bf16*)(ws + WS_F);
    const float* mix = a.in[16] + (size_t)l * 2 * 1920;
    const float* w0 = a.in[17] + l * 1024; const float* a0 = a.in[19] + l * 1024;
    const float* kkw = a.in[22] + l * 512; const float* kaw = a.in[23] + l * 512; const float* rkw = a.in[24] + l * 512;
    const bf16* W2T = (const bf16*)(ws + WS_W2T) + (size_t)l * 2 * 512 * 64; const bf16* A2T = (const bf16*)(ws + WS_A2T) + (size_t)l * 2 * 512 * 64;
    const bf16* G2T = (const bf16*)(ws + WS_G2T) + (size_t)l * 512 * 128;
    float* SI = (float*)(ws + WS_SI); float* Gb = (float*)(ws + WS_G); float* BON = (float*)(ws + WS_BON);
    const int hh = __builtin_amdgcn_readfirstlane(tid >> 6), lane = tid & 63;
    int q = lane & 15, g = lane >> 4; asm volatile("" : "+v"(q), "+v"(g));
    const int tok0 = tile * 16, T = tok0 < NCTX ? 256 : 1024, pos0 = tok0 & (T - 1);
    for (int i = tid; i < 18 * 240; i += 512) { const int r = i / 240, c = i - r * 240, pos = pos0 + r - 1;
        v4u v = {0u, 0u, 0u, 0u}; if (pos >= 0 && pos < T) v = *(const v4u*)(F + (size_t)(tok0 + r - 1) * NINP + C_RW + c * 8);
        *(LAS v4u*)(lds + r * FT_PITCH + c * 16) = v; }
    for (int i = tid; i < 960; i += 512) *(LAS f32x4*)(lds + MX_OFF + 16 * i) = *(const f32x4*)(mix + 4 * i);
    __syncthreads();
    const LAS unsigned char* ftq = lds + (q + 1) * FT_PITCH; const LAS float* mx = (const LAS float*)(lds + MX_OFF);
    float t8[8];
    for (int op = hh; op < 12; op += 8) {
        const int chb = op < 2 ? 1536 : (op < 4 ? 1600 : (op < 6 ? 1664 : (op < 8 ? 1728 : 1792))), ks = op < 8 ? (op & 1) : (op - 8), ch = chb + 32 * ks + 8 * g;
        shift8_lds(ftq + ch * 2, mx + ch, t8);
        if (op < 4) {
#pragma unroll
            for (int e = 0; e < 8; ++e) t8[e] = ftanh(t8[e]); }
        else if (op >= 8) {
#pragma unroll
            for (int e = 0; e < 8; ++e) t8[e] = sigm(t8[e]); }
        *(LAS bf16x8*)(lds + BO_OFF + op * 1024 + lane * 16) = pack8(t8);
    }
    __syncthreads();
    const LAS unsigned char* bo = lds + BO_OFF + lane * 16;
    const int row = tok0 + q;
    const unsigned ao = (unsigned)(hh * 64 + q) * 64 + 8 * g, go = (unsigned)(hh * 64 + q) * 128 + 8 * g;
    const unsigned c40 = hh * 64 + 4 * g;
    { f32x4 acc[4];
#pragma unroll
        for (int rb = 0; rb < 4; ++rb) acc[rb] = (f32x4){0.f, 0.f, 0.f, 0.f};
#pragma unroll
        for (int ks = 0; ks < 4; ++ks) { const bf16x8 bop = *(const LAS bf16x8*)(bo + (8 + ks) * 1024);
#pragma unroll
            for (int rb = 0; rb < 4; ++rb) acc[rb] = mfma16(*(const bf16x8*)(G2T + (go + 2048 * rb + 32 * ks)), bop, acc[rb]); }
#pragma unroll
        for (int rb = 0; rb < 4; ++rb) *(v2u*)((bf16*)Gb + ((unsigned)row * 512 + c40 + 16 * rb)) = pk4(acc[rb]);
        asm volatile("" ::: "memory"); }
    float ss = 0.f;
#pragma unroll
    for (int rb = 0; rb < 4; ++rb) { const unsigned c4 = c40 + 16 * rb;
        const f32x4 kv = shift4_lds(ftq + (512 + c4) * 2, mx + 512 + c4) * *(const f32x4*)(kkw + c4); ss += (kv[0] * kv[0] + kv[1] * kv[1]) + (kv[2] * kv[2] + kv[3] * kv[3]); }
    ss = xrow16_sum(ss);
    const float kinv = __builtin_amdgcn_rcpf(fmaxf(__builtin_amdgcn_sqrtf(ss), 1e-12f));
    float bonus = 0.f;
    const int tq = tile < 256 ? (tile & 15) : ((tile - 256) & 63), nct = tile < 256 ? 16 : 64, sb = tile < 256 ? (tile >> 4) : ((tile - 256) >> 6);
    const int cid_f = (tile < 256 ? sb * 16 : 256 + sb * 64) + tq, cid_b = (tile < 256 ? sb * 16 : 256 + sb * 64) + (nct - 1 - tq);
    const f32x4 z4 = {0.f, 0.f, 0.f, 0.f};
    v2u idop; { f32x4 idv;
#pragma unroll
        for (int e = 0; e < 4; ++e) idv[e] = (4 * g + e == q) ? 1.f : 0.f; idop = pk4(idv); }
#pragma unroll
    for (int d = 0; d < 2; ++d) {
        f32x4 cBe = z4, cBt = z4, cKa = z4, cRb = z4, cRk = z4;
        f32x4 decd[4], asd[4];
        { f32x4 acc[4];
#pragma unroll
          for (int rb = 0; rb < 4; ++rb) acc[rb] = z4;
#pragma unroll
          for (int ks = 0; ks < 2; ++ks) { const bf16x8 bop = *(const LAS bf16x8*)(bo + (2 * d + ks) * 1024);
#pragma unroll
              for (int rb = 0; rb < 4; ++rb) acc[rb] = mfma16(*(const bf16x8*)(W2T + (ao + 32768 * d + 1024 * rb + 32 * ks)), bop, acc[rb]); }
#pragma unroll
          for (int rb = 0; rb < 4; ++rb) { const f32x4 wz = *(const f32x4*)(w0 + (512 * d + c40 + 16 * rb));
#pragma unroll
              for (int e = 0; e < 4; ++e) decd[rb][e] = __expf(-__expf(logsigmoid(wz[e] + acc[rb][e]) - 0.5f)); }
          asm volatile("" ::: "memory");
#pragma unroll
          for (int rb = 0; rb < 4; ++rb) acc[rb] = z4;
#pragma unroll
          for (int ks = 0; ks < 2; ++ks) { const bf16x8 bop = *(const LAS bf16x8*)(bo + (4 + 2 * d + ks) * 1024);
#pragma unroll
              for (int rb = 0; rb < 4; ++rb) acc[rb] = mfma16(*(const bf16x8*)(A2T + (ao + 32768 * d + 1024 * rb + 32 * ks)), bop, acc[rb]); }
#pragma unroll
          for (int rb = 0; rb < 4; ++rb) { const f32x4 az = *(const f32x4*)(a0 + (512 * d + c40 + 16 * rb));
#pragma unroll
              for (int e = 0; e < 4; ++e) asd[rb][e] = sigm(az[e] + acc[rb][e]); }
          asm volatile("" ::: "memory"); }
        unsigned oo = (unsigned)((d * 8 + hh) * 512 + (d == 0 ? cid_f : cid_b)) * OPS_BLOCK + lane * 16;
        unsigned char* ops = ws + WS_OPS + oo;
#pragma unroll
        for (int rb = 0; rb < 4; ++rb) { const unsigned c4 = c40 + 16 * rb;
            const f32x4 rr = shift4_lds(ftq + c4 * 2, mx + c4), kh = shift4_lds(ftq + (512 + c4) * 2, mx + 512 + c4);
            const f32x4 kkv = kh * *(const f32x4*)(kkw + c4), kav = *(const f32x4*)(kaw + c4);
            const f32x4 as = asd[rb], wv = decd[rb];
            f32x4 kd, bv, nkk;
#pragma unroll
            for (int e = 0; e < 4; ++e) { kd[e] = kh[e] * (1.0f + (as[e] - 1.0f) * kav[e]); const float kn = kkv[e] * kinv; nkk[e] = -kn; bv[e] = kn * as[e]; }
            { const f32x4 rkv = *(const f32x4*)(rkw + c4);
#pragma unroll
              for (int e = 0; e < 4; ++e) bonus += rr[e] * rkv[e] * kd[e]; }
            if (d == 0) *(v2u*)((bf16*)(ws + WS_V) + ((unsigned)row * 512 + c4)) = pk4(shift4_lds(ftq + (1024 + c4) * 2, mx + 1024 + c4));
            f32x4 gi, gx, gc;
#pragma unroll
            for (int e = 0; e < 4; ++e) { float x = wv[e];
                if (d == 0) { x *= dppf<0x111>(x); x *= dppf<0x112>(x); x *= dppf<0x114>(x); x *= dppf<0x118>(x); gx[e] = dppf<0x111>(x); }
                else        { x *= dppf<0x101>(x); x *= dppf<0x102>(x); x *= dppf<0x104>(x); x *= dppf<0x108>(x); gx[e] = dppf<0x101>(x); }
                gi[e] = x; gc[e] = __shfl(x, (lane & 48) | (d == 0 ? 15 : 0)); }
            f32x4 ginv;
#pragma unroll
            for (int e = 0; e < 4; ++e) ginv[e] = __builtin_amdgcn_rcpf(gi[e]);
            const v2u aop = pk4(gx * nkk), rop = pk4(gi * rr), bop = pk4(bv * ginv), kop = pk4(kd * ginv), btop = pk4(bv * ginv * gc), ktop = pk4(kd * ginv * gc);
            { const v2u bt_ = pk4(mfma16k(btop, idop, z4)), kt_ = pk4(mfma16k(ktop, idop, z4));
              *(v4u*)(ops + rb * 1024) = (v4u){aop.x, aop.y, rop.x, rop.y}; *(v4u*)(ops + (4 + rb) * 1024) = (v4u){bt_.x, bt_.y, kt_.x, kt_.y}; }
            if (q == (d == 0 ? 15 : 0)) *(f32x4*)(ops - lane * 16 + 20 * 512 + (16 * rb + 4 * g) * 4) = gi;
            cBe = mfma16k(bop, aop, cBe); cBt = mfma16k(aop, bop, cBt); cKa = mfma16k(kop, aop, cKa); cRb = mfma16k(bop, rop, cRb); cRk = mfma16k(kop, rop, cRk);
            asm volatile("" ::: "memory"); }
        f32x4 Beta = cBe, BetaT = cBt, Kap = cKa, Rb = cRb, Rk = cRk, Id;
#pragma unroll
        for (int e = 0; e < 4; ++e) { const int rw = 4 * g + e;
            const bool jt = d == 0 ? rw < q : rw > q, tj = d == 0 ? q < rw : q > rw, je = d == 0 ? rw <= q : rw >= q;
            if (!jt) { Beta[e] = 0.f; Kap[e] = 0.f; } if (!tj) BetaT[e] = 0.f; if (!je) { Rb[e] = 0.f; Rk[e] = 0.f; }
            Id[e] = rw == q ? 1.f : 0.f; }
        const v2u kap_ = pk4(Kap), rb_ = pk4(Rb), rk_ = pk4(Rk);
        const f32x4 B2 = mfma16k(pk4(BetaT), pk4(Beta), z4), B2T = mfma16k(pk4(Beta), pk4(BetaT), z4);
        const f32x4 B4 = mfma16k(pk4(B2T), pk4(B2), z4), B4T = mfma16k(pk4(B2), pk4(B2T), z4);
        const f32x4 B8 = mfma16k(pk4(B4T), pk4(B4), z4);
        const f32x4 T1 = mfma16k(pk4(Id + BetaT), pk4(Id + B2), z4), T1T = mfma16k(pk4(Id + B2), pk4(Id + BetaT), z4);
        const f32x4 T2 = mfma16k(pk4(Id + B4T), pk4(Id + B8), z4);
        { const v2u tt_ = pk4(mfma16k(pk4(T1T), pk4(T2), z4)); *(v4u*)(ops + 8 * 1024) = (v4u){kap_.x, kap_.y, tt_.x, tt_.y}; *(v4u*)(ops + 9 * 1024) = (v4u){rb_.x, rb_.y, rk_.x, rk_.y}; }
        asm volatile("" ::: "memory"); }
    bonus = xrow16_sum(bonus);
    if (g == 0) BON[(size_t)row * 8 + hh] = bonus;
    __syncthreads();
}

__device__ __forceinline__ void phase_post(ArgsRef a, unsigned char* ws, int l, int gw, int NGW, int lane) {
    const bf16* Y = (const bf16*)(ws + WS_Y); const bf16* Gb = (const bf16*)(ws + WS_G); const bf16* Vb = (const bf16*)(ws + WS_V); const float* BON = (const float*)(ws + WS_BON);
    bf16* O3 = (bf16*)(ws + WS_O3) + 1024;
    const float* lng = a.in[25] + l * 512; const float* lnb = a.in[26] + l * 512;
    const int c = 8 * lane, hh = lane >> 3;
    for (int row0 = gw; row0 < MT; row0 += 4 * NGW) {
        v4u yfw[4], ybw[4], vw[4], gw4[4]; float bon[4];
#pragma unroll
        for (int i = 0; i < 4; ++i) { const int row = row0 + i * NGW; if (row < MT) {
            yfw[i] = *(const v4u*)(Y + (size_t)row * 512 + c); ybw[i] = *(const v4u*)(Y + (size_t)(MT + row) * 512 + c);
            vw[i] = *(const v4u*)(Vb + (size_t)row * 512 + c); gw4[i] = *(const v4u*)(Gb + (size_t)row * 512 + c); bon[i] = BON[(size_t)row * 8 + hh]; } }
#pragma unroll
        for (int i = 0; i < 4; ++i) { const int row = row0 + i * NGW; if (row < MT) {
            f32x4 y0 = {bf_lo(yfw[i].x) + bf_lo(ybw[i].x), bf_hi(yfw[i].x) + bf_hi(ybw[i].x), bf_lo(yfw[i].y) + bf_lo(ybw[i].y), bf_hi(yfw[i].y) + bf_hi(ybw[i].y)};
            f32x4 y1 = {bf_lo(yfw[i].z) + bf_lo(ybw[i].z), bf_hi(yfw[i].z) + bf_hi(ybw[i].z), bf_lo(yfw[i].w) + bf_lo(ybw[i].w), bf_hi(yfw[i].w) + bf_hi(ybw[i].w)};
            float s = (y0[0] + y0[1]) + (y0[2] + y0[3]) + (y1[0] + y1[1]) + (y1[2] + y1[3]); s = red8(s);
            const float mu = s * (1.f / 64.f); y0 = y0 - mu; y1 = y1 - mu;
            float s2 = (y0[0] * y0[0] + y0[1] * y0[1]) + (y0[2] * y0[2] + y0[3] * y0[3]) + (y1[0] * y1[0] + y1[1] * y1[1]) + (y1[2] * y1[2] + y1[3] * y1[3]); s2 = red8(s2);
            const float rstd = __builtin_amdgcn_rsqf(s2 * (1.f / 64.f) + 64e-5f);
            const f32x4 v0 = {bf_lo(vw[i].x), bf_hi(vw[i].x), bf_lo(vw[i].y), bf_hi(vw[i].y)}, v1 = {bf_lo(vw[i].z), bf_hi(vw[i].z), bf_lo(vw[i].w), bf_hi(vw[i].w)};
            const f32x4 g0 = {bf_lo(gw4[i].x), bf_hi(gw4[i].x), bf_lo(gw4[i].y), bf_hi(gw4[i].y)}, g1 = {bf_lo(gw4[i].z), bf_hi(gw4[i].z), bf_lo(gw4[i].w), bf_hi(gw4[i].w)};
            const f32x4 o0 = (y0 * rstd * *(const f32x4*)(lng + c) + *(const f32x4*)(lnb + c) + v0 * bon[i]) * g0;
            const f32x4 o1 = (y1 * rstd * *(const f32x4*)(lng + c + 4) + *(const f32x4*)(lnb + c + 4) + v1 * bon[i]) * g1;
            v4u w; w.x = cvt_pk_bf16(o0[0], o0[1]); w.y = cvt_pk_bf16(o0[2], o0[3]); w.z = cvt_pk_bf16(o1[0], o1[1]); w.w = cvt_pk_bf16(o1[2], o1[3]);
            *(v4u*)(O3 + (size_t)row * 1536 + c) = w; } }
    }
}

__device__ __forceinline__ void scan_unit(ArgsRef a, unsigned char* ws, int l, bool lat, int b, int head, int dir, int half, LAS unsigned char* lds, int tid) {
    const int T = lat ? 1024 : 256, tokbase = lat ? NCTX + b * 1024 : b * 256, nch = T / 32;
    const bool active = !lat || tid < 256;
    const int row = (lat ? 32 * half : 0) + ((lat ? (tid & 255) : tid) >> 3), kseg = tid & 7;
    const float* si = (const float*)(ws + WS_SI) + ((size_t)(dir * 8 + head) * MT + tokbase) * 384;
    float* Yo = (float*)(ws + WS_Y) + ((size_t)dir * MT + tokbase) * 512 + head * 64;
    pg8::f32x2 S2[4];
    if (lat) { const float* sp = a.in[dir == 0 ? 6 : 7] + ((size_t)(b * 4 + l) * 8 + head) * 4096 + row * 64 + 8 * kseg;
        const f32x4 s0 = *(const f32x4*)sp, s1 = *(const f32x4*)(sp + 4); S2[0] = (pg8::f32x2){s0[0], s0[1]}; S2[1] = (pg8::f32x2){s0[2], s0[3]}; S2[2] = (pg8::f32x2){s1[0], s1[1]}; S2[3] = (pg8::f32x2){s1[2], s1[3]}; }
    else {
#pragma unroll
        for (int i = 0; i < 4; ++i) S2[i] = (pg8::f32x2){0.f, 0.f}; }
    LAS float* buf0 = (LAS float*)lds; LAS float* ybuf0 = (LAS float*)(lds + 98304);
    f32x4 pre[6];
    { const int tok0 = dir == 0 ? 0 : T - 32; const f32x4* s4 = (const f32x4*)(si + (size_t)tok0 * 384);
#pragma unroll
      for (int j = 0; j < 6; ++j) pre[j] = s4[tid + 512 * j]; }
    for (int c = 0; c < nch; ++c) {
        LAS float* buf = buf0 + (c & 1) * 12288; LAS float* yb = ybuf0 + (c & 1) * 2048;
#pragma unroll
        for (int j = 0; j < 6; ++j) *(LAS f32x4*)(buf + 4 * (tid + 512 * j)) = pre[j];
        __syncthreads();
        if (c > 0) { const int tp = dir == 0 ? 32 * (c - 1) : T - 32 * c; LAS float* ybp = ybuf0 + ((c - 1) & 1) * 2048;
            if (!lat) *(f32x4*)(Yo + (size_t)(tp + (tid >> 4)) * 512 + 4 * (tid & 15)) = *(LAS f32x4*)(ybp + 4 * tid);
            else if (tid < 256) *(f32x4*)(Yo + (size_t)(tp + (tid >> 3)) * 512 + 32 * half + 4 * (tid & 7)) = *(LAS f32x4*)(ybp + (tid >> 3) * 64 + 32 * half + 4 * (tid & 7)); }
        if (c + 1 < nch) { const int tok0 = dir == 0 ? 32 * (c + 1) : T - 32 * (c + 2); const f32x4* s4 = (const f32x4*)(si + (size_t)tok0 * 384);
#pragma unroll
            for (int j = 0; j < 6; ++j) pre[j] = s4[tid + 512 * j]; }
        if (active)
#pragma unroll 2
        for (int s = 0; s < 32; ++s) {
            const int ti = dir == 0 ? s : 31 - s; const LAS float* rec = buf + ti * 384 + 8 * kseg;
            typedef pg8::f32x2 f2;
            const f32x4 a0 = *(const LAS f32x4*)(rec + 256), a1 = *(const LAS f32x4*)(rec + 260);
            const f32x4 w0 = *(const LAS f32x4*)(rec + 64), w1 = *(const LAS f32x4*)(rec + 68), b0 = *(const LAS f32x4*)(rec + 320), b1 = *(const LAS f32x4*)(rec + 324);
            const f32x4 k0 = *(const LAS f32x4*)(rec + 128), k1 = *(const LAS f32x4*)(rec + 132), r0 = *(const LAS f32x4*)(rec), r1 = *(const LAS f32x4*)(rec + 4);
            const float vv = buf[ti * 384 + 192 + row];
            f2 t = S2[0] * (f2){a0[0], a0[1]}; t = S2[1] * (f2){a0[2], a0[3]} + t; t = S2[2] * (f2){a1[0], a1[1]} + t; t = S2[3] * (f2){a1[2], a1[3]} + t;
            const float sa = red8(t.x + t.y);
            const f2 sa2 = {sa, sa}, vv2 = {vv, vv};
            S2[0] = S2[0] * (f2){w0[0], w0[1]} + sa2 * (f2){b0[0], b0[1]} + vv2 * (f2){k0[0], k0[1]};
            S2[1] = S2[1] * (f2){w0[2], w0[3]} + sa2 * (f2){b0[2], b0[3]} + vv2 * (f2){k0[2], k0[3]};
            S2[2] = S2[2] * (f2){w1[0], w1[1]} + sa2 * (f2){b1[0], b1[1]} + vv2 * (f2){k1[0], k1[1]};
            S2[3] = S2[3] * (f2){w1[2], w1[3]} + sa2 * (f2){b1[2], b1[3]} + vv2 * (f2){k1[2], k1[3]};
            f2 u = S2[0] * (f2){r0[0], r0[1]}; u = S2[1] * (f2){r0[2], r0[3]} + u; u = S2[2] * (f2){r1[0], r1[1]} + u; u = S2[3] * (f2){r1[2], r1[3]} + u;
            const float y = red8(u.x + u.y);
            if (kseg == 0) yb[ti * 64 + row] = y;
        }
    }
    __syncthreads();
    { const int tp = dir == 0 ? 32 * (nch - 1) : 0; LAS float* ybp = ybuf0 + ((nch - 1) & 1) * 2048;
      if (!lat) *(f32x4*)(Yo + (size_t)(tp + (tid >> 4)) * 512 + 4 * (tid & 15)) = *(LAS f32x4*)(ybp + 4 * tid);
      else if (tid < 256) *(f32x4*)(Yo + (size_t)(tp + (tid >> 3)) * 512 + 32 * half + 4 * (tid & 7)) = *(LAS f32x4*)(ybp + (tid >> 3) * 64 + 32 * half + 4 * (tid & 7)); }
    if (!lat) { float* op = a.out + (dir == 0 ? OUT_RF : OUT_RB) + ((size_t)(b * 4 + l) * 8 + head) * 4096 + row * 64 + 8 * kseg;
        *(f32x4*)op = (f32x4){S2[0].x, S2[0].y, S2[1].x, S2[1].y}; *(f32x4*)(op + 4) = (f32x4){S2[2].x, S2[2].y, S2[3].x, S2[3].y}; }
    __syncthreads();
}

__device__ __forceinline__ void scan_pair_ctx(ArgsRef a, unsigned char* ws, int l, int b, int head, LAS unsigned char* lds, int tid) {
    typedef pg8::f32x2 f2;
    const int d = tid >> 8, gt = tid & 255, lr = gt >> 3, kseg = gt & 7, tokbase = b * 256;
    const float* si = (const float*)(ws + WS_SI) + ((size_t)(d * 8 + head) * MT + tokbase) * 384;
    float* Yo = (float*)(ws + WS_Y) + ((size_t)d * MT + tokbase) * 512 + head * 64;
    LAS float* buf0 = (LAS float*)(lds + d * 57344); LAS float* ybuf0 = (LAS float*)(lds + d * 57344 + 49152);
    f2 SA[4], SB[4];
#pragma unroll
    for (int i = 0; i < 4; ++i) { SA[i] = (f2){0.f, 0.f}; SB[i] = (f2){0.f, 0.f}; }
    f32x4 pre[6];
    { const int tok0 = d == 0 ? 0 : 256 - 16; const f32x4* s4 = (const f32x4*)(si + (size_t)tok0 * 384);
#pragma unroll
      for (int j = 0; j < 6; ++j) pre[j] = s4[gt + 256 * j]; }
    for (int c = 0; c < 16; ++c) {
        LAS float* buf = buf0 + (c & 1) * 6144; LAS float* yb = ybuf0 + (c & 1) * 1024;
#pragma unroll
        for (int j = 0; j < 6; ++j) *(LAS f32x4*)(buf + 4 * (gt + 256 * j)) = pre[j];
        __syncthreads();
        if (c > 0) { const int tp = d == 0 ? 16 * (c - 1) : 256 - 16 * c; LAS float* ybp = ybuf0 + ((c - 1) & 1) * 1024;
            *(f32x4*)(Yo + (size_t)(tp + (gt >> 4)) * 512 + 4 * (gt & 15)) = *(LAS f32x4*)(ybp + 4 * gt); }
        if (c + 1 < 16) { const int tok0 = d == 0 ? 16 * (c + 1) : 256 - 16 * (c + 2); const f32x4* s4 = (const f32x4*)(si + (size_t)tok0 * 384);
#pragma unroll
            for (int j = 0; j < 6; ++j) pre[j] = s4[gt + 256 * j]; }
#pragma unroll 2
        for (int s = 0; s < 16; ++s) {
            const int ti = d == 0 ? s : 15 - s; const LAS float* rec = buf + ti * 384 + 8 * kseg;
            const f32x4 a0 = *(const LAS f32x4*)(rec + 256), a1 = *(const LAS f32x4*)(rec + 260);
            const f32x4 w0 = *(const LAS f32x4*)(rec + 64), w1 = *(const LAS f32x4*)(rec + 68), b0 = *(const LAS f32x4*)(rec + 320), b1 = *(const LAS f32x4*)(rec + 324);
            const f32x4 k0 = *(const LAS f32x4*)(rec + 128), k1 = *(const LAS f32x4*)(rec + 132), r0 = *(const LAS f32x4*)(rec), r1 = *(const LAS f32x4*)(rec + 4);
            const f2 v2 = *(const LAS f2*)(buf + ti * 384 + 192 + 2 * lr);
            const f2 a01 = {a0[0], a0[1]}, a23 = {a0[2], a0[3]}, a45 = {a1[0], a1[1]}, a67 = {a1[2], a1[3]};
            f2 tA = SA[0] * a01; tA = SA[1] * a23 + tA; tA = SA[2] * a45 + tA; tA = SA[3] * a67 + tA;
            f2 tB = SB[0] * a01; tB = SB[1] * a23 + tB; tB = SB[2] * a45 + tB; tB = SB[3] * a67 + tB;
            const float saA = red8(tA.x + tA.y), saB = red8(tB.x + tB.y);
            const f2 sA2 = {saA, saA}, sB2 = {saB, saB}, vA2 = {v2.x, v2.x}, vB2 = {v2.y, v2.y};
            const f2 w01 = {w0[0], w0[1]}, w23 = {w0[2], w0[3]}, w45 = {w1[0], w1[1]}, w67 = {w1[2], w1[3]};
            const f2 b01 = {b0[0], b0[1]}, b23 = {b0[2], b0[3]}, b45 = {b1[0], b1[1]}, b67 = {b1[2], b1[3]};
            const f2 k01 = {k0[0], k0[1]}, k23 = {k0[2], k0[3]}, k45 = {k1[0], k1[1]}, k67 = {k1[2], k1[3]};
            SA[0] = SA[0] * w01 + sA2 * b01 + vA2 * k01; SA[1] = SA[1] * w23 + sA2 * b23 + vA2 * k23; SA[2] = SA[2] * w45 + sA2 * b45 + vA2 * k45; SA[3] = SA[3] * w67 + sA2 * b67 + vA2 * k67;
            SB[0] = SB[0] * w01 + sB2 * b01 + vB2 * k01; SB[1] = SB[1] * w23 + sB2 * b23 + vB2 * k23; SB[2] = SB[2] * w45 + sB2 * b45 + vB2 * k45; SB[3] = SB[3] * w67 + sB2 * b67 + vB2 * k67;
            const f2 r01 = {r0[0], r0[1]}, r23 = {r0[2], r0[3]}, r45 = {r1[0], r1[1]}, r67 = {r1[2], r1[3]};
            f2 uA = SA[0] * r01; uA = SA[1] * r23 + uA; uA = SA[2] * r45 + uA; uA = SA[3] * r67 + uA;
            f2 uB = SB[0] * r01; uB = SB[1] * r23 + uB; uB = SB[2] * r45 + uB; uB = SB[3] * r67 + uB;
            const float yA = red8(uA.x + uA.y), yB = red8(uB.x + uB.y);
            if (kseg == 0) *(LAS f2*)(yb + ti * 64 + 2 * lr) = (f2){yA, yB};
        }
    }
    __syncthreads();
    { const int tp = d == 0 ? 16 * 15 : 0; LAS float* ybp = ybuf0 + (15 & 1) * 1024;
      *(f32x4*)(Yo + (size_t)(tp + (gt >> 4)) * 512 + 4 * (gt & 15)) = *(LAS f32x4*)(ybp + 4 * gt); }
    { float* op = a.out + (d == 0 ? OUT_RF : OUT_RB) + ((size_t)(b * 4 + l) * 8 + head) * 4096 + (2 * lr) * 64 + 8 * kseg;
      *(f32x4*)op = (f32x4){SA[0].x, SA[0].y, SA[1].x, SA[1].y}; *(f32x4*)(op + 4) = (f32x4){SA[2].x, SA[2].y, SA[3].x, SA[3].y};
      *(f32x4*)(op + 64) = (f32x4){SB[0].x, SB[0].y, SB[1].x, SB[1].y}; *(f32x4*)(op + 68) = (f32x4){SB[2].x, SB[2].y, SB[3].x, SB[3].y}; }
    __syncthreads();
}

__device__ __forceinline__ void scan_wave(ArgsRef a, unsigned char* ws, int l, bool lat, int b, int head, int dir, int rg, int lane) {
    const int T = lat ? 1024 : 256, tokbase = lat ? NCTX + b * 1024 : b * 256, nch = T / 16, dh = dir * 8 + head;
    const int cu0 = dh * 512 + (lat ? 256 + b * 64 : b * 16);
    const int q = lane & 15, g4 = lane >> 4, row = 16 * rg + q;
    const float* siv = (const float*)(ws + WS_V) + head * 64 + row;
    float* Yo = (float*)(ws + WS_Y) + (size_t)dir * MT * 512 + head * 64 + row;
    f32x4 ST[4];
    if (lat) { const float* sp = a.in[dir == 0 ? 6 : 7] + ((size_t)(b * 4 + l) * 8 + head) * 4096 + row * 64 + 4 * g4;
#pragma unroll
        for (int kt = 0; kt < 4; ++kt) ST[kt] = *(const f32x4*)(sp + 16 * kt); }
    else {
#pragma unroll
        for (int kt = 0; kt < 4; ++kt) ST[kt] = (f32x4){0.f, 0.f, 0.f, 0.f}; }
    struct COps { v2u im[20]; f32x4 gC[4]; f32x4 vv; };
#define CH_LOAD(O, C) do { const unsigned char* ops_ = ws + WS_OPS + (size_t)(cu0 + (C)) * OPS_BLOCK; \
        _Pragma("unroll") for (int i = 0; i < 10; ++i) { const v4u pr_ = *(const v4u*)(ops_ + i * 1024 + lane * 16); O.im[2 * i] = (v2u){pr_.x, pr_.y}; O.im[2 * i + 1] = (v2u){pr_.z, pr_.w}; } \
        _Pragma("unroll") for (int kt = 0; kt < 4; ++kt) O.gC[kt] = *(const f32x4*)(ops_ + 20 * 512 + (16 * kt + 4 * g4) * 4); \
        _Pragma("unroll") for (int e = 0; e < 4; ++e) { O.vv[e] = siv[(size_t)(tokbase + 16 * (dir == 0 ? (C) : nch - 1 - (C)) + 4 * g4 + e) * 512]; } } while (0)
#define CH_STEP(O, C) do { const v2u vB = pk4(O.vv); v2u sB[4]; \
        _Pragma("unroll") for (int kt = 0; kt < 4; ++kt) sB[kt] = pk4(ST[kt]); \
        f32x4 X = {0.f, 0.f, 0.f, 0.f}, Yt = {0.f, 0.f, 0.f, 0.f}; \
        _Pragma("unroll") for (int kt = 0; kt < 4; ++kt) { X = mfma16k(O.im[kt], sB[kt], X); Yt = mfma16k(O.im[4 + kt], sB[kt], Yt); } \
        X = mfma16k(O.im[16], vB, X); \
        const f32x4 P = mfma16k(O.im[17], pk4(X), (f32x4){0.f, 0.f, 0.f, 0.f}); const v2u pB = pk4(P); \
        Yt = mfma16k(O.im[18], pB, Yt); Yt = mfma16k(O.im[19], vB, Yt); \
        _Pragma("unroll") for (int e = 0; e < 4; ++e) { Yo[(size_t)(tokbase + 16 * (dir == 0 ? (C) : nch - 1 - (C)) + 4 * g4 + e) * 512] = Yt[e]; } \
        _Pragma("unroll") for (int kt = 0; kt < 4; ++kt) { f32x4 n = ST[kt] * O.gC[kt]; n = mfma16k(O.im[8 + kt], pB, n); n = mfma16k(O.im[12 + kt], vB, n); ST[kt] = n; } } while (0)
    { COps A, B; CH_LOAD(A, 0);
      for (int c = 0; c < nch; c += 2) {
          CH_LOAD(B, c + 1);
          CH_STEP(A, c);
          if (c + 2 < nch) CH_LOAD(A, c + 2);
          CH_STEP(B, c + 1);
      } }
#undef CH_LOAD
#undef CH_STEP
    if (!lat) { float* op = a.out + (dir == 0 ? OUT_RF : OUT_RB) + ((size_t)(b * 4 + l) * 8 + head) * 4096 + row * 64 + 4 * g4;
#pragma unroll
        for (int kt = 0; kt < 4; ++kt) *(f32x4*)(op + 16 * kt) = ST[kt]; }
}

__device__ __forceinline__ void scan_wg(ArgsRef a, unsigned char* ws, int l, bool lat, int b, int head, LAS unsigned char* lds, int tid) {
    const int lane = tid & 63, wv = __builtin_amdgcn_readfirstlane(tid >> 6), dir = wv >> 2, rg = wv & 3, sl = tid & 255;
    const int T = lat ? 1024 : 256, tokbase = lat ? NCTX + b * 1024 : b * 256, nch = T / 16, dh = dir * 8 + head;
    const int cu0 = dh * 512 + (lat ? 256 + b * 64 : b * 16);
    const int q = lane & 15, g4 = lane >> 4, row = 16 * rg + q;
    const bf16* siv = (const bf16*)(ws + WS_V) + head * 64 + row;
    bf16* Yo = (bf16*)(ws + WS_Y) + (size_t)dir * MT * 512 + head * 64 + row;
    LAS unsigned char* slot0 = lds + dir * (2 * OPS_BLOCK);
    f32x4 ST[4];
    if (lat) { const float* sp = a.in[dir == 0 ? 6 : 7] + ((size_t)(b * 4 + l) * 8 + head) * 4096 + row * 64 + 4 * g4;
#pragma unroll
        for (int kt = 0; kt < 4; ++kt) ST[kt] = *(const f32x4*)(sp + 16 * kt); }
    else {
#pragma unroll
        for (int kt = 0; kt < 4; ++kt) ST[kt] = (f32x4){0.f, 0.f, 0.f, 0.f}; }
    struct GRegs { v4u x0, x1, x2; v2u vv; };
#define SW_GLOAD(R, C) do { const unsigned char* ob_ = ws + WS_OPS + (size_t)(cu0 + (C)) * OPS_BLOCK + sl * 16; \
        R.x0 = *(const v4u*)ob_; R.x1 = *(const v4u*)(ob_ + 4096); if (sl < 160) R.x2 = *(const v4u*)(ob_ + 8192); \
        { const bf16* vp_ = siv + (size_t)(tokbase + 16 * (dir == 0 ? (C) : nch - 1 - (C)) + 4 * g4) * 512; \
          R.vv.x = (unsigned)vp_[0] | ((unsigned)vp_[512] << 16); R.vv.y = (unsigned)vp_[1024] | ((unsigned)vp_[1536] << 16); } } while (0)
#define SW_PARK(R, C) do { LAS unsigned char* sp_ = slot0 + ((C) & 1) * OPS_BLOCK + sl * 16; \
        *(LAS v4u*)sp_ = R.x0; *(LAS v4u*)(sp_ + 4096) = R.x1; if (sl < 160) *(LAS v4u*)(sp_ + 8192) = R.x2; } while (0)
#define SW_STEP(VV, C) do { const LAS unsigned char* sb_ = slot0 + ((C) & 1) * OPS_BLOCK; v2u im[20]; \
        _Pragma("unroll") for (int i = 0; i < 10; ++i) { const v4u pr_ = *(const LAS v4u*)(sb_ + i * 1024 + lane * 16); im[2 * i] = (v2u){pr_.x, pr_.y}; im[2 * i + 1] = (v2u){pr_.z, pr_.w}; } \
        f32x4 gC_[4]; _Pragma("unroll") for (int kt = 0; kt < 4; ++kt) gC_[kt] = *(const LAS f32x4*)(sb_ + 20 * 512 + (16 * kt + 4 * g4) * 4); \
        const v2u vB = VV; v2u sB[4]; \
        _Pragma("unroll") for (int kt = 0; kt < 4; ++kt) sB[kt] = pk4(ST[kt]); \
        f32x4 X = {0.f, 0.f, 0.f, 0.f}, Yt = {0.f, 0.f, 0.f, 0.f}; \
        _Pragma("unroll") for (int kt = 0; kt < 4; ++kt) { X = mfma16k(im[2 * kt], sB[kt], X); Yt = mfma16k(im[2 * kt + 1], sB[kt], Yt); } \
        X = mfma16k(im[16], vB, X); \
        const f32x4 P = mfma16k(im[17], pk4(X), (f32x4){0.f, 0.f, 0.f, 0.f}); const v2u pB = pk4(P); \
        Yt = mfma16k(im[18], pB, Yt); Yt = mfma16k(im[19], vB, Yt); \
        _Pragma("unroll") for (int e = 0; e < 4; ++e) Yo[(size_t)(tokbase + 16 * (dir == 0 ? (C) : nch - 1 - (C)) + 4 * g4 + e) * 512] = h1(Yt[e]); \
        _Pragma("unroll") for (int kt = 0; kt < 4; ++kt) { f32x4 n = ST[kt] * gC_[kt]; n = mfma16k(im[8 + 2 * kt], pB, n); n = mfma16k(im[9 + 2 * kt], vB, n); ST[kt] = n; } } while (0)
    { GRegs R0, R1, R2; v2u vcur;
      SW_GLOAD(R0, 0); SW_GLOAD(R1, 1); SW_GLOAD(R2, 2);
      SW_PARK(R0, 0); vcur = R0.vv;
      __syncthreads();
      for (int c = 0; c < nch; c += 3) {
          { v2u vn = vcur; if (c + 1 < nch) { SW_PARK(R1, c + 1); vn = R1.vv; } if (c + 3 < nch) SW_GLOAD(R0, c + 3); SW_STEP(vcur, c); vcur = vn; __syncthreads(); }
          if (c + 1 < nch) { v2u vn = vcur; if (c + 2 < nch) { SW_PARK(R2, c + 2); vn = R2.vv; } if (c + 4 < nch) SW_GLOAD(R1, c + 4); SW_STEP(vcur, c + 1); vcur = vn; __syncthreads(); }
          if (c + 2 < nch) { v2u vn = vcur; if (c + 3 < nch) { SW_PARK(R0, c + 3); vn = R0.vv; } if (c + 5 < nch) SW_GLOAD(R2, c + 5); SW_STEP(vcur, c + 2); vcur = vn; __syncthreads(); }
      } }
#undef SW_GLOAD
#undef SW_PARK
#undef SW_STEP
    if (!lat) { float* op = a.out + (dir == 0 ? OUT_RF : OUT_RB) + ((size_t)(b * 4 + l) * 8 + head) * 4096 + row * 64 + 4 * g4;
#pragma unroll
        for (int kt = 0; kt < 4; ++kt) *(f32x4*)(op + 16 * kt) = ST[kt]; }
}

constexpr int ATT_KP = 272, ATT_VP = 288, ATT_BUF = 64 * ATT_KP + 64 * ATT_VP;
template <int MODE> __device__ __forceinline__ void att_src(ArgsRef a, unsigned char* ws, int l, int b, int h, int c, int j, int rg, int skey, int sseg, const bf16*& kp, const bf16*& vp) {
    const bf16* F = (const bf16*)(ws + WS_F);
    if (MODE == 0 || MODE == 2) { const size_t ro = (size_t)(b * 256 + 32 * c + skey) * NINP + h * 128 + sseg * 8; kp = F + ro + (MODE == 0 ? C_NAK : C_DFK); vp = F + ro + (MODE == 0 ? C_NAV : C_DFV); }
    else if (MODE == 3) {
        if (c < 32) { kp = (const bf16*)(ws + WS_KR) + (size_t)(b * 1024 + 32 * c + skey) * 512 + h * 128 + sseg * 8; vp = F + (size_t)(NCTX + b * 1024 + 32 * c + skey) * NINP + C_DFV + h * 128 + sseg * 8; }
        else { const size_t ro = ((size_t)(b * 4 + l) * 256 + 32 * (c - 32) + skey) * 512 + h * 128 + sseg * 8; kp = (const bf16*)(ws + WS_CKDF) + ro; vp = (const bf16*)(ws + WS_CVDF) + ro; }
    } else {
        const int nloc = 12;
        if (c < nloc) { const int kr = (rg ? 4 : 0) + c; int kc0 = 16 * j - 8; kc0 = kc0 < 0 ? 0 : (kc0 > 32 ? 32 : kc0);
            const size_t ro = (size_t)(NCTX + b * 1024 + kr * 64 + kc0 + skey) * NINP + h * 128 + sseg * 8; kp = F + ro + C_NAK; vp = F + ro + C_NAV; }
        else { const size_t ro = ((size_t)(b * 4 + l) * 256 + 32 * (c - nloc) + skey) * 512 + h * 128 + sseg * 8; kp = (const bf16*)(ws + WS_CKNA) + ro; vp = (const bf16*)(ws + WS_CVNA) + ro; }
    }
}
template <int MODE> __device__ __forceinline__ void attn_unit(ArgsRef a, unsigned char* ws, int l, int uidx, LAS unsigned char* lds, int tid) {
    constexpr bool DIFF = (MODE == 2 || MODE == 3); constexpr int NS = DIFF ? 2 : 1;
    const int wave = __builtin_amdgcn_readfirstlane(tid >> 6), lane = tid & 63, q = lane & 15, g = lane >> 4, skey = tid >> 4, sseg = tid & 15;
    const bf16* F = (const bf16*)(ws + WS_F);
    int b, h, j = 0, rg = 0, nchunks, orow; const bf16* Qp;
    if (MODE == 0 || MODE == 2) { b = uidx >> 3; h = (uidx >> 1) & 3; const int half = uidx & 1; orow = b * 256 + half * 128 + wave * 16 + q; Qp = F + (size_t)orow * NINP + (MODE == 0 ? C_NAQ : C_DFQ) + h * 128; nchunks = 8; }
    else if (MODE == 3) { b = uidx >> 5; h = (uidx >> 3) & 3; const int qb = uidx & 7; const int lr = b * 1024 + qb * 128 + wave * 16 + q; orow = NCTX + lr; Qp = (const bf16*)(ws + WS_QR) + (size_t)lr * 512 + h * 128; nchunks = 40; }
    else { b = uidx >> 5; h = (uidx >> 3) & 3; j = (uidx >> 1) & 3; rg = uidx & 1; const int r = rg * 8 + wave; orow = NCTX + b * 1024 + r * 64 + 16 * j + q; Qp = F + (size_t)orow * NINP + C_NAQ + h * 128; nchunks = 12 + 8; }
    bf16x8 qf[4];
#pragma unroll
    for (int ks = 0; ks < 4; ++ks) qf[ks] = *(const bf16x8*)(Qp + 32 * ks + 8 * g);
    const float csc = (DIFF ? 0.125f : 0.08838834764831845f) * 1.4426950408889634f;
    float m[NS], ls[NS]; f32x4 o[NS][8];
#pragma unroll
    for (int n = 0; n < NS; ++n) { m[n] = -__builtin_inff(); ls[n] = 0.f;
#pragma unroll
        for (int d = 0; d < 8; ++d) o[n][d] = (f32x4){0.f, 0.f, 0.f, 0.f}; }
    const int nloc = 12, r = rg * 8 + wave, qc = 16 * j + q;
    int rs = r - 4; rs = rs < 0 ? 0 : (rs > 8 ? 8 : rs);
    int kc0 = 16 * j - 8; kc0 = kc0 < 0 ? 0 : (kc0 > 32 ? 32 : kc0);
    int wc0 = qc - 8; wc0 = wc0 < 0 ? 0 : (wc0 > 48 ? 48 : wc0);
    const float* rpb = a.in[13] + (size_t)(l * 4 + h) * 15 * 31;
    if (MODE == 1) { for (int i = tid; i < 15 * 31; i += 512) ((LAS float*)(lds + 2 * ATT_BUF))[i] = rpb[i] * 1.4426950408889634f; }
    v4u kreg, vreg, kreg1, vreg1;
    { const bf16 *kp, *vp; att_src<MODE>(a, ws, l, b, h, 0, j, rg, skey, sseg, kp, vp); kreg = *(const v4u*)kp; vreg = *(const v4u*)vp;
      att_src<MODE>(a, ws, l, b, h, 1, j, rg, skey, sseg, kp, vp); kreg1 = *(const v4u*)kp; vreg1 = *(const v4u*)vp; }
    for (int c2 = 0; c2 < nchunks / 2; ++c2) {
        LAS unsigned char* Kl0 = lds + (c2 & 1) * ATT_BUF; LAS unsigned char* Vl0 = Kl0 + 64 * ATT_KP;
        *(LAS v4u*)(Kl0 + skey * ATT_KP + sseg * 16) = kreg; *(LAS v4u*)(Vl0 + skey * ATT_VP + sseg * 16) = vreg;
        *(LAS v4u*)(Kl0 + (32 + skey) * ATT_KP + sseg * 16) = kreg1; *(LAS v4u*)(Vl0 + (32 + skey) * ATT_VP + sseg * 16) = vreg1;
        __syncthreads();
        if (2 * c2 + 2 < nchunks) { const bf16 *kp, *vp; att_src<MODE>(a, ws, l, b, h, 2 * c2 + 2, j, rg, skey, sseg, kp, vp); kreg = *(const v4u*)kp; vreg = *(const v4u*)vp;
            att_src<MODE>(a, ws, l, b, h, 2 * c2 + 3, j, rg, skey, sseg, kp, vp); kreg1 = *(const v4u*)kp; vreg1 = *(const v4u*)vp; }
#pragma unroll 1
      for (int sub = 0; sub < 2; ++sub) { const int c = 2 * c2 + sub;
        const LAS unsigned char* Kl = Kl0 + sub * 32 * ATT_KP; const LAS unsigned char* Vl = Vl0 + sub * 32 * ATT_VP;
        bool active = true; int kr = 0;
        if (MODE == 1 && c < nloc) { kr = (rg ? 4 : 0) + c; active = (kr >= rs) && (kr < rs + 8); }
        if (active) {
            f32x4 s[NS][2];
#pragma unroll
            for (int n = 0; n < NS; ++n) { s[n][0] = (f32x4){0.f, 0.f, 0.f, 0.f}; s[n][1] = s[n][0]; }
            { bf16x8 ka[2][4];
#pragma unroll
              for (int t = 0; t < 2; ++t)
#pragma unroll
                  for (int ks = 0; ks < 4; ++ks) ka[t][ks] = *(const LAS bf16x8*)(Kl + (16 * t + q) * ATT_KP + (32 * ks + 8 * g) * 2);
#pragma unroll
              for (int t = 0; t < 2; ++t)
#pragma unroll
                  for (int ks = 0; ks < 4; ++ks) { const int n = DIFF ? (ks >> 1) : 0; s[n][t] = mfma16(ka[t][ks], qf[ks], s[n][t]); }
              __builtin_amdgcn_sched_group_barrier(0x100, 4, 1);
#pragma unroll
              for (int k = 0; k < 4; ++k) { __builtin_amdgcn_sched_group_barrier(0x8, 1, 1); __builtin_amdgcn_sched_group_barrier(0x100, 1, 1); }
              __builtin_amdgcn_sched_group_barrier(0x8, 4, 1); }
            const bool biased = (MODE == 1 && c < nloc);
            if (biased) { const LAS float* rrow = (const LAS float*)(lds + 2 * ATT_BUF) + (kr - r + 7) * 31 + 15;
#pragma unroll
                for (int t = 0; t < 2; ++t)
#pragma unroll
                    for (int e = 0; e < 4; ++e) { const int kc = kc0 + 16 * t + 4 * g + e; int rel = kc - qc; rel = rel < -15 ? -15 : (rel > 15 ? 15 : rel);
                        const bool inw = (kc >= wc0) && (kc < wc0 + 16); s[0][t][e] = inw ? __builtin_fmaf(s[0][t][e], csc, rrow[rel]) : -__builtin_inff(); } }
            bf16x8 pb[NS];
#pragma unroll
            for (int n = 0; n < NS; ++n) {
                const float mx = fmaxf(fmaxf(fmaxf(s[n][0][0], s[n][0][1]), fmaxf(s[n][0][2], s[n][0][3])), fmaxf(fmaxf(s[n][1][0], s[n][1][1]), fmaxf(s[n][1][2], s[n][1][3])));
                const float mu = biased ? mx : mx * csc;
                if (__any(mu > m[n] + 8.0f)) {
                    const float mnew = fmaxf(m[n], xrow16_max(mu));
                    const float alpha = __builtin_amdgcn_exp2f(m[n] - ((mnew == -__builtin_inff()) ? 0.f : mnew)); m[n] = mnew;
                    ls[n] = ls[n] * alpha;
#pragma unroll
                    for (int d = 0; d < 8; ++d) o[n][d] = o[n][d] * alpha;
                }
                const float muse = (m[n] == -__builtin_inff()) ? 0.f : m[n];
                float p[8]; float psum = 0.f;
                if (biased) {
#pragma unroll
                    for (int e = 0; e < 4; ++e) { p[e] = __builtin_amdgcn_exp2f(s[n][0][e] - muse); p[4 + e] = __builtin_amdgcn_exp2f(s[n][1][e] - muse); psum += p[e] + p[4 + e]; } }
                else {
#pragma unroll
                    for (int e = 0; e < 4; ++e) { p[e] = __builtin_amdgcn_exp2f(__builtin_fmaf(s[n][0][e], csc, -muse)); p[4 + e] = __builtin_amdgcn_exp2f(__builtin_fmaf(s[n][1][e], csc, -muse)); psum += p[e] + p[4 + e]; } }
                ls[n] += psum;
                pb[n] = pack8(p);
            }
            bf16x8 vt[8];
#pragma unroll
            for (int d = 0; d < 8; ++d) {
                const LAS unsigned char* va = Vl + (4 * g + (q >> 2)) * ATT_VP + (16 * d + 4 * (q & 3)) * 2;
                const s16x4 lo = vtr(va), hi = vtr(va + 16 * ATT_VP);
                vt[d] = (bf16x8){lo[0], lo[1], lo[2], lo[3], hi[0], hi[1], hi[2], hi[3]}; }
#pragma unroll
            for (int d = 0; d < 8; ++d)
#pragma unroll
                for (int n = 0; n < NS; ++n) o[n][d] = mfma16(vt[d], pb[n], o[n][d]);
            __builtin_amdgcn_sched_group_barrier(0x100, 8, 0);
#pragma unroll
            for (int k = 0; k < 4; ++k) { __builtin_amdgcn_sched_group_barrier(0x8, NS, 0); __builtin_amdgcn_sched_group_barrier(0x100, 2, 0); }
            __builtin_amdgcn_sched_group_barrier(0x8, 4 * NS, 0);
        }
      }
    }
    bf16* O3 = (bf16*)(ws + WS_O3) + (size_t)orow * 1536 + (DIFF ? 512 : 0) + h * 128 + 4 * g;
    if constexpr (!DIFF) { const float inv = __builtin_amdgcn_rcpf(xrow16_sum(ls[0]));
#pragma unroll
        for (int d = 0; d < 8; ++d) { const f32x4 v = o[0][d] * inv; v2u w; w.x = cvt_pk_bf16(v[0], v[1]); w.y = cvt_pk_bf16(v[2], v[3]); *(v2u*)(O3 + 16 * d) = w; } }
    else { const float lam = ((const float*)(ws + WS_LAM))[l], li = lam_init_of(l);
        const float i0 = __builtin_amdgcn_rcpf(xrow16_sum(ls[0])), i1 = lam * __builtin_amdgcn_rcpf(xrow16_sum(ls[1])); float ss = 0.f;
#pragma unroll
        for (int d = 0; d < 8; ++d) { o[0][d] = o[0][d] * i0 - o[1][d] * i1; ss += (o[0][d][0] * o[0][d][0] + o[0][d][1] * o[0][d][1]) + (o[0][d][2] * o[0][d][2] + o[0][d][3] * o[0][d][3]); }
        ss = xrow16_sum(ss);
        const float rsn = __builtin_amdgcn_rsqf(ss * (1.f / 128.f) + LN_EPS) * (1.0f - li);
        const float* sub = a.in[15] + l * 512 + h * 128 + 4 * g;
#pragma unroll
        for (int d = 0; d < 8; ++d) { const f32x4 v = o[0][d] * rsn * *(const f32x4*)(sub + 16 * d); v2u w; w.x = cvt_pk_bf16(v[0], v[1]); w.y = cvt_pk_bf16(v[2], v[3]); *(v2u*)(O3 + 16 * d) = w; } }
    __syncthreads();
}

__device__ __forceinline__ void rb_wait(gu32* cnt, int ra, int rb, int tid) {
    if (tid == 0) {
        unsigned sp = 0u;
        if (rb > ra + 1) { for (int r = ra; r < rb; ++r) while (__hip_atomic_load(cnt + 64 * r, RLX_AGENT) < pg8::RB_NEED) { __builtin_amdgcn_s_sleep(1); if (++sp > (1u << 22)) break; } }
        else while (__hip_atomic_load(cnt + 64 * ra, RLX_AGENT) < pg8::RB_NEED || __hip_atomic_load(cnt + 64 * rb, RLX_AGENT) < pg8::RB_NEED) { __builtin_amdgcn_s_sleep(1); if (++sp > (1u << 22)) break; }
        __builtin_amdgcn_fence(__ATOMIC_ACQUIRE, "agent");
    }
    __syncthreads();
}

constexpr int MIX_SCL = 32, MIX_A3 = MIX_SCL + 128, MIX_A0 = MIX_A3 + 128, MIX_A1 = MIX_A0 + 128, MIX_A2 = MIX_A1 + 128, MIX_SCC = MIX_A2 + 128, MIX_END = MIX_SCC;
__device__ __forceinline__ void phase_mix(ArgsRef a, unsigned char* ws, int l, LAS unsigned char* lds, int tid, int rep) {
    gu32* head = (gu32*)(ws + WS_CTL) + CW_MIXQ + 64 * (l + 4 * rep);
    volatile LAS int* slot = (volatile LAS int*)(lds + MISC_OFF + 64);
    for (;;) {
        if (tid == 0) slot[0] = (int)__hip_atomic_fetch_add(head, 1u, __ATOMIC_RELAXED, __HIP_MEMORY_SCOPE_AGENT);
        __syncthreads();
        const int u = __builtin_amdgcn_readfirstlane(slot[0]);
        __syncthreads();
        if (u >= MIX_END) break;
        if (u < MIX_SCL) scan_wg(a, ws, l, true, u >> 3, u & 7, lds, tid);
        else if (u < MIX_A3) attn_unit<3>(a, ws, l, u - MIX_SCL, lds, tid);
        else if (u < MIX_A0) attn_unit<0>(a, ws, l, u - MIX_A3, lds, tid);
        else if (u < MIX_A1) attn_unit<1>(a, ws, l, u - MIX_A0, lds, tid);
        else if (u < MIX_A2) attn_unit<2>(a, ws, l, u - MIX_A1, lds, tid);
        else { const int v = u - MIX_A2; scan_wg(a, ws, l, false, v >> 3, v & 7, lds, tid); }
    }
}

__global__ void __launch_bounds__(NWAVES * 64, 2) fwd_kernel(Args args) {
    extern __shared__ __attribute__((aligned(16))) unsigned char lds_raw[];
    LAS unsigned char* lds = (LAS unsigned char*)lds_raw;
    const int tid = threadIdx.x; const int wave_s = __builtin_amdgcn_readfirstlane(tid >> 6);
    const int G = gridDim.x, bid = blockIdx.x, NGW = G * NWAVES;
    for (int u = tid; u < (LDS_BYTES - RING_BYTES) / 4; u += NWAVES * 64) ((LAS unsigned*)(lds + RING_BYTES))[u] = 0u;
    __syncthreads();
    unsigned* barw = (unsigned*)(args.ws + WS_CTL) + CW_BAR;
    XcdBarrier bar; bar.bar = barw; bar.x = 0; bar.st = nullptr;
    if (MK_SINGLE) bar = xcd_barrier_post(barw, (volatile LAS unsigned*)(lds + MISC_OFF) + 8);
    const int lo = args.ph_lo, hi = args.ph_hi;
#ifndef PH_MASK
#define PH_MASK 0xFFFFu
#endif
#define PM(i) (((PH_MASK) >> (i)) & 1u)
#ifndef DUP_MASK
#define DUP_MASK 0u
#endif
#define DUPN(i) ((((DUP_MASK) >> (i)) & 1u) ? 2 : 1)
#define IN(k) (lo <= (k) && (k) < hi)
#define SEAM(k) do { if (MK_SINGLE && IN(k) && IN((k) + 1)) xcd_barrier(bar); } while (0)
#define FRESH() int tid_, bid_ = bid, G_ = G; asm volatile("v_mbcnt_lo_u32_b32 %0, -1, 0\n\tv_mbcnt_hi_u32_b32 %0, -1, %0" : "=v"(tid_)); tid_ += wave_s * 64; const CAS Args* ap_ = (const CAS Args*)__builtin_amdgcn_kernarg_segment_ptr(); asm volatile("" : "+v"(tid_), "+s"(ap_), "+s"(bid_), "+s"(G_)); ArgsRef A_ = *ap_; unsigned char* ws = A_.ws; const int lane_ = tid_ & 63, wave_ = __builtin_amdgcn_readfirstlane(tid_ >> 6), gw_ = bid_ * NWAVES + wave_, NGW_ = G_ * NWAVES; (void)lane_; (void)gw_; (void)NGW_
    if (PM(0) && IN(0)) for (int rep = 0; rep < DUPN(0); ++rep) { FRESH(); phase_ada(A_, ws, lds, tid_, bid_, G_); __syncthreads(); phase_cvt(A_, ws, lds, tid_, bid_, G_); __syncthreads(); }
    SEAM(0);
    if (PM(1) && IN(1)) { FRESH(); phase_ln<0>(A_, ws, 0, gw_, NGW_, lane_); }
    SEAM(1);
    for (int l = 0; l < NL; ++l) {
        const int pb = 2 + 10 * l;
        if (PM(2) && IN(pb + 0)) { FRESH(); pg8::Gemm g{(const pg8::bf16_t*)(ws + WS_H), (const pg8::bf16_t*)(ws + WS_WIN) + (size_t)l * NINP * D, MT, NINP, D}; pg8::DepOrder S; S.init(MT, NINP, G_, bid_);
            S.cnt = (gu32*)(ws + WS_CTL) + CW_RB + 2048 * l; S.lead = (tid_ == 0); S.pend = -1;
            pg8::EpiF E{(pg8::bf16_t*)(ws + WS_F), A_.out, l, ws + WS_GF};
            pg8::gemm_phase<pg8::EpiF, pg8::DepOrder, true, true>(lds, g, S, E, tid_); S.flush(); }
        if (PM(3) && IN(pb + 1)) { FRESH(); gu32* cnt = (gu32*)(ws + WS_CTL) + CW_RB + 2048 * l; gu32* head = (gu32*)(ws + WS_CTL) + CW_PREQ + 64 * l; volatile LAS int* slot = (volatile LAS int*)(lds + MISC_OFF + 64);
            for (;;) {
                if (tid_ == 0) slot[0] = (int)__hip_atomic_fetch_add(head, 1u, __ATOMIC_RELAXED, __HIP_MEMORY_SCOPE_AGENT);
                __syncthreads();
                const int t = __builtin_amdgcn_readfirstlane(slot[0]);
                __syncthreads();
                if (t >= 512) break;
                const int tok0 = t * 16; rb_wait(cnt, (tok0 > 0 ? tok0 - 1 : 0) >> 8, (tok0 + 16 < MT ? tok0 + 16 : MT - 1) >> 8, tid_);
                pre_tile(A_, ws, l, t, lds, tid_); }
            rb_wait(cnt, 16, 32, tid_);
            phase_rope(ws, gw_, NGW_, lane_); }
        SEAM(pb + 1);
        if (PM(4) && IN(pb + 2)) for (int rep = 0; rep < DUPN(4); ++rep) { FRESH(); phase_mix(A_, ws, l, lds, tid_, rep); if (rep + 1 < DUPN(4)) xcd_barrier(bar); }
        SEAM(pb + 2);
        if (PM(5) && IN(pb + 3)) for (int rep = 0; rep < DUPN(5); ++rep) { FRESH(); phase_post(A_, ws, l, gw_, NGW_, lane_); }
        SEAM(pb + 3);
        if (PM(6) && IN(pb + 4)) for (int rep = 0; rep < DUPN(6); ++rep) { FRESH(); pg8::Gemm g{(const pg8::bf16_t*)(ws + WS_O3), (const pg8::bf16_t*)(ws + WS_WBR) + (size_t)l * D * 1536, MT, D, 1536}; pg8::StaticOrder S; S.init(MT, D, G_, bid_);
            pg8::EpiMerge E{ws + WS_GF, (pg8::bf16_t*)(ws + WS_MERGED)};
            pg8::gemm_phase<pg8::EpiMerge, pg8::StaticOrder, true, true, true>(lds, g, S, E, tid_); }
        SEAM(pb + 4);
        if (PM(7) && IN(pb + 5)) for (int rep = 0; rep < DUPN(7); ++rep) { FRESH(); pg8::Gemm g{(const pg8::bf16_t*)(ws + WS_MERGED), (const pg8::bf16_t*)(ws + WS_WO) + (size_t)l * D * D, MT, D, D}; pg8::StaticOrder S; S.init(MT, D, G_, bid_);
            const int gk = l == 0 ? 0 : 2 * l; pg8::EpiRes E{(const pg8::bf16_t*)(ws + (l == 0 ? WS_X : WS_MBUF)), l == 0 ? (const float*)nullptr : (const float*)(ws + WS_ST2), (const float*)(ws + WS_GB) + (size_t)gk * 2 * D, (const float*)(ws + WS_GB) + (size_t)gk * 2 * D + D,
                (const float*)(ws + WS_MOD) + (size_t)l * 5 * 12288 + 2 * D, (pg8::bf16_t*)(ws + WS_MBUF)};
            pg8::gemm_phase<pg8::EpiRes, pg8::StaticOrder, true, true>(lds, g, S, E, tid_); }
        SEAM(pb + 5);
        if (PM(8) && IN(pb + 6)) for (int rep = 0; rep < DUPN(8); ++rep) { FRESH(); phase_ln<1>(A_, ws, l, gw_, NGW_, lane_); }
        SEAM(pb + 6);
        if (PM(9) && IN(pb + 7)) for (int rep = 0; rep < DUPN(9); ++rep) { FRESH(); pg8::Gemm g{(const pg8::bf16_t*)(ws + WS_H), (const pg8::bf16_t*)(ws + WS_WFI) + (size_t)l * NFI * D, MT, NFI, D}; pg8::StaticOrder S; S.init(MT, NFI, G_, bid_);
            pg8::EpiSwiglu E{(pg8::bf16_t*)(ws + WS_F)};
            pg8::gemm_phase<pg8::EpiSwiglu, pg8::StaticOrder, true, true>(lds, g, S, E, tid_); }
        SEAM(pb + 7);
        if (PM(10) && IN(pb + 8)) for (int rep = 0; rep < DUPN(10); ++rep) { FRESH(); pg8::Gemm g{(const pg8::bf16_t*)(ws + WS_F), (const pg8::bf16_t*)(ws + WS_WFO) + (size_t)l * D * FF, MT, D, FF}; pg8::StaticOrder S; S.init(MT, D, G_, bid_);
            const int gk = 1 + 2 * l; pg8::EpiRes E{(const pg8::bf16_t*)(ws + WS_MBUF), (const float*)(ws + WS_ST1), (const float*)(ws + WS_GB) + (size_t)gk * 2 * D, (const float*)(ws + WS_GB) + (size_t)gk * 2 * D + D,
                (const float*)(ws + WS_MOD) + (size_t)l * 5 * 12288 + 5 * D, (pg8::bf16_t*)(ws + WS_MBUF)};
            pg8::gemm_phase<pg8::EpiRes, pg8::StaticOrder, true, true>(lds, g, S, E, tid_); }
        SEAM(pb + 8);
        if (PM(11) && IN(pb + 9)) for (int rep = 0; rep < DUPN(11); ++rep) { FRESH(); if (l < NL - 1) phase_ln<2>(A_, ws, l, gw_, NGW_, lane_); else phase_ln<3>(A_, ws, l, gw_, NGW_, lane_); }
        SEAM(pb + 9);
    }
#undef FRESH
#undef IN
#undef SEAM
}
constexpr int N_PHASES = 2 + 10 * NL;

extern "C" void kernel_launch(void* const* d_in, const int* in_sizes, int n_in, void* d_out, int out_size, void* d_ws, size_t ws_size, hipStream_t stream) {
    static int grid = 0;
    if (grid == 0) {
        if (n_in != 35 || out_size != (int)OUT_TOTAL || ws_size < WS_END) { fprintf(stderr, "kernel_launch: unexpected problem: n_in %d out %d ws %zu (need %zu)\n", n_in, out_size, ws_size, (size_t)WS_END); grid = -1; return; }
        int dev = 0, cus = 0, per_cu = 0;
        if (hipGetDevice(&dev) != hipSuccess || hipDeviceGetAttribute(&cus, hipDeviceAttributeMultiprocessorCount, dev) != hipSuccess) { grid = -1; return; }
        if (hipFuncSetAttribute((const void*)fwd_kernel, hipFuncAttributeMaxDynamicSharedMemorySize, LDS_BYTES) != hipSuccess) { fprintf(stderr, "kernel_launch: hipFuncSetAttribute failed\n"); grid = -1; return; }
        if (hipOccupancyMaxActiveBlocksPerMultiprocessor(&per_cu, (const void*)fwd_kernel, NWAVES * 64, LDS_BYTES) != hipSuccess || per_cu < 1) fprintf(stderr, "kernel_launch: occupancy query says %d\n", per_cu);
        (void)hipGetLastError();
        grid = cus;
    }
    if (grid < 0) return;
    (void)hipMemsetAsync((char*)d_ws + WS_CTL, 0, CTL_ZERO_BYTES, stream);
    Args a{};
    for (int i = 0; i < 35; ++i) a.in[i] = (const float*)d_in[i];
    a.out = (float*)d_out; a.ws = (unsigned char*)d_ws; a.l_lo = 0; a.l_hi = NL;
    if (MK_SINGLE) { a.ph_lo = 0; a.ph_hi = N_PHASES; hipLaunchKernelGGL(fwd_kernel, dim3(grid), dim3(NWAVES * 64), LDS_BYTES, stream, a); }
    else for (int p = 0; p < N_PHASES; ++p) { a.ph_lo = p; a.ph_hi = p + 1; hipLaunchKernelGGL(fwd_kernel, dim3(grid), dim3(NWAVES * 64), LDS_BYTES, stream, a); }
}
```

```cpp
#include <hip/hip_runtime.h>
#include <cstdio>
#include <cstdint>

#ifndef MK_SINGLE
#define MK_SINGLE 1
#endif

constexpr int D = 2048, MT = 8192, NCTX = 4096, NL = 4;
constexpr int NIN = 11136, NINP = 11264, FF = 5632, NFI = 11264;
constexpr int C_NAQ = 0, C_NAK = 512, C_NAV = 1024, C_DFQ = 1536, C_DFK = 2048, C_DFV = 2560, C_RW = 3072, C_GATE = 5120;
__host__ __device__ __forceinline__ constexpr unsigned gf_off(int i, int pm, int j, int wave) { return (unsigned)((((i * 32 + pm) * 8 + j) * 8 + wave) * 16) * 1024u; }
constexpr size_t OUT_YP = 0, OUT_NAK = 16777216, OUT_NAV = 25165824, OUT_DFK = 33554432, OUT_DFV = 41943040, OUT_RF = 50331648, OUT_RB = 52428800, OUT_TOTAL = 54525952;
constexpr float LN_EPS = 1e-5f;

namespace pg8 {
#define PG8_LAS __attribute__((address_space(3)))
typedef unsigned short bf16_t;
typedef short bf16x8 __attribute__((ext_vector_type(8)));
typedef float f32x4 __attribute__((ext_vector_type(4)));
typedef unsigned u32x4 __attribute__((ext_vector_type(4)));
constexpr int BM = 256, BK = 64, HALF = 128, HTB = HALF * BK * 2  , STAGE_BYTES = 8 * HTB, NXCD = 8, WGM = 8;

__host__ __device__ __forceinline__ int lds_byte(int r, int c) { const int st = (r >> 4) * 2 + (c >> 5), rr = r & 15, cc = c & 31, ob = rr * 64 + cc * 2; return st * 1024 + (ob ^ (((ob >> 9) & 1) << 5)); }
__host__ __device__ __forceinline__ void stage_rc(int b, int& R, int& C) { const int st = b / 1024, sb = b % 1024, swz = sb ^ (((sb >> 9) & 1) << 5); R = (st >> 1) * 16 + swz / 64; C = (st & 1) * 32 + (swz % 64) / 2; }
__host__ __device__ __forceinline__ int perm32(int rho) { const int n = rho >> 4, i = rho & 15; return 8 * (i >> 2) + 4 * n + (i & 3); }

struct Unit { int pm, pn; };
struct Gemm { const bf16_t* A; const bf16_t* Bt; int M, N, K; };

struct StaticOrder {
    int nM, nN, nwg, G, c;
    __host__ __device__ void init(int M, int N, int G_, int c_) { nM = M / BM; nN = N / BM; nwg = nM * nN; G = G_; c = c_; }
    __host__ __device__ bool next(int i, Unit& u) const {
        const long L = (long)i * G + c; if (L >= nwg) return false;
        int wgid = (int)L; { const int q = nwg / NXCD, r = nwg % NXCD, xcd = wgid % NXCD, off = wgid / NXCD; wgid = (xcd < r ? xcd * (q + 1) : r * (q + 1) + (xcd - r) * q) + off; }
        const int nig = WGM * nN, gid = wgid / nig, fm = gid * WGM, gsz = (nM - fm) < WGM ? (nM - fm) : WGM;
        u.pm = fm + ((wgid % nig) % gsz); u.pn = (wgid % nig) / gsz; return true;
    }
    __device__ __forceinline__ void a_ready(const Unit&) const {}
    __device__ __forceinline__ void done(const Unit&) const {}
};

typedef __attribute__((address_space(1))) unsigned gu32_;
typedef __attribute__((address_space(1))) unsigned long long gu64_;
__host__ __device__ __forceinline__ bool f_needed(int pn) { return (pn >= 6 && pn < 10) || (pn >= 12 && pn < 20); }
constexpr unsigned RB_NEED = 12u;
struct DepOrder : StaticOrder {
    gu32_* cnt; bool lead; mutable int pend;
    __device__ __forceinline__ void flush() const { if (pend >= 0 && lead) (void)__hip_atomic_fetch_add(cnt + 64 * pend, 1u, __ATOMIC_RELAXED, __HIP_MEMORY_SCOPE_AGENT); pend = -1; }
    __device__ __forceinline__ void done(const Unit& u) const { flush(); pend = f_needed(u.pn) ? u.pm : -1; }
};

__device__ __forceinline__ unsigned cvt_pk_bf16(float lo, float hi) { typedef _Float16 h2_ __attribute__((ext_vector_type(2))); typedef float f2_ __attribute__((ext_vector_type(2))); const f2_ v = {lo, hi}; return __builtin_bit_cast(unsigned, __builtin_convertvector(v, h2_)); }
typedef float f32x2 __attribute__((ext_vector_type(2)));
typedef unsigned u32x2 __attribute__((ext_vector_type(2)));
typedef _Float16 h16x2 __attribute__((ext_vector_type(2)));
typedef _Float16 h16x8 __attribute__((ext_vector_type(8)));
__device__ __forceinline__ float bf_lo(unsigned w) { return (float)__builtin_bit_cast(h16x2, w)[0]; }
__device__ __forceinline__ float bf_hi(unsigned w) { return (float)__builtin_bit_cast(h16x2, w)[1]; }
__device__ __forceinline__ float sigm(float x) { return __builtin_amdgcn_rcpf(1.0f + __expf(-x)); }

struct EpiF {
    static constexpr bool PERM = true, AFTER_DRAIN = false;
    bf16_t* F; float* out; int layer; unsigned char* GF;
    __device__ __forceinline__ void operator()(const f32x4 (&acc)[2][2][4][2], const Unit& u, int wr, int wc, int fr, int fq) const {
        const int row0 = u.pm * BM + wr * 64 + fr, col0 = u.pn * BM + wc * 32 + 8 * fq;
        float* ob = nullptr;
        if (u.pm < 16) { const int seg = u.pn >> 1;
            if (seg == 1) ob = out + OUT_NAK; else if (seg == 2) ob = out + OUT_NAV; else if (seg == 4) ob = out + OUT_DFK; else if (seg == 5) ob = out + OUT_DFV; }
        const __amdgpu_buffer_rsrc_t frs = __builtin_amdgcn_make_buffer_rsrc(F, 0, MT * NINP * 2, 0x00020000);
        const bool gt = u.pn >= 20; const unsigned gbase = gt ? gf_off((u.pn - 20) >> 3, u.pm, (u.pn - 20) & 7, wr * 4 + wc) + (unsigned)(fr + 16 * fq) * 16u : 0u;
        const bool wt = f_needed(u.pn);
        const int cseg = (u.pn & 1) * 256 + wc * 32 + 8 * fq;
#pragma unroll
        for (int ai = 0; ai < 2; ++ai)
#pragma unroll
            for (int m = 0; m < 4; ++m) { const int row = row0 + ai * HALF + m * 16; bf16_t* rowp = F + (size_t)row * NINP + col0;
#pragma unroll
                for (int bj = 0; bj < 2; ++bj) { const f32x4 v0 = acc[ai][bj][m][0], v1 = acc[ai][bj][m][1];
                    u32x4 w; w.x = cvt_pk_bf16(v0[0], v0[1]); w.y = cvt_pk_bf16(v0[2], v0[3]); w.z = cvt_pk_bf16(v1[0], v1[1]); w.w = cvt_pk_bf16(v1[2], v1[3]);
                    if (gt) *(u32x4*)(GF + gbase + (unsigned)(ai * 8 + m * 2 + bj) * 1024u) = w;
                    else if (wt) __builtin_amdgcn_raw_buffer_store_b128(w, frs, (unsigned)(((unsigned)row * NINP + col0 + bj * HALF) * 2u), 0,   16);
                    else *(u32x4*)(rowp + bj * HALF) = w;
                    if (ob) { float* dst = ob + ((size_t)((row >> 8) * 4 + layer) * 256 + (row & 255)) * 512 + cseg + bj * HALF; *(f32x4*)dst = v0; *(f32x4*)(dst + 4) = v1; } } }
    }
};
struct EpiMerge {
    static constexpr bool PERM = true, AFTER_DRAIN = false;
    const unsigned char* GF; bf16_t* merged;
    __device__ __forceinline__ static float egate(float x) { return __expf(-fminf(fmaxf(x, -30.f), 30.f)); }
    __device__ __forceinline__ void mid(f32x4 (&acc)[2][2][4][2], const Unit& u, int i, int wr, int wc, int fr, int fq) const {
        unsigned off0 = gf_off(i, u.pm, u.pn, wr * 4 + wc) + (unsigned)(fr + 16 * fq) * 16u;
        asm volatile("" : "+v"(off0));
        u32x4 ga[2][2], gb[2][2];
        { const unsigned char* gp = GF + off0;
#pragma unroll
          for (int bj = 0; bj < 2; ++bj) { ga[0][bj] = *(const u32x4*)(gp + bj * 1024); gb[0][bj] = *(const u32x4*)(gp + gf_off(1, 0, 0, 0) + bj * 1024); } }
#pragma unroll
        for (int k = 0; k < 8; ++k) { const int ai = k >> 2, m = k & 3, cb = k & 1, nb = cb ^ 1;
            if (k < 7) { const unsigned char* gp = GF + (off0 + (unsigned)((k + 1) * 2) * 1024u);
#pragma unroll
                for (int bj = 0; bj < 2; ++bj) { ga[nb][bj] = *(const u32x4*)(gp + bj * 1024); gb[nb][bj] = *(const u32x4*)(gp + gf_off(1, 0, 0, 0) + bj * 1024); } }
            asm volatile("" ::: "memory");
#pragma unroll
            for (int bj = 0; bj < 2; ++bj) { const u32x4 xa = ga[cb][bj], xb = gb[cb][bj];
                f32x4 r0, r1;
                r0[0] = (1.f + egate(bf_lo(xb.x))) * __builtin_amdgcn_rcpf(1.f + egate(bf_lo(xa.x))); r0[1] = (1.f + egate(bf_hi(xb.x))) * __builtin_amdgcn_rcpf(1.f + egate(bf_hi(xa.x)));
                r0[2] = (1.f + egate(bf_lo(xb.y))) * __builtin_amdgcn_rcpf(1.f + egate(bf_lo(xa.y))); r0[3] = (1.f + egate(bf_hi(xb.y))) * __builtin_amdgcn_rcpf(1.f + egate(bf_hi(xa.y)));
                r1[0] = (1.f + egate(bf_lo(xb.z))) * __builtin_amdgcn_rcpf(1.f + egate(bf_lo(xa.z))); r1[1] = (1.f + egate(bf_hi(xb.z))) * __builtin_amdgcn_rcpf(1.f + egate(bf_hi(xa.z)));
                r1[2] = (1.f + egate(bf_lo(xb.w))) * __builtin_amdgcn_rcpf(1.f + egate(bf_lo(xa.w))); r1[3] = (1.f + egate(bf_hi(xb.w))) * __builtin_amdgcn_rcpf(1.f + egate(bf_hi(xa.w)));
                acc[ai][bj][m][0] *= r0; acc[ai][bj][m][1] *= r1; }
            asm volatile("" ::: "memory"); }
    }
    __device__ __forceinline__ void operator()(const f32x4 (&acc)[2][2][4][2], const Unit& u, int wr, int wc, int fr, int fq) const {
        const int row0 = u.pm * BM + wr * 64 + fr, col0 = u.pn * BM + wc * 32 + 8 * fq;
#pragma unroll
        for (int ai = 0; ai < 2; ++ai) {
            u32x4 gin[4][2];
#pragma unroll
            for (int m = 0; m < 4; ++m)
#pragma unroll
                for (int bj = 0; bj < 2; ++bj) gin[m][bj] = *(const u32x4*)(GF + gf_off(2, u.pm, u.pn, wr * 4 + wc) + (unsigned)(fr + 16 * fq) * 16u + (unsigned)(ai * 8 + m * 2 + bj) * 1024u);
#pragma unroll
            for (int m = 0; m < 4; ++m) { const int row = row0 + ai * HALF + m * 16;
#pragma unroll
                for (int bj = 0; bj < 2; ++bj) { const int col = col0 + bj * HALF;
                    const u32x4 gw = gin[m][bj];
                    f32x4 g0, g1; g0[0] = __builtin_amdgcn_rcpf(1.f + egate(bf_lo(gw.x))); g0[1] = __builtin_amdgcn_rcpf(1.f + egate(bf_hi(gw.x))); g0[2] = __builtin_amdgcn_rcpf(1.f + egate(bf_lo(gw.y))); g0[3] = __builtin_amdgcn_rcpf(1.f + egate(bf_hi(gw.y)));
                    g1[0] = __builtin_amdgcn_rcpf(1.f + egate(bf_lo(gw.z))); g1[1] = __builtin_amdgcn_rcpf(1.f + egate(bf_hi(gw.z))); g1[2] = __builtin_amdgcn_rcpf(1.f + egate(bf_lo(gw.w))); g1[3] = __builtin_amdgcn_rcpf(1.f + egate(bf_hi(gw.w)));
                    const f32x4 v0 = acc[ai][bj][m][0] * g0, v1 = acc[ai][bj][m][1] * g1;
                    u32x4 w; w.x = cvt_pk_bf16(v0[0], v0[1]); w.y = cvt_pk_bf16(v0[2], v0[3]); w.z = cvt_pk_bf16(v1[0], v1[1]); w.w = cvt_pk_bf16(v1[2], v1[3]);
                    *(u32x4*)(merged + (size_t)row * D + col) = w; } } }
    }
};
struct EpiRes {
    static constexpr bool PERM = true, AFTER_DRAIN = false;
    const bf16_t* src; const float* st; const float* gam; const float* bet; const float* gate; bf16_t* out;
    __device__ __forceinline__ void operator()(const f32x4 (&acc)[2][2][4][2], const Unit& u, int wr, int wc, int fr, int fq) const {
        const int row0 = u.pm * BM + wr * 64 + fr, col0 = u.pn * BM + wc * 32 + 8 * fq;
        const int cidx = u.pm < 16 ? 0 : 1 + ((u.pm - 16) >> 2);
        const float* gp = gate + (size_t)cidx * 12288 + col0;
        f32x2 rs[2][4];
#pragma unroll
        for (int ai = 0; ai < 2; ++ai)
#pragma unroll
            for (int m = 0; m < 4; ++m) { rs[ai][m] = (f32x2){1.f, 0.f}; if (st) rs[ai][m] = *(const f32x2*)(st + 2 * (row0 + ai * HALF + m * 16)); }
#pragma unroll
        for (int bj = 0; bj < 2; ++bj) {
            const f32x4 g0 = *(const f32x4*)(gp + bj * HALF), g1 = *(const f32x4*)(gp + bj * HALF + 4);
            const f32x4 ga0 = *(const f32x4*)(gam + col0 + bj * HALF), ga1 = *(const f32x4*)(gam + col0 + bj * HALF + 4);
            const f32x4 be0 = *(const f32x4*)(bet + col0 + bj * HALF), be1 = *(const f32x4*)(bet + col0 + bj * HALF + 4);
            u32x4 xin[2][4];
            if (bj == 1) {
#pragma unroll
                for (int ai = 0; ai < 2; ++ai)
#pragma unroll
                    for (int m = 0; m < 4; ++m) xin[ai][m] = *(const u32x4*)(src + (size_t)(row0 + ai * HALF + m * 16) * D + col0 + bj * HALF); }
#pragma unroll
            for (int ai = 0; ai < 2; ++ai) {
                if (bj == 0) {
#pragma unroll
                    for (int m = 0; m < 4; ++m) xin[ai][m] = *(const u32x4*)(src + (size_t)(row0 + ai * HALF + m * 16) * D + col0 + bj * HALF); }
#pragma unroll
                for (int m = 0; m < 4; ++m) { const size_t off = (size_t)(row0 + ai * HALF + m * 16) * D + col0 + bj * HALF;
                    const u32x4 xw = xin[ai][m]; const float r = rs[ai][m][0], mr = rs[ai][m][1];
                    const f32x4 x0 = {bf_lo(xw.x), bf_hi(xw.x), bf_lo(xw.y), bf_hi(xw.y)}, x1 = {bf_lo(xw.z), bf_hi(xw.z), bf_lo(xw.w), bf_hi(xw.w)};
                    const f32x4 v0 = (x0 * r - mr) * ga0 + be0 + g0 * acc[ai][bj][m][0], v1 = (x1 * r - mr) * ga1 + be1 + g1 * acc[ai][bj][m][1];
                    u32x4 w; w.x = cvt_pk_bf16(v0[0], v0[1]); w.y = cvt_pk_bf16(v0[2], v0[3]); w.z = cvt_pk_bf16(v1[0], v1[1]); w.w = cvt_pk_bf16(v1[2], v1[3]);
                    *(u32x4*)(out + off) = w; } }
        }
    }
};
struct EpiSwiglu {
    static constexpr bool PERM = true, AFTER_DRAIN = false;
    bf16_t* act;
    __device__ __forceinline__ void operator()(const f32x4 (&acc)[2][2][4][2], const Unit& u, int wr, int wc, int fr, int fq) const {
        const int row0 = u.pm * BM + wr * 64 + fr, col0 = u.pn * HALF + wc * 32 + 8 * fq;
#pragma unroll
        for (int ai = 0; ai < 2; ++ai)
#pragma unroll
            for (int m = 0; m < 4; ++m) { const int row = row0 + ai * HALF + m * 16;
                f32x4 r0, r1;
#pragma unroll
                for (int e = 0; e < 4; ++e) { const float g0 = acc[ai][0][m][0][e], g1 = acc[ai][0][m][1][e];
                    r0[e] = g0 * sigm(g0) * acc[ai][1][m][0][e]; r1[e] = g1 * sigm(g1) * acc[ai][1][m][1][e]; }
                u32x4 w; w.x = cvt_pk_bf16(r0[0], r0[1]); w.y = cvt_pk_bf16(r0[2], r0[3]); w.z = cvt_pk_bf16(r1[0], r1[1]); w.w = cvt_pk_bf16(r1[2], r1[3]);
                *(u32x4*)(act + (size_t)row * FF + col0) = w; }
    }
};

template <class Epi, class Sched, bool ALIGN_EPI = false, bool SP2 = false, bool HOOK = false>
__device__ __forceinline__ void gemm_phase(PG8_LAS unsigned char* lds, const Gemm g, const Sched& S, const Epi& E, const int tid) {
    const int wid = __builtin_amdgcn_readfirstlane(tid >> 6), lane = tid & 63, wr = wid >> 2, wc = wid & 3, fr = lane & 15, fq = lane >> 4;
    const int K = g.K, nt = K / BK;
    unsigned voffA[2], voffB[2];
#pragma unroll
    for (int i = 0; i < 2; ++i) { int R, C; stage_rc(tid * 16 + i * 8192, R, C); const int Rb = Epi::PERM ? ((R & ~31) + perm32(R & 31)) : R;
        voffA[i] = (unsigned)(R * K + C) * 2u; voffB[i] = (unsigned)(Rb * K + C) * 2u; }
    const size_t kstep = (size_t)(BK * 2);
    const size_t hstep = (size_t)HALF * K * 2;
    const size_t tstep = 2 * hstep;
    const unsigned ldsw = (unsigned)wid * 1024u;
    const int aoff = lds_byte(wr * 64 + fr, fq * 8), boff = lds_byte(wc * 32 + fr, fq * 8);
#define PG8_SA(b, h) (((b) * 2 + (h)) * HTB)
#define PG8_SB(b, h) ((4 + (b) * 2 + (h)) * HTB)
#define PG8_STAGE(bufoff, gbase, voff) do { _Pragma("unroll") for (int _i = 0; _i < 2; ++_i) \
        __builtin_amdgcn_global_load_lds((const unsigned*)((const char*)(gbase) + (voff)[_i]), (PG8_LAS unsigned*)(lds + (bufoff) + ldsw + _i * 8192), 16, 0, 0); } while (0)
#define PG8_LDA(dst, b, h) do { _Pragma("unroll") for (int m = 0; m < 4; ++m) _Pragma("unroll") for (int k = 0; k < 2; ++k) dst[m][k] = *(const PG8_LAS bf16x8*)(lds + PG8_SA(b, h) + aoff + m * 2048 + k * 1024); } while (0)
#define PG8_LDB(dst, b, h) do { _Pragma("unroll") for (int n = 0; n < 2; ++n) _Pragma("unroll") for (int k = 0; k < 2; ++k) dst[n][k] = *(const PG8_LAS bf16x8*)(lds + PG8_SB(b, h) + boff + n * 2048 + k * 1024); } while (0)
#define PG8_MMA(ai, bj, At, Bt) do { __builtin_amdgcn_s_setprio(1); _Pragma("unroll") for (int m = 0; m < 4; ++m) _Pragma("unroll") for (int n = 0; n < 2; ++n) _Pragma("unroll") for (int k = 0; k < 2; ++k) \
        acc[ai][bj][m][n] = __builtin_amdgcn_mfma_f32_16x16x32_f16(__builtin_bit_cast(h16x8, Bt[n][k]), __builtin_bit_cast(h16x8, At[m][k]), acc[ai][bj][m][n], 0, 0, 0); __builtin_amdgcn_s_setprio(0); } while (0)
#define PG8_WAIT_V(n) asm volatile("s_waitcnt vmcnt(" #n ")" ::: "memory")
#define PG8_WAIT_L(n) asm volatile("s_waitcnt lgkmcnt(" #n ")" ::: "memory")
#define PG8_BAR __builtin_amdgcn_s_barrier()
#define PG8_SCHED __builtin_amdgcn_sched_barrier(0)
    Unit cur, nxt; int ui = 0;
    if (!S.next(0, cur)) return;
    f32x4 acc[2][2][4][2];
#pragma unroll
    for (int a = 0; a < 2; ++a)
#pragma unroll
        for (int b = 0; b < 2; ++b)
#pragma unroll
            for (int m = 0; m < 4; ++m)
#pragma unroll
                for (int n = 0; n < 2; ++n) acc[a][b][m][n] = (f32x4){0.f, 0.f, 0.f, 0.f};
    bf16x8 At[4][2], B0[2][2], B1[2][2];
    const char* cA = (const char*)g.A + (size_t)cur.pm * tstep; const char* cB = (const char*)g.Bt + (size_t)cur.pn * tstep;
    S.a_ready(cur);
    if constexpr (SP2) {
        PG8_STAGE(PG8_SB(0, 0), cB, voffB); PG8_STAGE(PG8_SB(0, 1), cB + hstep, voffB); PG8_STAGE(PG8_SA(0, 0), cA, voffA); PG8_STAGE(PG8_SA(0, 1), cA + hstep, voffA);
        PG8_STAGE(PG8_SB(1, 0), cB + kstep, voffB); PG8_STAGE(PG8_SA(1, 0), cA + kstep, voffA); PG8_STAGE(PG8_SB(1, 1), cB + hstep + kstep, voffB);
        if (wr == 1) PG8_BAR;
        PG8_WAIT_V(8); PG8_BAR;
        PG8_WAIT_V(6); PG8_BAR;
    } else {
        PG8_STAGE(PG8_SB(0, 0), cB, voffB); PG8_STAGE(PG8_SA(0, 0), cA, voffA); PG8_STAGE(PG8_SB(0, 1), cB + hstep, voffB); PG8_STAGE(PG8_SA(0, 1), cA + hstep, voffA);
        if (wr == 1) PG8_BAR;
        PG8_WAIT_V(4); PG8_BAR;
        PG8_STAGE(PG8_SB(1, 0), cB + kstep, voffB); PG8_STAGE(PG8_SA(1, 0), cA + kstep, voffA); PG8_STAGE(PG8_SB(1, 1), cB + hstep + kstep, voffB);
        PG8_WAIT_V(6); PG8_BAR;
    }
    for (;;) {
        const bool has_next = S.next(ui + 1, nxt);
        const char* nA = has_next ? (const char*)g.A + (size_t)nxt.pm * tstep : cA; const char* nB = has_next ? (const char*)g.Bt + (size_t)nxt.pn * tstep : cB;
        for (int t = 0; t < nt; t += 2) {
            if constexpr (HOOK) { if (t == 8 || t == 16) E.mid(acc, cur, (t >> 3) - 1, wr, wc, fr, fq); }
            const bool last = (t == nt - 2);
            const char* a1 = cA + (size_t)(t + 1) * kstep;
            const char* a2 = last ? nA : cA + (size_t)(t + 2) * kstep; const char* b2 = last ? nB : cB + (size_t)(t + 2) * kstep;
            const char* a3 = a2 + kstep; const char* b3 = b2 + kstep;
            if (last && has_next) S.a_ready(nxt);
            if constexpr (SP2) {
            PG8_LDB(B0, 0, 0); PG8_LDB(B1, 0, 1); PG8_SCHED; PG8_LDA(At, 0, 0); PG8_STAGE(PG8_SA(1, 1), a1 + hstep, voffA);
            PG8_WAIT_V(8); PG8_WAIT_L(0); PG8_BAR; PG8_MMA(0, 0, At, B0); PG8_MMA(0, 1, At, B1); PG8_BAR; PG8_SCHED;
            PG8_LDA(At, 0, 1); PG8_STAGE(PG8_SB(0, 0), b2, voffB); PG8_STAGE(PG8_SB(0, 1), b2 + hstep, voffB); PG8_STAGE(PG8_SA(0, 0), a2, voffA);
            PG8_WAIT_V(8); PG8_WAIT_L(0); PG8_BAR; PG8_MMA(1, 0, At, B0); PG8_MMA(1, 1, At, B1); PG8_BAR; PG8_SCHED;
            PG8_LDB(B0, 1, 0); PG8_LDB(B1, 1, 1); PG8_SCHED; PG8_LDA(At, 1, 0); PG8_STAGE(PG8_SA(0, 1), a2 + hstep, voffA);
            PG8_WAIT_V(8); PG8_WAIT_L(0); PG8_BAR; PG8_MMA(0, 0, At, B0); PG8_MMA(0, 1, At, B1); PG8_BAR; PG8_SCHED;
            PG8_LDA(At, 1, 1); PG8_STAGE(PG8_SB(1, 0), b3, voffB); PG8_STAGE(PG8_SB(1, 1), b3 + hstep, voffB); PG8_STAGE(PG8_SA(1, 0), a3, voffA);
            PG8_WAIT_V(8); PG8_WAIT_L(0); PG8_BAR; PG8_MMA(1, 0, At, B0); PG8_MMA(1, 1, At, B1); PG8_BAR; PG8_SCHED;
            } else {
            PG8_LDB(B0, 0, 0); PG8_SCHED; PG8_LDA(At, 0, 0); PG8_STAGE(PG8_SA(1, 1), a1 + hstep, voffA);
            PG8_WAIT_L(8); PG8_BAR; PG8_WAIT_L(0); PG8_MMA(0, 0, At, B0); PG8_BAR; PG8_SCHED;
            PG8_LDB(B1, 0, 1); PG8_STAGE(PG8_SB(0, 0), b2, voffB);
            PG8_BAR; PG8_WAIT_L(0); PG8_MMA(0, 1, At, B1); PG8_BAR;
            PG8_LDA(At, 0, 1); PG8_STAGE(PG8_SA(0, 0), a2, voffA);
            PG8_BAR; PG8_WAIT_L(0); PG8_MMA(1, 0, At, B0); PG8_BAR; PG8_SCHED;
            PG8_STAGE(PG8_SB(0, 1), b2 + hstep, voffB);
            PG8_WAIT_V(6); PG8_BAR; PG8_MMA(1, 1, At, B1); PG8_BAR;
            PG8_LDB(B0, 1, 0); PG8_SCHED; PG8_LDA(At, 1, 0); PG8_STAGE(PG8_SA(0, 1), a2 + hstep, voffA);
            PG8_WAIT_L(8); PG8_BAR; PG8_WAIT_L(0); PG8_MMA(0, 0, At, B0); PG8_BAR; PG8_SCHED;
            PG8_LDB(B1, 1, 1); PG8_STAGE(PG8_SB(1, 0), b3, voffB);
            PG8_BAR; PG8_WAIT_L(0); PG8_MMA(0, 1, At, B1); PG8_BAR;
            PG8_LDA(At, 1, 1); PG8_STAGE(PG8_SA(1, 0), a3, voffA);
            PG8_BAR; PG8_WAIT_L(0); PG8_MMA(1, 0, At, B0); PG8_BAR; PG8_SCHED;
            PG8_STAGE(PG8_SB(1, 1), b3 + hstep, voffB);
            PG8_WAIT_V(6); PG8_BAR; PG8_MMA(1, 1, At, B1); PG8_BAR;
            }
        }
        if constexpr (ALIGN_EPI) { if (wr == 0) PG8_BAR; }
        if constexpr (!Epi::AFTER_DRAIN) { E(acc, cur, wr, wc, fr, fq); S.done(cur); }
        if (!has_next) break;
#pragma unroll
        for (int a = 0; a < 2; ++a)
#pragma unroll
            for (int b = 0; b < 2; ++b)
#pragma unroll
                for (int m = 0; m < 4; ++m)
#pragma unroll
                    for (int n = 0; n < 2; ++n) acc[a][b][m][n] = (f32x4){0.f, 0.f, 0.f, 0.f};
        cur = nxt; cA = nA; cB = nB; ++ui;
        if constexpr (ALIGN_EPI) { if (wr == 1) PG8_BAR; }
    }
    PG8_WAIT_V(0);
    if constexpr (!ALIGN_EPI) { if (wr == 0) PG8_BAR; }
    PG8_BAR;
    if constexpr (Epi::AFTER_DRAIN) { E.fused(acc, cur, wr, wc, fr, fq, lds, wid, lane); S.done(cur); }
#undef PG8_SA
#undef PG8_SB
#undef PG8_STAGE
#undef PG8_LDA
#undef PG8_LDB
#undef PG8_MMA
#undef PG8_WAIT_V
#undef PG8_WAIT_L
#undef PG8_BAR
#undef PG8_SCHED
}
}

#define GAS __attribute__((address_space(1)))
#define LAS __attribute__((address_space(3)))
typedef unsigned short bf16;
typedef unsigned v4u __attribute__((ext_vector_type(4)));
typedef float f32x4 __attribute__((ext_vector_type(4)));
typedef short bf16x8 __attribute__((ext_vector_type(8)));
typedef GAS unsigned gu32;
typedef GAS unsigned long long gu64;
#define RLX_AGENT __ATOMIC_RELAXED, __HIP_MEMORY_SCOPE_AGENT
#define LDS_WAIT() asm volatile("s_waitcnt lgkmcnt(0)" ::: "memory")
#define VM_WAIT() asm volatile("s_waitcnt vmcnt(0)" ::: "memory")
__device__ __forceinline__ unsigned long long rt() { return __builtin_amdgcn_s_memrealtime(); }
__device__ __forceinline__ unsigned f2bf(float f) { unsigned u = __builtin_bit_cast(unsigned, f); return (u + 0x7fffu + ((u >> 16) & 1u)) >> 16; }
__device__ __forceinline__ unsigned pk2(float lo, float hi) { return f2bf(lo) | (f2bf(hi) << 16); }

#define XB_TMO      128
#define XB_XCNT(j)  (256  + 64 * (j))
#define XB_XSUB(j)  (1280 + 64 * (j))
#define XB_XGEN(j)  (2304 + 64 * (j))
#define XB_TOP      3328
#define XB_TOPGEN   3392
#define XCD_BAR_WORDS 3456
#define XB_SPIN_CAP (1u << 18)

__device__ __forceinline__ unsigned xb_ld(unsigned* p)              { return __hip_atomic_load(p, __ATOMIC_RELAXED, __HIP_MEMORY_SCOPE_AGENT); }
__device__ __forceinline__ unsigned xb_add(unsigned* p, unsigned v) { return __hip_atomic_fetch_add(p, v, __ATOMIC_RELAXED, __HIP_MEMORY_SCOPE_AGENT); }
__device__ __forceinline__ unsigned xb_xcc_id() { return (unsigned)__builtin_amdgcn_s_getreg((3 << 11) | 20) & 0xFu; }
#define XB_SPIN(cond, bar) do { unsigned _sp = 0; while (cond) { __builtin_amdgcn_s_sleep(1); \
    if ((++_sp & 255u) == 0u) { if (xb_ld(&(bar)[XB_TMO])) break; if (_sp > XB_SPIN_CAP) { atomicAdd(&(bar)[XB_TMO], 1u); break; } } } } while (0)

struct XcdBarrier {
    unsigned* bar; unsigned x;
    volatile LAS unsigned* st;
};

__device__ __forceinline__ XcdBarrier xcd_barrier_post(unsigned* bar, volatile LAS unsigned* st) {
    XcdBarrier b; b.bar = bar; b.x = xb_xcc_id(); b.st = st;
    if (threadIdx.x == 0) (void)xb_add(&bar[XB_XCNT(b.x)], 1u);
    return b;
}
__device__ __forceinline__ void xcd_barrier_complete(unsigned* bar, unsigned x, unsigned& nloc, unsigned& nx) {
    const unsigned G = gridDim.x * gridDim.y * gridDim.z;
    unsigned sum, cnt, mine, sp = 0u;
    for (;;) {
        sum = 0u; cnt = 0u; mine = 0u;
#pragma unroll
        for (unsigned j = 0; j < 16; ++j) { const unsigned c = xb_ld(&bar[XB_XCNT(j)]); sum += c; cnt += (c > 0u) ? 1u : 0u; mine = (j == x) ? c : mine; }
        if (sum == G) break;
        __builtin_amdgcn_s_sleep(1);
        if ((++sp & 255u) == 0u) { if (xb_ld(&bar[XB_TMO])) break; if (sp > XB_SPIN_CAP) { atomicAdd(&bar[XB_TMO], 1u); break; } }
    }
    nloc = mine > 0u ? mine : 1u; nx = cnt > 0u ? cnt : 1u;
}

__device__ __forceinline__ void xcd_barrier(const XcdBarrier& b) {
    asm volatile("s_waitcnt vmcnt(0)" ::: "memory");
    __syncthreads();
    if (threadIdx.x == 0) {
        unsigned* bar = b.bar;
        __builtin_amdgcn_s_waitcnt(0);
        unsigned nloc = b.st[0], nx = b.st[1];
        if (nloc == 0u) { xcd_barrier_complete(bar, b.x, nloc, nx); b.st[0] = nloc; b.st[1] = nx; }
        const unsigned old = xb_add(&bar[XB_XSUB(b.x)], 1u);
        const unsigned gen = old / nloc;
        if (old + 1u == (gen + 1u) * nloc) {
            __builtin_amdgcn_fence(__ATOMIC_RELEASE, "agent");
            asm volatile("s_waitcnt vmcnt(0)" ::: "memory");
            const unsigned og = xb_add(&bar[XB_TOP], 1u);
            const unsigned tg = og / nx;
            if (og + 1u == (tg + 1u) * nx) xb_add(&bar[XB_TOPGEN], 1u);
            else XB_SPIN(xb_ld(&bar[XB_TOPGEN]) == tg, bar);
            __builtin_amdgcn_fence(__ATOMIC_ACQUIRE, "agent");
            xb_add(&bar[XB_XGEN(b.x)], 1u);
            asm volatile("s_waitcnt vmcnt(0)" ::: "memory");
        } else {
            XB_SPIN(xb_ld(&bar[XB_XGEN(b.x)]) == gen, bar);
            __builtin_amdgcn_fence(__ATOMIC_ACQUIRE, "agent");
            asm volatile("s_waitcnt vmcnt(0)" ::: "memory");
        }
    }
    __syncthreads();
}

constexpr float DN_ALPHA = 1.681792830507429f;
constexpr size_t MiB = 1u << 20;
constexpr size_t WS_CTL = 0, CTL_ZERO_BYTES = 1 * MiB;
constexpr size_t WS_MOD = 1 * MiB;
constexpr size_t WS_LAM = 2 * MiB, WS_ROPE = 2 * MiB + 4096, WS_W2T = 2 * MiB + 65536, WS_A2T = WS_W2T + 524288, WS_G2T = WS_A2T + 524288;
constexpr size_t WS_CKNA = 4 * MiB, WS_CVNA = 8 * MiB, WS_CKDF = 12 * MiB, WS_CVDF = 16 * MiB;
constexpr size_t WS_WIN = 20 * MiB, WS_WBR = 196 * MiB, WS_WO = 220 * MiB, WS_WFI = 252 * MiB, WS_WFO = 428 * MiB;
constexpr size_t WS_H = 516 * MiB;
constexpr size_t WS_F = 548 * MiB;
constexpr size_t WS_O3 = 724 * MiB;
constexpr size_t WS_MBUF = 748 * MiB;
constexpr size_t WS_MERGED = 812 * MiB;
constexpr size_t WS_X = 844 * MiB;
constexpr size_t WS_ST1 = 876 * MiB, WS_ST2 = 877 * MiB;
constexpr size_t WS_GB = 878 * MiB;
constexpr size_t WS_GF = 920 * MiB;
constexpr size_t WS_SI = 908 * MiB;
constexpr size_t WS_Y = 1100 * MiB;
constexpr size_t WS_G = 1132 * MiB;
constexpr size_t WS_BON = 1148 * MiB;
constexpr size_t WS_QR = 1149 * MiB, WS_KR = 1153 * MiB;
constexpr size_t WS_END = 1245 * MiB;
constexpr int CW_BAR = 4096, CW_MIXQ = 16384, CW_RB = 32768, CW_PREQ = 49152;

constexpr int RING_BYTES = 131072, MISC_OFF = RING_BYTES + 320, LDS_BYTES = 147456;
constexpr int NWAVES = 8;

struct Args { const float* in[35]; float* out; unsigned char* ws; int l_lo, l_hi, ph_lo, ph_hi; };
#define CAS __attribute__((address_space(4)))
typedef const CAS Args& ArgsRef;

typedef unsigned v2u __attribute__((ext_vector_type(2)));
typedef short s16x4 __attribute__((ext_vector_type(4)));
typedef short v4i16_t __attribute__((ext_vector_type(4)));
using pg8::cvt_pk_bf16; using pg8::bf_lo; using pg8::bf_hi; using pg8::sigm;

__device__ __forceinline__ bf16 f2h(float v) { return __builtin_bit_cast(unsigned short, (_Float16)v); }
template <int CTRL> __device__ __forceinline__ float dpp(float x) { return __builtin_bit_cast(float, __builtin_amdgcn_mov_dpp(__builtin_bit_cast(int, x), CTRL, 0xf, 0xf, true)); }
template <int CTRL> __device__ __forceinline__ float dppf(float x) { return __builtin_bit_cast(float, __builtin_amdgcn_update_dpp(0x3f800000, __builtin_bit_cast(int, x), CTRL, 0xf, 0xf, false)); }
__device__ __forceinline__ float red8(float x) { x += dpp<0xB1>(x); x += dpp<0x4E>(x); x += dpp<0x141>(x); return x; }
__device__ __forceinline__ float xrow16_max(float x) { x = fmaxf(x, __shfl_xor(x, 16)); x = fmaxf(x, __shfl_xor(x, 32)); return x; }
__device__ __forceinline__ float xrow16_sum(float x) { x += __shfl_xor(x, 16); x += __shfl_xor(x, 32); return x; }
__device__ __forceinline__ float wave_sum(float v) {
    v += dpp<0xB1>(v); v += dpp<0x4E>(v); v += dpp<0x141>(v); v += dpp<0x128>(v);
    return xrow16_sum(v);
}
__device__ __forceinline__ s16x4 vtr(const LAS unsigned char* p) { return __builtin_bit_cast(s16x4, __builtin_amdgcn_ds_read_tr16_b64_v4i16((LAS v4i16_t*)p)); }
__device__ __forceinline__ f32x4 mfma16(bf16x8 a, bf16x8 b, f32x4 c) { return __builtin_amdgcn_mfma_f32_16x16x32_f16(__builtin_bit_cast(pg8::h16x8, a), __builtin_bit_cast(pg8::h16x8, b), c, 0, 0, 0); }

__device__ __forceinline__ void phase_ada(ArgsRef a, unsigned char* ws, LAS unsigned char* lds, int tid, int bid, int G) {
    LAS float* sc = (LAS float*)lds;
    LAS float* red = sc + 5 * 2048;
    const float* cvec = a.in[8]; const float* cctx = a.in[9];
    for (int i = tid; i < 5 * 2048; i += 512) { const int c = i >> 11, k = i & 2047; const float v = c == 0 ? cctx[k] : cvec[(c - 1) * 2048 + k]; sc[i] = v / (1.0f + expf(-v)); }
    __syncthreads();
    const int wave = tid >> 6, lane = tid & 63;
    float* MOD = (float*)(ws + WS_MOD);
    for (int unit = bid; unit < NL * 96; unit += G) {
        const int l = unit / 96, n0 = (unit % 96) * 128;
        const float* W = a.in[10] + (size_t)l * 2048 * 12288 + n0 + 2 * lane;
        float acc[5][2];
#pragma unroll
        for (int c = 0; c < 5; ++c) { acc[c][0] = 0.f; acc[c][1] = 0.f; }
        const int k0 = wave * 256;
        for (int kk = 0; kk < 256; kk += 8) {
            pg8::f32x2 w[8];
#pragma unroll
            for (int j = 0; j < 8; ++j) w[j] = *(const pg8::f32x2*)(W + (size_t)(k0 + kk + j) * 12288);
#pragma unroll
            for (int j = 0; j < 8; ++j)
#pragma unroll
                for (int c = 0; c < 5; ++c) { const float s = sc[c * 2048 + k0 + kk + j]; acc[c][0] += s * w[j].x; acc[c][1] += s * w[j].y; }
        }
#pragma unroll
        for (int c = 0; c < 5; ++c) { red[(wave * 5 + c) * 128 + 2 * lane] = acc[c][0]; red[(wave * 5 + c) * 128 + 2 * lane + 1] = acc[c][1]; }
        __syncthreads();
        for (int i = tid; i < 5 * 128; i += 512) { const int c = i >> 7, n = i & 127; float s = 0.f;
#pragma unroll
            for (int w = 0; w < 8; ++w) s += red[(w * 5 + c) * 128 + n];
            MOD[((size_t)l * 5 + c) * 12288 + n0 + n] = s + a.in[11][(size_t)l * 12288 + n0 + n]; }
        __syncthreads();
    }
}

__device__ __forceinline__ void transpose_item(const float* W, int K, int N, bf16* WT, int k0, int n0, int drow0, LAS float* scr, int lane, int ldk = 0) {
    if (ldk == 0) ldk = K;
    { f32x4 r[8];
#pragma unroll
      for (int i = 0; i < 8; ++i) r[i] = *(const f32x4*)(W + (size_t)(k0 + 8 * i + (lane >> 3)) * N + n0 + 4 * (lane & 7));
#pragma unroll
      for (int i = 0; i < 8; ++i) { LAS float* d = scr + (8 * i + (lane >> 3)) * 33 + 4 * (lane & 7); d[0] = r[i][0]; d[1] = r[i][1]; d[2] = r[i][2]; d[3] = r[i][3]; } }
    LDS_WAIT(); asm volatile("" ::: "memory");
    const int c = lane & 7;
#pragma unroll
    for (int j = 0; j < 4; ++j) { const int n = (lane >> 3) + 8 * j; const LAS float* s = scr + (8 * c) * 33 + n;
        v4u o; o.x = cvt_pk_bf16(s[0 * 33], s[1 * 33]); o.y = cvt_pk_bf16(s[2 * 33], s[3 * 33]); o.z = cvt_pk_bf16(s[4 * 33], s[5 * 33]); o.w = cvt_pk_bf16(s[6 * 33], s[7 * 33]);
        *(v4u*)(WT + (size_t)(drow0 + n) * ldk + k0 + 8 * c) = o; }
    LDS_WAIT(); asm volatile("" ::: "memory");
}
constexpr int IT_WIN = 32 * 348, IT_WBR = 3 * 8 * 64, IT_WO = 32 * 64, IT_WFI = 32 * 352, IT_WFO = 88 * 64, IT_LAYER = IT_WIN + IT_WBR + IT_WO + IT_WFI + IT_WFO;
__device__ __forceinline__ void phase_cvt(ArgsRef a, unsigned char* ws, LAS unsigned char* lds, int tid, int bid, int G) {
    const int wave = tid >> 6, lane = tid & 63;
    LAS float* scr = (LAS float*)(lds + wave * 16384);
    const int gw = bid * NWAVES + wave, NGW = G * NWAVES;
    constexpr int IT_ALL = NL * IT_LAYER, IT_EVEN = 56 * 2048;
    const bool skew = (G == 256);
    for (int it = gw, st2 = 0; ; ) {
        if (!skew) { if (it >= IT_ALL) break; }
        else if (!st2) { if (it >= IT_EVEN) { st2 = 1; if (bid < 128) break; it = IT_EVEN + (gw - 1024); continue; } }
        else if (it >= IT_ALL) break;
        const int it_next = it + ((skew && st2) ? 1024 : NGW);
        const int l = it / IT_LAYER; int r = it - l * IT_LAYER;
        if (r < IT_WIN) { const int kb = r / 348, nb = r - kb * 348, n0 = 32 * nb;
            transpose_item(a.in[12] + (size_t)l * D * NIN, D, NIN, (bf16*)(ws + WS_WIN) + (size_t)l * NINP * D, 64 * kb, n0, n0 + (n0 >= 4992 ? 128 : 0), scr, lane); it = it_next; continue; }
        r -= IT_WIN;
        if (r < IT_WBR) { const int i = r >> 9, rr = r & 511, kb = rr >> 6, nb = rr & 63;
            transpose_item(a.in[27] + (size_t)(l * 3 + i) * 512 * D, 512, D, (bf16*)(ws + WS_WBR) + (size_t)l * D * 1536 + i * 512, 64 * kb, 32 * nb, 32 * nb, scr, lane, 1536); it = it_next; continue; }
        r -= IT_WBR;
        if (r < IT_WO) { const int kb = r >> 6, nb = r & 63;
            transpose_item(a.in[28] + (size_t)l * D * D, D, D, (bf16*)(ws + WS_WO) + (size_t)l * D * D, 64 * kb, 32 * nb, 32 * nb, scr, lane); it = it_next; continue; }
        r -= IT_WO;
        if (r < IT_WFI) { const int kb = r / 352, nb = r - kb * 352, n0 = 32 * nb;
            const int dr = n0 < FF ? (n0 >> 7) * 256 + (n0 & 127) : ((n0 - FF) >> 7) * 256 + 128 + ((n0 - FF) & 127);
            transpose_item(a.in[31] + (size_t)l * D * NFI, D, NFI, (bf16*)(ws + WS_WFI) + (size_t)l * NFI * D, 64 * kb, n0, dr, scr, lane); it = it_next; continue; }
        r -= IT_WFI;
        { const int kb = r >> 6, nb = r & 63;
            transpose_item(a.in[32] + (size_t)l * FF * D, FF, D, (bf16*)(ws + WS_WFO) + (size_t)l * D * FF, 64 * kb, 32 * nb, 32 * nb, scr, lane); }
        it = it_next;
    }
    const int gt = bid * 512 + tid, NGT = G * 512;
    for (int i = gt; i < 4 * 262144; i += NGT) { const int t = i >> 18, e = (i & 262143) * 8;
        const float* src = a.in[2 + t] + e; const f32x4 x0 = *(const f32x4*)src, x1 = *(const f32x4*)(src + 4);
        v4u o; o.x = cvt_pk_bf16(x0[0], x0[1]); o.y = cvt_pk_bf16(x0[2], x0[3]); o.z = cvt_pk_bf16(x1[0], x1[1]); o.w = cvt_pk_bf16(x1[2], x1[3]);
        *(v4u*)((bf16*)(ws + WS_CKNA + (size_t)t * 4 * MiB) + e) = o; }
    for (int i = gt; i < 3 * 262144; i += NGT) { const int t = i >> 18, e = i & 262143;
        if (t < 2) { const int j = e & 63, c = (e >> 6) & 511, ld = e >> 15;
            const float v = a.in[t == 0 ? 18 : 20][((size_t)ld * 64 + j) * 512 + c];
            ((bf16*)(ws + (t == 0 ? WS_W2T : WS_A2T)))[e] = f2h(v); }
        else { const int j = e & 127, c = (e >> 7) & 511, l = e >> 16;
            ((bf16*)(ws + WS_G2T))[e] = f2h(a.in[21][((size_t)l * 128 + j) * 512 + c]); } }
    for (int i = gt; i < 64 * 16; i += NGT) { const int pos = i >> 4, f = i & 15; const float inv = powf(10000.0f, -(float)f / 16.0f); const float ang = (float)pos * inv;
        float* rp = (float*)(ws + WS_ROPE) + 2 * i; rp[0] = cosf(ang); rp[1] = sinf(ang); }
    for (int i = gt; i < 9 * D; i += NGT) { const int k = i / D, c = i - k * D; float gv = 1.f, bv = 0.f;
        if (k > 0) { const int l = (k - 1) >> 1; if ((k - 1) & 1) { gv = a.in[33][l * D + c]; bv = a.in[34][l * D + c]; } else { gv = a.in[29][l * D + c]; bv = a.in[30][l * D + c]; } }
        float* gb = (float*)(ws + WS_GB) + (size_t)k * 2 * D; gb[c] = DN_ALPHA * gv; gb[D + c] = DN_ALPHA * bv; }
    if (gw < NL) { const float* lp = a.in[14] + gw * 256; const float s1 = wave_sum(lp[lane] * lp[64 + lane]), s2 = wave_sum(lp[128 + lane] * lp[192 + lane]);
        const float li = gw == 0 ? 0.2f : gw == 1 ? 0.355509067590969f : gw == 2 ? 0.470713018343584f : 0.556058204155641f;
        if (lane == 0) ((float*)(ws + WS_LAM))[gw] = expf(s1) - expf(s2) + li; }
}
__device__ __forceinline__ float lam_init_of(int l) { return l == 0 ? 0.2f : l == 1 ? 0.355509067590969f : l == 2 ? 0.470713018343584f : 0.556058204155641f; }

template <int MODE> __device__ __forceinline__ void phase_ln(ArgsRef a, unsigned char* ws, int l, int gw, int NGW, int lane) {
    const float* MODp = (const float*)(ws + WS_MOD);
    bf16* X = (bf16*)(ws + WS_X); bf16* H = (bf16*)(ws + WS_H);
    const float* lg = MODE == 1 ? a.in[29] + l * D : a.in[33] + l * D; const float* lb = MODE == 1 ? a.in[30] + l * D : a.in[34] + l * D;
    const int ml = MODE == 2 ? l + 1 : l, mi = MODE == 1 ? 3 : 0;
    for (int row = gw; row < MT; row += NGW) {
        f32x4 v[8]; float s = 0.f;
        if (MODE == 0) { const float* src = (row < NCTX ? a.in[0] + (size_t)row * D : a.in[1] + (size_t)(row - NCTX) * D) + 8 * lane;
#pragma unroll
            for (int j = 0; j < 4; ++j) { v[2 * j] = *(const f32x4*)(src + 512 * j); v[2 * j + 1] = *(const f32x4*)(src + 512 * j + 4); } }
        else { const bf16* src = (const bf16*)(ws + WS_MBUF) + (size_t)row * D + 8 * lane;
#pragma unroll
            for (int j = 0; j < 4; ++j) { const v4u w = *(const v4u*)(src + 512 * j);
                v[2 * j] = (f32x4){bf_lo(w.x), bf_hi(w.x), bf_lo(w.y), bf_hi(w.y)}; v[2 * j + 1] = (f32x4){bf_lo(w.z), bf_hi(w.z), bf_lo(w.w), bf_hi(w.w)}; } }
#pragma unroll
        for (int j = 0; j < 8; ++j) s += (v[j][0] + v[j][1]) + (v[j][2] + v[j][3]);
        if (MODE != 0) {
            const float mean = wave_sum(s) * (1.f / D); float s2 = 0.f;
#pragma unroll
            for (int j = 0; j < 8; ++j) { v[j] = v[j] - mean; s2 += (v[j][0] * v[j][0] + v[j][1] * v[j][1]) + (v[j][2] * v[j][2] + v[j][3] * v[j][3]); }
            const float rstd = __builtin_amdgcn_rsqf(wave_sum(s2) * (1.f / D) + LN_EPS);
            if (MODE != 3 && lane == 0) *(pg8::f32x2*)((float*)(ws + (MODE == 1 ? WS_ST1 : WS_ST2)) + 2 * row) = (pg8::f32x2){rstd, mean * rstd};
            s = 0.f;
#pragma unroll
            for (int j = 0; j < 8; ++j) { const int co = 8 * lane + 512 * (j >> 1) + 4 * (j & 1); const f32x4 gg = *(const f32x4*)(lg + co), bb = *(const f32x4*)(lb + co);
                v[j] = v[j] * rstd * gg + bb; s += (v[j][0] + v[j][1]) + (v[j][2] + v[j][3]); }
        }
        if (MODE == 3) { float* xo = a.out + (size_t)row * D + 8 * lane;
#pragma unroll
            for (int j = 0; j < 4; ++j) { *(f32x4*)(xo + 512 * j) = v[2 * j]; *(f32x4*)(xo + 512 * j + 4) = v[2 * j + 1]; } }
        else if (MODE == 0) { bf16* xo = X + (size_t)row * D + 8 * lane;
#pragma unroll
            for (int j = 0; j < 4; ++j) { v4u w; w.x = cvt_pk_bf16(v[2 * j][0], v[2 * j][1]); w.y = cvt_pk_bf16(v[2 * j][2], v[2 * j][3]); w.z = cvt_pk_bf16(v[2 * j + 1][0], v[2 * j + 1][1]); w.w = cvt_pk_bf16(v[2 * j + 1][2], v[2 * j + 1][3]);
                *(v4u*)(xo + 512 * j) = w; } }
        if (MODE != 3) {
            const float mean = wave_sum(s) * (1.f / D); float s2 = 0.f;
#pragma unroll
            for (int j = 0; j < 8; ++j) { v[j] = v[j] - mean; s2 += (v[j][0] * v[j][0] + v[j][1] * v[j][1]) + (v[j][2] * v[j][2] + v[j][3] * v[j][3]); }
            const float rstd = __builtin_amdgcn_rsqf(wave_sum(s2) * (1.f / D) + LN_EPS);
            const int cidx = row < NCTX ? 0 : 1 + ((row - NCTX) >> 10);
            const float* shp = MODp + ((size_t)ml * 5 + cidx) * 12288 + mi * D; const float* scp = shp + D;
            bf16* ho = H + (size_t)row * D + 8 * lane;
#pragma unroll
            for (int j = 0; j < 4; ++j) { const int co = 8 * lane + 512 * j;
                const f32x4 h0 = v[2 * j] * rstd * (*(const f32x4*)(scp + co) + 1.0f) + *(const f32x4*)(shp + co), h1 = v[2 * j + 1] * rstd * (*(const f32x4*)(scp + co + 4) + 1.0f) + *(const f32x4*)(shp + co + 4);
                v4u w; w.x = cvt_pk_bf16(h0[0], h0[1]); w.y = cvt_pk_bf16(h0[2], h0[3]); w.z = cvt_pk_bf16(h1[0], h1[1]); w.w = cvt_pk_bf16(h1[2], h1[3]);
                *(v4u*)(ho + 512 * j) = w; }
        }
    }
}

__device__ __forceinline__ void shift8(const bf16* F, unsigned fo, bool hp, bool hn, const float* mix, unsigned mo, float (&o)[8]) {
    const v4u c = *(const v4u*)(F + fo); v4u p = {0u, 0u, 0u, 0u}, n = {0u, 0u, 0u, 0u};
    if (hp) p = *(const v4u*)(F + (fo - NINP)); if (hn) n = *(const v4u*)(F + (fo + NINP));
    const f32x4 m0a = *(const f32x4*)(mix + mo), m0b = *(const f32x4*)(mix + (mo + 4)), m1a = *(const f32x4*)(mix + (mo + 1920)), m1b = *(const f32x4*)(mix + (mo + 1924));
#pragma unroll
    for (int w = 0; w < 4; ++w) { const unsigned cw = c[w], pw = p[w], nw = n[w];
        const float f0 = bf_lo(cw), f1 = bf_hi(cw); const float m00 = w < 2 ? m0a[2 * w] : m0b[2 * w - 4], m01 = w < 2 ? m0a[2 * w + 1] : m0b[2 * w - 3];
        const float m10 = w < 2 ? m1a[2 * w] : m1b[2 * w - 4], m11 = w < 2 ? m1a[2 * w + 1] : m1b[2 * w - 3];
        o[2 * w] = f0 + m00 * (bf_lo(pw) - f0) + m10 * (bf_lo(nw) - f0); o[2 * w + 1] = f1 + m01 * (bf_hi(pw) - f1) + m11 * (bf_hi(nw) - f1); }
}
__device__ __forceinline__ f32x4 shift4(const bf16* F, unsigned fo, bool hp, bool hn, const float* mix, unsigned mo) {
    const v2u c = *(const v2u*)(F + fo); v2u p = {0u, 0u}, n = {0u, 0u};
    if (hp) p = *(const v2u*)(F + (fo - NINP)); if (hn) n = *(const v2u*)(F + (fo + NINP));
    const f32x4 m0 = *(const f32x4*)(mix + mo), m1 = *(const f32x4*)(mix + (mo + 1920));
    f32x4 f, pv, nv; f[0] = bf_lo(c.x); f[1] = bf_hi(c.x); f[2] = bf_lo(c.y); f[3] = bf_hi(c.y);
    pv[0] = bf_lo(p.x); pv[1] = bf_hi(p.x); pv[2] = bf_lo(p.y); pv[3] = bf_hi(p.y); nv[0] = bf_lo(n.x); nv[1] = bf_hi(n.x); nv[2] = bf_lo(n.y); nv[3] = bf_hi(n.y);
    return f + m0 * (pv - f) + m1 * (nv - f);
}
__device__ __forceinline__ float ftanh(float x) { return 1.0f - 2.0f * __builtin_amdgcn_rcpf(1.0f + __expf(2.0f * x)); }
__device__ __forceinline__ bf16x8 pack8(const float (&o)[8]) { v4u w; w.x = cvt_pk_bf16(o[0], o[1]); w.y = cvt_pk_bf16(o[2], o[3]); w.z = cvt_pk_bf16(o[4], o[5]); w.w = cvt_pk_bf16(o[6], o[7]); return __builtin_bit_cast(bf16x8, w); }
__device__ __forceinline__ float logsigmoid(float z) { const float e = __expf(-fabsf(z)); return fminf(z, 0.f) - __logf(1.0f + e); }

__device__ __forceinline__ void phase_pre(ArgsRef a, unsigned char* ws, int l, int gw, int NGW, int lane) {
    const bf16* F = (const bf16*)(ws + WS_F);
    const float* mix = a.in[16] + (size_t)l * 2 * 1920;
    const float* w0 = a.in[17] + l * 1024; const float* a0 = a.in[19] + l * 1024;
    const float* kkw = a.in[22] + l * 512; const float* kaw = a.in[23] + l * 512; const float* rkw = a.in[24] + l * 512;
    const bf16* W2T = (const bf16*)(ws + WS_W2T) + (size_t)l * 2 * 512 * 64; const bf16* A2T = (const bf16*)(ws + WS_A2T) + (size_t)l * 2 * 512 * 64;
    const bf16* G2T = (const bf16*)(ws + WS_G2T) + (size_t)l * 512 * 128;
    float* SI = (float*)(ws + WS_SI); float* Gb = (float*)(ws + WS_G); float* BON = (float*)(ws + WS_BON);
    for (int u = 4096 + gw; u < 4096 + 8192; u += NGW) {
        int q = lane & 15, g = lane >> 4; asm volatile("" : "+v"(q), "+v"(g));
        if (u < 4096) {
            const int tile = u >> 3, hh = u & 7, row = tile * 16 + q;
            const int T = row < NCTX ? 256 : 1024, pos = row & (T - 1); const bool hp = pos > 0, hn = pos < T - 1;
            const unsigned fo = (unsigned)row * NINP + C_RW;
            float t8[8]; f32x4 af[4], ab[4];
            const unsigned ao = (unsigned)(hh * 64 + q) * 64 + 8 * g, go = (unsigned)(hh * 64 + q) * 128 + 8 * g;
            const unsigned c40 = hh * 64 + 4 * g;
            const unsigned so = ((unsigned)hh * MT + row) * 384 + 4 * g;
#pragma unroll
            for (int d = 0; d < 2; ++d) { f32x4 acc[4];
#pragma unroll
                for (int rb = 0; rb < 4; ++rb) acc[rb] = (f32x4){0.f, 0.f, 0.f, 0.f};
#pragma unroll
                for (int ks = 0; ks < 2; ++ks) { const unsigned cb = 32 * ks + 8 * g; shift8(F, fo + 1536 + 64 * d + cb, hp, hn, mix, 1536 + 64 * d + cb, t8);
#pragma unroll
                    for (int e = 0; e < 8; ++e) t8[e] = ftanh(t8[e]);
                    const bf16x8 bop = pack8(t8);
#pragma unroll
                    for (int rb = 0; rb < 4; ++rb) acc[rb] = mfma16(*(const bf16x8*)(W2T + (ao + 32768 * d + 1024 * rb + 32 * ks)), bop, acc[rb]); }
#pragma unroll
                for (int rb = 0; rb < 4; ++rb) { const f32x4 wz = *(const f32x4*)(w0 + (512 * d + c40 + 16 * rb)); f32x4 dec;
#pragma unroll
                    for (int e = 0; e < 4; ++e) dec[e] = __expf(-__expf(logsigmoid(wz[e] + acc[rb][e]) - 0.5f));
                    *(f32x4*)(SI + (so + 8u * MT * 384u * d + 16 * rb + 64)) = dec; }
                asm volatile("" ::: "memory"); }
#pragma unroll
            for (int d = 0; d < 2; ++d) { f32x4 acc[4];
#pragma unroll
                for (int rb = 0; rb < 4; ++rb) acc[rb] = (f32x4){0.f, 0.f, 0.f, 0.f};
#pragma unroll
                for (int ks = 0; ks < 2; ++ks) { const unsigned cb = 32 * ks + 8 * g; shift8(F, fo + 1664 + 64 * d + cb, hp, hn, mix, 1664 + 64 * d + cb, t8);
                    const bf16x8 bop = pack8(t8);
#pragma unroll
                    for (int rb = 0; rb < 4; ++rb) acc[rb] = mfma16(*(const bf16x8*)(A2T + (ao + 32768 * d + 1024 * rb + 32 * ks)), bop, acc[rb]); }
#pragma unroll
                for (int rb = 0; rb < 4; ++rb) { const f32x4 az = *(const f32x4*)(a0 + (512 * d + c40 + 16 * rb));
#pragma unroll
                    for (int e = 0; e < 4; ++e) { const float v = sigm(az[e] + acc[rb][e]); if (d == 0) af[rb][e] = v; else ab[rb][e] = v; } }
                asm volatile("" ::: "memory"); }
            { f32x4 acc[4];
#pragma unroll
                for (int rb = 0; rb < 4; ++rb) acc[rb] = (f32x4){0.f, 0.f, 0.f, 0.f};
#pragma unroll
                for (int ks = 0; ks < 4; ++ks) { const unsigned cb = 32 * ks + 8 * g; shift8(F, fo + 1792 + cb, hp, hn, mix, 1792 + cb, t8);
#pragma unroll
                    for (int e = 0; e < 8; ++e) t8[e] = sigm(t8[e]);
                    const bf16x8 bop = pack8(t8);
#pragma unroll
                    for (int rb = 0; rb < 4; ++rb) acc[rb] = mfma16(*(const bf16x8*)(G2T + (go + 2048 * rb + 32 * ks)), bop, acc[rb]); }
#pragma unroll
                for (int rb = 0; rb < 4; ++rb) *(f32x4*)(Gb + ((unsigned)row * 512 + c40 + 16 * rb)) = acc[rb];
                asm volatile("" ::: "memory"); }
            float ss = 0.f;
#pragma unroll
            for (int rb = 0; rb < 4; ++rb) { const unsigned c4 = c40 + 16 * rb;
                const f32x4 kv = shift4(F, fo + 512 + c4, hp, hn, mix, 512 + c4) * *(const f32x4*)(kkw + c4); ss += (kv[0] * kv[0] + kv[1] * kv[1]) + (kv[2] * kv[2] + kv[3] * kv[3]); }
            ss = xrow16_sum(ss);
            const float kinv = __builtin_amdgcn_rcpf(fmaxf(__builtin_amdgcn_sqrtf(ss), 1e-12f));
            float bonus = 0.f;
            asm volatile("" ::: "memory");
#pragma unroll
            for (int rb = 0; rb < 4; ++rb) { const unsigned c4 = c40 + 16 * rb;
                const f32x4 rr = shift4(F, fo + c4, hp, hn, mix, c4), kh = shift4(F, fo + 512 + c4, hp, hn, mix, 512 + c4), vv = shift4(F, fo + 1024 + c4, hp, hn, mix, 1024 + c4);
                const f32x4 kkv = kh * *(const f32x4*)(kkw + c4);
                const f32x4 kav = *(const f32x4*)(kaw + c4), rkv = *(const f32x4*)(rkw + c4);
                f32x4 kdf, kdb, bf, bb, nkk;
#pragma unroll
                for (int e = 0; e < 4; ++e) {
                    kdf[e] = kh[e] * (1.0f + (af[rb][e] - 1.0f) * kav[e]); kdb[e] = kh[e] * (1.0f + (ab[rb][e] - 1.0f) * kav[e]);
                    const float kn = kkv[e] * kinv; nkk[e] = -kn; bf[e] = kn * af[rb][e]; bb[e] = kn * ab[rb][e];
                    bonus += rr[e] * rkv[e] * (kdf[e] + kdb[e]); }
                const unsigned s0 = so + 16 * rb, s1 = s0 + 8u * MT * 384u;
                *(f32x4*)(SI + s0) = rr; *(f32x4*)(SI + (s0 + 128)) = kdf; *(f32x4*)(SI + (s0 + 192)) = vv; *(f32x4*)(SI + (s0 + 256)) = nkk; *(f32x4*)(SI + (s0 + 320)) = bf;
                *(f32x4*)(SI + s1) = rr; *(f32x4*)(SI + (s1 + 128)) = kdb; *(f32x4*)(SI + (s1 + 192)) = vv; *(f32x4*)(SI + (s1 + 256)) = nkk; *(f32x4*)(SI + (s1 + 320)) = bb;
                asm volatile("" ::: "memory"); }
            bonus = xrow16_sum(bonus);
            if (g == 0) BON[(size_t)row * 8 + hh] = bonus;
        } else {
            const int v = u - 4096, lr = v >> 1, isk = v & 1;
            const bf16* src = F + (size_t)(NCTX + lr) * NINP + (isk ? C_DFK : C_DFQ) + 8 * lane;
            const v4u x = *(const v4u*)src; v4u xp; xp.x = __shfl_xor(x.x, 2); xp.y = __shfl_xor(x.y, 2); xp.z = __shfl_xor(x.z, 2); xp.w = __shfl_xor(x.w, 2);
            const int seg = lane & 7, tpos = lr & 1023, pos = seg < 4 ? (tpos >> 6) : (tpos & 63); const bool second = (seg & 2) != 0;
            const float* rp = (const float*)(ws + WS_ROPE) + ((size_t)pos * 16 + 8 * (seg & 1)) * 2;
            float o[8];
#pragma unroll
            for (int w = 0; w < 4; ++w) { const unsigned xw = x[w], pw = xp[w];
                const float c0 = rp[4 * w], s0 = rp[4 * w + 1], c1 = rp[4 * w + 2], s1 = rp[4 * w + 3];
                o[2 * w] = second ? bf_lo(xw) * c0 + bf_lo(pw) * s0 : bf_lo(xw) * c0 - bf_lo(pw) * s0;
                o[2 * w + 1] = second ? bf_hi(xw) * c1 + bf_hi(pw) * s1 : bf_hi(xw) * c1 - bf_hi(pw) * s1; }
            v4u ow; ow.x = cvt_pk_bf16(o[0], o[1]); ow.y = cvt_pk_bf16(o[2], o[3]); ow.z = cvt_pk_bf16(o[4], o[5]); ow.w = cvt_pk_bf16(o[6], o[7]);
            *(v4u*)((bf16*)(ws + (isk ? WS_KR : WS_QR)) + (size_t)lr * 512 + 8 * lane) = ow;
        }
    }
}

__device__ __forceinline__ void phase_rope(unsigned char* ws, int gw, int NGW, int lane) {
    const bf16* F = (const bf16*)(ws + WS_F); const float* ropet = (const float*)(ws + WS_ROPE);
    const int seg = lane & 7; const bool second = (seg & 2) != 0;
    for (int u0 = gw; u0 < 8192; u0 += 4 * NGW) {
        v4u x[4]; f32x4 t[4][4];
#pragma unroll
        for (int i = 0; i < 4; ++i) { const int v = u0 + i * NGW; if (v < 8192) { const int lr = v >> 1, isk = v & 1, tpos = lr & 1023, pos = seg < 4 ? (tpos >> 6) : (tpos & 63);
                x[i] = *(const v4u*)(F + (size_t)(NCTX + lr) * NINP + (isk ? C_DFK : C_DFQ) + 8 * lane);
                const float* rp = ropet + ((size_t)pos * 16 + 8 * (seg & 1)) * 2;
#pragma unroll
                for (int w = 0; w < 4; ++w) t[i][w] = *(const f32x4*)(rp + 4 * w); } }
#pragma unroll
        for (int i = 0; i < 4; ++i) { const int v = u0 + i * NGW; if (v < 8192) { const int lr = v >> 1, isk = v & 1;
                v4u xp; xp.x = __shfl_xor(x[i].x, 2); xp.y = __shfl_xor(x[i].y, 2); xp.z = __shfl_xor(x[i].z, 2); xp.w = __shfl_xor(x[i].w, 2);
                v4u ow;
#pragma unroll
                for (int w = 0; w < 4; ++w) { const unsigned xw = x[i][w], pw = xp[w]; const f32x4 cs = t[i][w];
                    const float o0 = second ? bf_lo(xw) * cs[0] + bf_lo(pw) * cs[1] : bf_lo(xw) * cs[0] - bf_lo(pw) * cs[1];
                    const float o1 = second ? bf_hi(xw) * cs[2] + bf_hi(pw) * cs[3] : bf_hi(xw) * cs[2] - bf_hi(pw) * cs[3];
                    ow[w] = cvt_pk_bf16(o0, o1); }
                *(v4u*)((bf16*)(ws + (isk ? WS_KR : WS_QR)) + (size_t)lr * 512 + 8 * lane) = ow; } }
    }
}

constexpr size_t WS_OPS = 1157 * MiB; constexpr int OPS_BLOCK = 21 * 512, N_CHUNKS = 8192;
#define IMO(i) ((((i) >> 1) * 1024) + (((i) & 1) * 8))
typedef _Float16 h16x4 __attribute__((ext_vector_type(4)));
__device__ __forceinline__ f32x4 mfma16k(v2u a, v2u b, f32x4 c) { return __builtin_amdgcn_mfma_f32_16x16x16f16(__builtin_bit_cast(h16x4, a), __builtin_bit_cast(h16x4, b), c, 0, 0, 0); }
__device__ __forceinline__ v2u pk4(f32x4 v) { v2u r; r.x = cvt_pk_bf16(v[0], v[1]); r.y = cvt_pk_bf16(v[2], v[3]); return r; }
__device__ __forceinline__ unsigned short h1(float v) { return __builtin_bit_cast(unsigned short, (_Float16)v); }
struct ChunkId { int dh, T, tokbase, c; };
__device__ __forceinline__ ChunkId chunk_decode(int cu) { ChunkId k; k.dh = cu >> 9; const int cid = cu & 511;
    if (cid < 256) { k.T = 256; k.tokbase = (cid >> 4) * 256; k.c = cid & 15; } else { k.T = 1024; k.tokbase = NCTX + ((cid - 256) >> 6) * 1024; k.c = (cid - 256) & 63; } return k; }
constexpr size_t WS_V = WS_SI;
constexpr int FT_PITCH = 3856, MX_OFF = 18 * FT_PITCH, BO_OFF = MX_OFF + 2 * 1920 * 4, PRE_LDS = BO_OFF + 12 * 1024;
static_assert(MX_OFF % 16 == 0 && PRE_LDS <= RING_BYTES, "pre-pass LDS map");
__device__ __forceinline__ void shift8_lds(const LAS unsigned char* ft  , const LAS float* mx  , float (&o)[8]) {
    const v4u c = *(const LAS v4u*)ft, p = *(const LAS v4u*)(ft - FT_PITCH), n = *(const LAS v4u*)(ft + FT_PITCH);
    const f32x4 m0a = *(const LAS f32x4*)mx, m0b = *(const LAS f32x4*)(mx + 4), m1a = *(const LAS f32x4*)(mx + 1920), m1b = *(const LAS f32x4*)(mx + 1924);
#pragma unroll
    for (int w = 0; w < 4; ++w) { const unsigned cw = c[w], pw = p[w], nw = n[w];
        const float f0 = bf_lo(cw), f1 = bf_hi(cw); const float m00 = w < 2 ? m0a[2 * w] : m0b[2 * w - 4], m01 = w < 2 ? m0a[2 * w + 1] : m0b[2 * w - 3];
        const float m10 = w < 2 ? m1a[2 * w] : m1b[2 * w - 4], m11 = w < 2 ? m1a[2 * w + 1] : m1b[2 * w - 3];
        o[2 * w] = f0 + m00 * (bf_lo(pw) - f0) + m10 * (bf_lo(nw) - f0); o[2 * w + 1] = f1 + m01 * (bf_hi(pw) - f1) + m11 * (bf_hi(nw) - f1); }
}
__device__ __forceinline__ f32x4 shift4_lds(const LAS unsigned char* ft, const LAS float* mx) {
    const v2u c = *(const LAS v2u*)ft, p = *(const LAS v2u*)(ft - FT_PITCH), n = *(const LAS v2u*)(ft + FT_PITCH);
    const f32x4 m0 = *(const LAS f32x4*)mx, m1 = *(const LAS f32x4*)(mx + 1920);
    f32x4 f, pv, nv; f[0] = bf_lo(c.x); f[1] = bf_hi(c.x); f[2] = bf_lo(c.y); f[3] = bf_hi(c.y);
    pv[0] = bf_lo(p.x); pv[1] = bf_hi(p.x); pv[2] = bf_lo(p.y); pv[3] = bf_hi(p.y); nv[0] = bf_lo(n.x); nv[1] = bf_hi(n.x); nv[2] = bf_lo(n.y); nv[3] = bf_hi(n.y);
    return f + m0 * (pv - f) + m1 * (nv - f);
}
__device__ __forceinline__ void pre_tile(ArgsRef a, unsigned char* ws, int l, int tile, LAS unsigned char* lds, int tid) {
    const bf16* F = (const bf16*)(ws + WS_F);
    const float* mix = a.in[16] + (size_t)l * 2 * 1920;
    const float* w0 = a.in[17] + l * 1024; const float* a0 = a.in[19] + l * 1024;
    const float* kkw = a.in[22] + l * 512; const float* kaw = a.in[23] + l * 512; const float* rkw = a.in[24] + l * 512;
    const bf16* W2T = (const bf16*)(ws + WS_W2T) + (size_t)l * 2 * 512 * 64; const bf16* A2T = (const bf16*)(ws + WS_A2T) + (size_t)l * 2 * 512 * 64;
    const bf16* G2T = (const bf16*)(ws + WS_G2T) + (size_t)l * 512 * 128;
    float* SI = (float*)(ws + WS_SI); float* Gb = (float*)(ws + WS_G); float* BON = (float*)(ws + WS_BON);
    const int hh = __builtin_amdgcn_readfirstlane(tid >> 6), lane = tid & 63;
    int q = lane & 15, g = lane >> 4; asm volatile("" : "+v"(q), "+v"(g));
    const int tok0 = tile * 16, T = tok0 < NCTX ? 256 : 1024, pos0 = tok0 & (T - 1);
    for (int i = tid; i < 18 * 240; i += 512) { const int r = i / 240, c = i - r * 240, pos = pos0 + r - 1;
        v4u v = {0u, 0u, 0u, 0u}; if (pos >= 0 && pos < T) v = *(const v4u*)(F + (size_t)(tok0 + r - 1) * NINP + C_RW + c * 8);
        *(LAS v4u*)(lds + r * FT_PITCH + c * 16) = v; }
    for (int i = tid; i < 960; i += 512) *(LAS f32x4*)(lds + MX_OFF + 16 * i) = *(const f32x4*)(mix + 4 * i);
    __syncthreads();
    const LAS unsigned char* ftq = lds + (q + 1) * FT_PITCH; const LAS float* mx = (const LAS float*)(lds + MX_OFF);
    float t8[8];
    for (int op = hh; op < 12; op += 8) {
        const int chb = op < 2 ? 1536 : (op < 4 ? 1600 : (op < 6 ? 1664 : (op < 8 ? 1728 : 1792))), ks = op < 8 ? (op & 1) : (op - 8), ch = chb + 32 * ks + 8 * g;
        shift8_lds(ftq + ch * 2, mx + ch, t8);
        if (op < 4) {
#pragma unroll
            for (int e = 0; e < 8; ++e) t8[e] = ftanh(t8[e]); }
        else if (op >= 8) {
#pragma unroll
            for (int e = 0; e < 8; ++e) t8[e] = sigm(t8[e]); }
        *(LAS bf16x8*)(lds + BO_OFF + op * 1024 + lane * 16) = pack8(t8);
    }
    __syncthreads();
    const LAS unsigned char* bo = lds + BO_OFF + lane * 16;
    const int row = tok0 + q;
    const unsigned ao = (unsigned)(hh * 64 + q) * 64 + 8 * g, go = (unsigned)(hh * 64 + q) * 128 + 8 * g;
    const unsigned c40 = hh * 64 + 4 * g;
    { f32x4 acc[4];
#pragma unroll
        for (int rb = 0; rb < 4; ++rb) acc[rb] = (f32x4){0.f, 0.f, 0.f, 0.f};
#pragma unroll
        for (int ks = 0; ks < 4; ++ks) { const bf16x8 bop = *(const LAS bf16x8*)(bo + (8 + ks) * 1024);
#pragma unroll
            for (int rb = 0; rb < 4; ++rb) acc[rb] = mfma16(*(const bf16x8*)(G2T + (go + 2048 * rb + 32 * ks)), bop, acc[rb]); }
#pragma unroll
        for (int rb = 0; rb < 4; ++rb) *(v2u*)((bf16*)Gb + ((unsigned)row * 512 + c40 + 16 * rb)) = pk4(acc[rb]);
        asm volatile("" ::: "memory"); }
    float ss = 0.f;
#pragma unroll
    for (int rb = 0; rb < 4; ++rb) { const unsigned c4 = c40 + 16 * rb;
        const f32x4 kv = shift4_lds(ftq + (512 + c4) * 2, mx + 512 + c4) * *(const f32x4*)(kkw + c4); ss += (kv[0] * kv[0] + kv[1] * kv[1]) + (kv[2] * kv[2] + kv[3] * kv[3]); }
    ss = xrow16_sum(ss);
    const float kinv = __builtin_amdgcn_rcpf(fmaxf(__builtin_amdgcn_sqrtf(ss), 1e-12f));
    float bonus = 0.f;
    const int tq = tile < 256 ? (tile & 15) : ((tile - 256) & 63), nct = tile < 256 ? 16 : 64, sb = tile < 256 ? (tile >> 4) : ((tile - 256) >> 6);
    const int cid_f = (tile < 256 ? sb * 16 : 256 + sb * 64) + tq, cid_b = (tile < 256 ? sb * 16 : 256 + sb * 64) + (nct - 1 - tq);
    const f32x4 z4 = {0.f, 0.f, 0.f, 0.f};
    v2u idop; { f32x4 idv;
#pragma unroll
        for (int e = 0; e < 4; ++e) idv[e] = (4 * g + e == q) ? 1.f : 0.f; idop = pk4(idv); }
#pragma unroll
    for (int d = 0; d < 2; ++d) {
        f32x4 cBe = z4, cBt = z4, cKa = z4, cRb = z4, cRk = z4;
        f32x4 decd[4], asd[4];
        { f32x4 acc[4];
#pragma unroll
          for (int rb = 0; rb < 4; ++rb) acc[rb] = z4;
#pragma unroll
          for (int ks = 0; ks < 2; ++ks) { const bf16x8 bop = *(const LAS bf16x8*)(bo + (2 * d + ks) * 1024);
#pragma unroll
              for (int rb = 0; rb < 4; ++rb) acc[rb] = mfma16(*(const bf16x8*)(W2T + (ao + 32768 * d + 1024 * rb + 32 * ks)), bop, acc[rb]); }
#pragma unroll
          for (int rb = 0; rb < 4; ++rb) { const f32x4 wz = *(const f32x4*)(w0 + (512 * d + c40 + 16 * rb));
#pragma unroll
              for (int e = 0; e < 4; ++e) decd[rb][e] = __expf(-__expf(logsigmoid(wz[e] + acc[rb][e]) - 0.5f)); }
          asm volatile("" ::: "memory");
#pragma unroll
          for (int rb = 0; rb < 4; ++rb) acc[rb] = z4;
#pragma unroll
          for (int ks = 0; ks < 2; ++ks) { const bf16x8 bop = *(const LAS bf16x8*)(bo + (4 + 2 * d + ks) * 1024);
#pragma unroll
              for (int rb = 0; rb < 4; ++rb) acc[rb] = mfma16(*(const bf16x8*)(A2T + (ao + 32768 * d + 1024 * rb + 32 * ks)), bop, acc[rb]); }
#pragma unroll
          for (int rb = 0; rb < 4; ++rb) { const f32x4 az = *(const f32x4*)(a0 + (512 * d + c40 + 16 * rb));
#pragma unroll
              for (int e = 0; e < 4; ++e) asd[rb][e] = sigm(az[e] + acc[rb][e]); }
          asm volatile("" ::: "memory"); }
        unsigned oo = (unsigned)((d * 8 + hh) * 512 + (d == 0 ? cid_f : cid_b)) * OPS_BLOCK + lane * 16;
        unsigned char* ops = ws + WS_OPS + oo;
#pragma unroll
        for (int rb = 0; rb < 4; ++rb) { const unsigned c4 = c40 + 16 * rb;
            const f32x4 rr = shift4_lds(ftq + c4 * 2, mx + c4), kh = shift4_lds(ftq + (512 + c4) * 2, mx + 512 + c4);
            const f32x4 kkv = kh * *(const f32x4*)(kkw + c4), kav = *(const f32x4*)(kaw + c4);
            const f32x4 as = asd[rb], wv = decd[rb];
            f32x4 kd, bv, nkk;
#pragma unroll
            for (int e = 0; e < 4; ++e) { kd[e] = kh[e] * (1.0f + (as[e] - 1.0f) * kav[e]); const float kn = kkv[e] * kinv; nkk[e] = -kn; bv[e] = kn * as[e]; }
            { const f32x4 rkv = *(const f32x4*)(rkw + c4);
#pragma unroll
              for (int e = 0; e < 4; ++e) bonus += rr[e] * rkv[e] * kd[e]; }
            if (d == 0) *(v2u*)((bf16*)(ws + WS_V) + ((unsigned)row * 512 + c4)) = pk4(shift4_lds(ftq + (1024 + c4) * 2, mx + 1024 + c4));
            f32x4 gi, gx, gc;
#pragma unroll
            for (int e = 0; e < 4; ++e) { float x = wv[e];
                if (d == 0) { x *= dppf<0x111>(x); x *= dppf<0x112>(x); x *= dppf<0x114>(x); x *= dppf<0x118>(x); gx[e] = dppf<0x111>(x); }
                else        { x *= dppf<0x101>(x); x *= dppf<0x102>(x); x *= dppf<0x104>(x); x *= dppf<0x108>(x); gx[e] = dppf<0x101>(x); }
                gi[e] = x; gc[e] = __shfl(x, (lane & 48) | (d == 0 ? 15 : 0)); }
            f32x4 ginv;
#pragma unroll
            for (int e = 0; e < 4; ++e) ginv[e] = __builtin_amdgcn_rcpf(gi[e]);
            const v2u aop = pk4(gx * nkk), rop = pk4(gi * rr), bop = pk4(bv * ginv), kop = pk4(kd * ginv), btop = pk4(bv * ginv * gc), ktop = pk4(kd * ginv * gc);
            { const v2u bt_ = pk4(mfma16k(btop, idop, z4)), kt_ = pk4(mfma16k(ktop, idop, z4));
              *(v4u*)(ops + rb * 1024) = (v4u){aop.x, aop.y, rop.x, rop.y}; *(v4u*)(ops + (4 + rb) * 1024) = (v4u){bt_.x, bt_.y, kt_.x, kt_.y}; }
            if (q == (d == 0 ? 15 : 0)) *(f32x4*)(ops - lane * 16 + 20 * 512 + (16 * rb + 4 * g) * 4) = gi;
            cBe = mfma16k(bop, aop, cBe); cBt = mfma16k(aop, bop, cBt); cKa = mfma16k(kop, aop, cKa); cRb = mfma16k(bop, rop, cRb); cRk = mfma16k(kop, rop, cRk);
            asm volatile("" ::: "memory"); }
        f32x4 Beta = cBe, BetaT = cBt, Kap = cKa, Rb = cRb, Rk = cRk, Id;
#pragma unroll
        for (int e = 0; e < 4; ++e) { const int rw = 4 * g + e;
            const bool jt = d == 0 ? rw < q : rw > q, tj = d == 0 ? q < rw : q > rw, je = d == 0 ? rw <= q : rw >= q;
            if (!jt) { Beta[e] = 0.f; Kap[e] = 0.f; } if (!tj) BetaT[e] = 0.f; if (!je) { Rb[e] = 0.f; Rk[e] = 0.f; }
            Id[e] = rw == q ? 1.f : 0.f; }
        const v2u kap_ = pk4(Kap), rb_ = pk4(Rb), rk_ = pk4(Rk);
        const f32x4 B2 = mfma16k(pk4(BetaT), pk4(Beta), z4), B2T = mfma16k(pk4(Beta), pk4(BetaT), z4);
        const f32x4 B4 = mfma16k(pk4(B2T), pk4(B2), z4), B4T = mfma16k(pk4(B2), pk4(B2T), z4);
        const f32x4 B8 = mfma16k(pk4(B4T), pk4(B4), z4);
        const f32x4 T1 = mfma16k(pk4(Id + BetaT), pk4(Id + B2), z4), T1T = mfma16k(pk4(Id + B2), pk4(Id + BetaT), z4);
        const f32x4 T2 = mfma16k(pk4(Id + B4T), pk4(Id + B8), z4);
        { const v2u tt_ = pk4(mfma16k(pk4(T1T), pk4(T2), z4)); *(v4u*)(ops + 8 * 1024) = (v4u){kap_.x, kap_.y, tt_.x, tt_.y}; *(v4u*)(ops + 9 * 1024) = (v4u){rb_.x, rb_.y, rk_.x, rk_.y}; }
        asm volatile("" ::: "memory"); }
    bonus = xrow16_sum(bonus);
    if (g == 0) BON[(size_t)row * 8 + hh] = bonus;
    __syncthreads();
}

__device__ __forceinline__ void phase_post(ArgsRef a, unsigned char* ws, int l, int gw, int NGW, int lane) {
    const bf16* Y = (const bf16*)(ws + WS_Y); const bf16* Gb = (const bf16*)(ws + WS_G); const bf16* Vb = (const bf16*)(ws + WS_V); const float* BON = (const float*)(ws + WS_BON);
    bf16* O3 = (bf16*)(ws + WS_O3) + 1024;
    const float* lng = a.in[25] + l * 512; const float* lnb = a.in[26] + l * 512;
    const int c = 8 * lane, hh = lane >> 3;
    for (int row0 = gw; row0 < MT; row0 += 4 * NGW) {
        v4u yfw[4], ybw[4], vw[4], gw4[4]; float bon[4];
#pragma unroll
        for (int i = 0; i < 4; ++i) { const int row = row0 + i * NGW; if (row < MT) {
            yfw[i] = *(const v4u*)(Y + (size_t)row * 512 + c); ybw[i] = *(const v4u*)(Y + (size_t)(MT + row) * 512 + c);
            vw[i] = *(const v4u*)(Vb + (size_t)row * 512 + c); gw4[i] = *(const v4u*)(Gb + (size_t)row * 512 + c); bon[i] = BON[(size_t)row * 8 + hh]; } }
#pragma unroll
        for (int i = 0; i < 4; ++i) { const int row = row0 + i * NGW; if (row < MT) {
            f32x4 y0 = {bf_lo(yfw[i].x) + bf_lo(ybw[i].x), bf_hi(yfw[i].x) + bf_hi(ybw[i].x), bf_lo(yfw[i].y) + bf_lo(ybw[i].y), bf_hi(yfw[i].y) + bf_hi(ybw[i].y)};
            f32x4 y1 = {bf_lo(yfw[i].z) + bf_lo(ybw[i].z), bf_hi(yfw[i].z) + bf_hi(ybw[i].z), bf_lo(yfw[i].w) + bf_lo(ybw[i].w), bf_hi(yfw[i].w) + bf_hi(ybw[i].w)};
            float s = (y0[0] + y0[1]) + (y0[2] + y0[3]) + (y1[0] + y1[1]) + (y1[2] + y1[3]); s = red8(s);
            const float mu = s * (1.f / 64.f); y0 = y0 - mu; y1 = y1 - mu;
            float s2 = (y0[0] * y0[0] + y0[1] * y0[1]) + (y0[2] * y0[2] + y0[3] * y0[3]) + (y1[0] * y1[0] + y1[1] * y1[1]) + (y1[2] * y1[2] + y1[3] * y1[3]); s2 = red8(s2);
            const float rstd = __builtin_amdgcn_rsqf(s2 * (1.f / 64.f) + 64e-5f);
            const f32x4 v0 = {bf_lo(vw[i].x), bf_hi(vw[i].x), bf_lo(vw[i].y), bf_hi(vw[i].y)}, v1 = {bf_lo(vw[i].z), bf_hi(vw[i].z), bf_lo(vw[i].w), bf_hi(vw[i].w)};
            const f32x4 g0 = {bf_lo(gw4[i].x), bf_hi(gw4[i].x), bf_lo(gw4[i].y), bf_hi(gw4[i].y)}, g1 = {bf_lo(gw4[i].z), bf_hi(gw4[i].z), bf_lo(gw4[i].w), bf_hi(gw4[i].w)};
            const f32x4 o0 = (y0 * rstd * *(const f32x4*)(lng + c) + *(const f32x4*)(lnb + c) + v0 * bon[i]) * g0;
            const f32x4 o1 = (y1 * rstd * *(const f32x4*)(lng + c + 4) + *(const f32x4*)(lnb + c + 4) + v1 * bon[i]) * g1;
            v4u w; w.x = cvt_pk_bf16(o0[0], o0[1]); w.y = cvt_pk_bf16(o0[2], o0[3]); w.z = cvt_pk_bf16(o1[0], o1[1]); w.w = cvt_pk_bf16(o1[2], o1[3]);
            *(v4u*)(O3 + (size_t)row * 1536 + c) = w; } }
    }
}

__device__ __forceinline__ void scan_unit(ArgsRef a, unsigned char* ws, int l, bool lat, int b, int head, int dir, int half, LAS unsigned char* lds, int tid) {
    const int T = lat ? 1024 : 256, tokbase = lat ? NCTX + b * 1024 : b * 256, nch = T / 32;
    const bool active = !lat || tid < 256;
    const int row = (lat ? 32 * half : 0) + ((lat ? (tid & 255) : tid) >> 3), kseg = tid & 7;
    const float* si = (const float*)(ws + WS_SI) + ((size_t)(dir * 8 + head) * MT + tokbase) * 384;
    float* Yo = (float*)(ws + WS_Y) + ((size_t)dir * MT + tokbase) * 512 + head * 64;
    pg8::f32x2 S2[4];
    if (lat) { const float* sp = a.in[dir == 0 ? 6 : 7] + ((size_t)(b * 4 + l) * 8 + head) * 4096 + row * 64 + 8 * kseg;
        const f32x4 s0 = *(const f32x4*)sp, s1 = *(const f32x4*)(sp + 4); S2[0] = (pg8::f32x2){s0[0], s0[1]}; S2[1] = (pg8::f32x2){s0[2], s0[3]}; S2[2] = (pg8::f32x2){s1[0], s1[1]}; S2[3] = (pg8::f32x2){s1[2], s1[3]}; }
    else {
#pragma unroll
        for (int i = 0; i < 4; ++i) S2[i] = (pg8::f32x2){0.f, 0.f}; }
    LAS float* buf0 = (LAS float*)lds; LAS float* ybuf0 = (LAS float*)(lds + 98304);
    f32x4 pre[6];
    { const int tok0 = dir == 0 ? 0 : T - 32; const f32x4* s4 = (const f32x4*)(si + (size_t)tok0 * 384);
#pragma unroll
      for (int j = 0; j < 6; ++j) pre[j] = s4[tid + 512 * j]; }
    for (int c = 0; c < nch; ++c) {
        LAS float* buf = buf0 + (c & 1) * 12288; LAS float* yb = ybuf0 + (c & 1) * 2048;
#pragma unroll
        for (int j = 0; j < 6; ++j) *(LAS f32x4*)(buf + 4 * (tid + 512 * j)) = pre[j];
        __syncthreads();
        if (c > 0) { const int tp = dir == 0 ? 32 * (c - 1) : T - 32 * c; LAS float* ybp = ybuf0 + ((c - 1) & 1) * 2048;
            if (!lat) *(f32x4*)(Yo + (size_t)(tp + (tid >> 4)) * 512 + 4 * (tid & 15)) = *(LAS f32x4*)(ybp + 4 * tid);
            else if (tid < 256) *(f32x4*)(Yo + (size_t)(tp + (tid >> 3)) * 512 + 32 * half + 4 * (tid & 7)) = *(LAS f32x4*)(ybp + (tid >> 3) * 64 + 32 * half + 4 * (tid & 7)); }
        if (c + 1 < nch) { const int tok0 = dir == 0 ? 32 * (c + 1) : T - 32 * (c + 2); const f32x4* s4 = (const f32x4*)(si + (size_t)tok0 * 384);
#pragma unroll
            for (int j = 0; j < 6; ++j) pre[j] = s4[tid + 512 * j]; }
        if (active)
#pragma unroll 2
        for (int s = 0; s < 32; ++s) {
            const int ti = dir == 0 ? s : 31 - s; const LAS float* rec = buf + ti * 384 + 8 * kseg;
            typedef pg8::f32x2 f2;
            const f32x4 a0 = *(const LAS f32x4*)(rec + 256), a1 = *(const LAS f32x4*)(rec + 260);
            const f32x4 w0 = *(const LAS f32x4*)(rec + 64), w1 = *(const LAS f32x4*)(rec + 68), b0 = *(const LAS f32x4*)(rec + 320), b1 = *(const LAS f32x4*)(rec + 324);
            const f32x4 k0 = *(const LAS f32x4*)(rec + 128), k1 = *(const LAS f32x4*)(rec + 132), r0 = *(const LAS f32x4*)(rec), r1 = *(const LAS f32x4*)(rec + 4);
            const float vv = buf[ti * 384 + 192 + row];
            f2 t = S2[0] * (f2){a0[0], a0[1]}; t = S2[1] * (f2){a0[2], a0[3]} + t; t = S2[2] * (f2){a1[0], a1[1]} + t; t = S2[3] * (f2){a1[2], a1[3]} + t;
            const float sa = red8(t.x + t.y);
            const f2 sa2 = {sa, sa}, vv2 = {vv, vv};
            S2[0] = S2[0] * (f2){w0[0], w0[1]} + sa2 * (f2){b0[0], b0[1]} + vv2 * (f2){k0[0], k0[1]};
            S2[1] = S2[1] * (f2){w0[2], w0[3]} + sa2 * (f2){b0[2], b0[3]} + vv2 * (f2){k0[2], k0[3]};
            S2[2] = S2[2] * (f2){w1[0], w1[1]} + sa2 * (f2){b1[0], b1[1]} + vv2 * (f2){k1[0], k1[1]};
            S2[3] = S2[3] * (f2){w1[2], w1[3]} + sa2 * (f2){b1[2], b1[3]} + vv2 * (f2){k1[2], k1[3]};
            f2 u = S2[0] * (f2){r0[0], r0[1]}; u = S2[1] * (f2){r0[2], r0[3]} + u; u = S2[2] * (f2){r1[0], r1[1]} + u; u = S2[3] * (f2){r1[2], r1[3]} + u;
            const float y = red8(u.x + u.y);
            if (kseg == 0) yb[ti * 64 + row] = y;
        }
    }
    __syncthreads();
    { const int tp = dir == 0 ? 32 * (nch - 1) : 0; LAS float* ybp = ybuf0 + ((nch - 1) & 1) * 2048;
      if (!lat) *(f32x4*)(Yo + (size_t)(tp + (tid >> 4)) * 512 + 4 * (tid & 15)) = *(LAS f32x4*)(ybp + 4 * tid);
      else if (tid < 256) *(f32x4*)(Yo + (size_t)(tp + (tid >> 3)) * 512 + 32 * half + 4 * (tid & 7)) = *(LAS f32x4*)(ybp + (tid >> 3) * 64 + 32 * half + 4 * (tid & 7)); }
    if (!lat) { float* op = a.out + (dir == 0 ? OUT_RF : OUT_RB) + ((size_t)(b * 4 + l) * 8 + head) * 4096 + row * 64 + 8 * kseg;
        *(f32x4*)op = (f32x4){S2[0].x, S2[0].y, S2[1].x, S2[1].y}; *(f32x4*)(op + 4) = (f32x4){S2[2].x, S2[2].y, S2[3].x, S2[3].y}; }
    __syncthreads();
}

__device__ __forceinline__ void scan_pair_ctx(ArgsRef a, unsigned char* ws, int l, int b, int head, LAS unsigned char* lds, int tid) {
    typedef pg8::f32x2 f2;
    const int d = tid >> 8, gt = tid & 255, lr = gt >> 3, kseg = gt & 7, tokbase = b * 256;
    const float* si = (const float*)(ws + WS_SI) + ((size_t)(d * 8 + head) * MT + tokbase) * 384;
    float* Yo = (float*)(ws + WS_Y) + ((size_t)d * MT + tokbase) * 512 + head * 64;
    LAS float* buf0 = (LAS float*)(lds + d * 57344); LAS float* ybuf0 = (LAS float*)(lds + d * 57344 + 49152);
    f2 SA[4], SB[4];
#pragma unroll
    for (int i = 0; i < 4; ++i) { SA[i] = (f2){0.f, 0.f}; SB[i] = (f2){0.f, 0.f}; }
    f32x4 pre[6];
    { const int tok0 = d == 0 ? 0 : 256 - 16; const f32x4* s4 = (const f32x4*)(si + (size_t)tok0 * 384);
#pragma unroll
      for (int j = 0; j < 6; ++j) pre[j] = s4[gt + 256 * j]; }
    for (int c = 0; c < 16; ++c) {
        LAS float* buf = buf0 + (c & 1) * 6144; LAS float* yb = ybuf0 + (c & 1) * 1024;
#pragma unroll
        for (int j = 0; j < 6; ++j) *(LAS f32x4*)(buf + 4 * (gt + 256 * j)) = pre[j];
        __syncthreads();
        if (c > 0) { const int tp = d == 0 ? 16 * (c - 1) : 256 - 16 * c; LAS float* ybp = ybuf0 + ((c - 1) & 1) * 1024;
            *(f32x4*)(Yo + (size_t)(tp + (gt >> 4)) * 512 + 4 * (gt & 15)) = *(LAS f32x4*)(ybp + 4 * gt); }
        if (c + 1 < 16) { const int tok0 = d == 0 ? 16 * (c + 1) : 256 - 16 * (c + 2); const f32x4* s4 = (const f32x4*)(si + (size_t)tok0 * 384);
#pragma unroll
            for (int j = 0; j < 6; ++j) pre[j] = s4[gt + 256 * j]; }
#pragma unroll 2
        for (int s = 0; s < 16; ++s) {
            const int ti = d == 0 ? s : 15 - s; const LAS float* rec = buf + ti * 384 + 8 * kseg;
            const f32x4 a0 = *(const LAS f32x4*)(rec + 256), a1 = *(const LAS f32x4*)(rec + 260);
            const f32x4 w0 = *(const LAS f32x4*)(rec + 64), w1 = *(const LAS f32x4*)(rec + 68), b0 = *(const LAS f32x4*)(rec + 320), b1 = *(const LAS f32x4*)(rec + 324);
            const f32x4 k0 = *(const LAS f32x4*)(rec + 128), k1 = *(const LAS f32x4*)(rec + 132), r0 = *(const LAS f32x4*)(rec), r1 = *(const LAS f32x4*)(rec + 4);
            const f2 v2 = *(const LAS f2*)(buf + ti * 384 + 192 + 2 * lr);
            const f2 a01 = {a0[0], a0[1]}, a23 = {a0[2], a0[3]}, a45 = {a1[0], a1[1]}, a67 = {a1[2], a1[3]};
            f2 tA = SA[0] * a01; tA = SA[1] * a23 + tA; tA = SA[2] * a45 + tA; tA = SA[3] * a67 + tA;
            f2 tB = SB[0] * a01; tB = SB[1] * a23 + tB; tB = SB[2] * a45 + tB; tB = SB[3] * a67 + tB;
            const float saA = red8(tA.x + tA.y), saB = red8(tB.x + tB.y);
            const f2 sA2 = {saA, saA}, sB2 = {saB, saB}, vA2 = {v2.x, v2.x}, vB2 = {v2.y, v2.y};
            const f2 w01 = {w0[0], w0[1]}, w23 = {w0[2], w0[3]}, w45 = {w1[0], w1[1]}, w67 = {w1[2], w1[3]};
            const f2 b01 = {b0[0], b0[1]}, b23 = {b0[2], b0[3]}, b45 = {b1[0], b1[1]}, b67 = {b1[2], b1[3]};
            const f2 k01 = {k0[0], k0[1]}, k23 = {k0[2], k0[3]}, k45 = {k1[0], k1[1]}, k67 = {k1[2], k1[3]};
            SA[0] = SA[0] * w01 + sA2 * b01 + vA2 * k01; SA[1] = SA[1] * w23 + sA2 * b23 + vA2 * k23; SA[2] = SA[2] * w45 + sA2 * b45 + vA2 * k45; SA[3] = SA[3] * w67 + sA2 * b67 + vA2 * k67;
            SB[0] = SB[0] * w01 + sB2 * b01 + vB2 * k01; SB[1] = SB[1] * w23 + sB2 * b23 + vB2 * k23; SB[2] = SB[2] * w45 + sB2 * b45 + vB2 * k45; SB[3] = SB[3] * w67 + sB2 * b67 + vB2 * k67;
            const f2 r01 = {r0[0], r0[1]}, r23 = {r0[2], r0[3]}, r45 = {r1[0], r1[1]}, r67 = {r1[2], r1[3]};
            f2 uA = SA[0] * r01; uA = SA[1] * r23 + uA; uA = SA[2] * r45 + uA; uA = SA[3] * r67 + uA;
            f2 uB = SB[0] * r01; uB = SB[1] * r23 + uB; uB = SB[2] * r45 + uB; uB = SB[3] * r67 + uB;
            const float yA = red8(uA.x + uA.y), yB = red8(uB.x + uB.y);
            if (kseg == 0) *(LAS f2*)(yb + ti * 64 + 2 * lr) = (f2){yA, yB};
        }
    }
    __syncthreads();
    { const int tp = d == 0 ? 16 * 15 : 0; LAS float* ybp = ybuf0 + (15 & 1) * 1024;
      *(f32x4*)(Yo + (size_t)(tp + (gt >> 4)) * 512 + 4 * (gt & 15)) = *(LAS f32x4*)(ybp + 4 * gt); }
    { float* op = a.out + (d == 0 ? OUT_RF : OUT_RB) + ((size_t)(b * 4 + l) * 8 + head) * 4096 + (2 * lr) * 64 + 8 * kseg;
      *(f32x4*)op = (f32x4){SA[0].x, SA[0].y, SA[1].x, SA[1].y}; *(f32x4*)(op + 4) = (f32x4){SA[2].x, SA[2].y, SA[3].x, SA[3].y};
      *(f32x4*)(op + 64) = (f32x4){SB[0].x, SB[0].y, SB[1].x, SB[1].y}; *(f32x4*)(op + 68) = (f32x4){SB[2].x, SB[2].y, SB[3].x, SB[3].y}; }
    __syncthreads();
}

__device__ __forceinline__ void scan_wave(ArgsRef a, unsigned char* ws, int l, bool lat, int b, int head, int dir, int rg, int lane) {
    const int T = lat ? 1024 : 256, tokbase = lat ? NCTX + b * 1024 : b * 256, nch = T / 16, dh = dir * 8 + head;
    const int cu0 = dh * 512 + (lat ? 256 + b * 64 : b * 16);
    const int q = lane & 15, g4 = lane >> 4, row = 16 * rg + q;
    const float* siv = (const float*)(ws + WS_V) + head * 64 + row;
    float* Yo = (float*)(ws + WS_Y) + (size_t)dir * MT * 512 + head * 64 + row;
    f32x4 ST[4];
    if (lat) { const float* sp = a.in[dir == 0 ? 6 : 7] + ((size_t)(b * 4 + l) * 8 + head) * 4096 + row * 64 + 4 * g4;
#pragma unroll
        for (int kt = 0; kt < 4; ++kt) ST[kt] = *(const f32x4*)(sp + 16 * kt); }
    else {
#pragma unroll
        for (int kt = 0; kt < 4; ++kt) ST[kt] = (f32x4){0.f, 0.f, 0.f, 0.f}; }
    struct COps { v2u im[20]; f32x4 gC[4]; f32x4 vv; };
#define CH_LOAD(O, C) do { const unsigned char* ops_ = ws + WS_OPS + (size_t)(cu0 + (C)) * OPS_BLOCK; \
        _Pragma("unroll") for (int i = 0; i < 10; ++i) { const v4u pr_ = *(const v4u*)(ops_ + i * 1024 + lane * 16); O.im[2 * i] = (v2u){pr_.x, pr_.y}; O.im[2 * i + 1] = (v2u){pr_.z, pr_.w}; } \
        _Pragma("unroll") for (int kt = 0; kt < 4; ++kt) O.gC[kt] = *(const f32x4*)(ops_ + 20 * 512 + (16 * kt + 4 * g4) * 4); \
        _Pragma("unroll") for (int e = 0; e < 4; ++e) { O.vv[e] = siv[(size_t)(tokbase + 16 * (dir == 0 ? (C) : nch - 1 - (C)) + 4 * g4 + e) * 512]; } } while (0)
#define CH_STEP(O, C) do { const v2u vB = pk4(O.vv); v2u sB[4]; \
        _Pragma("unroll") for (int kt = 0; kt < 4; ++kt) sB[kt] = pk4(ST[kt]); \
        f32x4 X = {0.f, 0.f, 0.f, 0.f}, Yt = {0.f, 0.f, 0.f, 0.f}; \
        _Pragma("unroll") for (int kt = 0; kt < 4; ++kt) { X = mfma16k(O.im[kt], sB[kt], X); Yt = mfma16k(O.im[4 + kt], sB[kt], Yt); } \
        X = mfma16k(O.im[16], vB, X); \
        const f32x4 P = mfma16k(O.im[17], pk4(X), (f32x4){0.f, 0.f, 0.f, 0.f}); const v2u pB = pk4(P); \
        Yt = mfma16k(O.im[18], pB, Yt); Yt = mfma16k(O.im[19], vB, Yt); \
        _Pragma("unroll") for (int e = 0; e < 4; ++e) { Yo[(size_t)(tokbase + 16 * (dir == 0 ? (C) : nch - 1 - (C)) + 4 * g4 + e) * 512] = Yt[e]; } \
        _Pragma("unroll") for (int kt = 0; kt < 4; ++kt) { f32x4 n = ST[kt] * O.gC[kt]; n = mfma16k(O.im[8 + kt], pB, n); n = mfma16k(O.im[12 + kt], vB, n); ST[kt] = n; } } while (0)
    { COps A, B; CH_LOAD(A, 0);
      for (int c = 0; c < nch; c += 2) {
          CH_LOAD(B, c + 1);
          CH_STEP(A, c);
          if (c + 2 < nch) CH_LOAD(A, c + 2);
          CH_STEP(B, c + 1);
      } }
#undef CH_LOAD
#undef CH_STEP
    if (!lat) { float* op = a.out + (dir == 0 ? OUT_RF : OUT_RB) + ((size_t)(b * 4 + l) * 8 + head) * 4096 + row * 64 + 4 * g4;
#pragma unroll
        for (int kt = 0; kt < 4; ++kt) *(f32x4*)(op + 16 * kt) = ST[kt]; }
}

__device__ __forceinline__ void scan_wg(ArgsRef a, unsigned char* ws, int l, bool lat, int b, int head, LAS unsigned char* lds, int tid) {
    const int lane = tid & 63, wv = __builtin_amdgcn_readfirstlane(tid >> 6), dir = wv >> 2, rg = wv & 3, sl = tid & 255;
    const int T = lat ? 1024 : 256, tokbase = lat ? NCTX + b * 1024 : b * 256, nch = T / 16, dh = dir * 8 + head;
    const int cu0 = dh * 512 + (lat ? 256 + b * 64 : b * 16);
    const int q = lane & 15, g4 = lane >> 4, row = 16 * rg + q;
    const bf16* siv = (const bf16*)(ws + WS_V) + head * 64 + row;
    bf16* Yo = (bf16*)(ws + WS_Y) + (size_t)dir * MT * 512 + head * 64 + row;
    LAS unsigned char* slot0 = lds + dir * (2 * OPS_BLOCK);
    f32x4 ST[4];
    if (lat) { const float* sp = a.in[dir == 0 ? 6 : 7] + ((size_t)(b * 4 + l) * 8 + head) * 4096 + row * 64 + 4 * g4;
#pragma unroll
        for (int kt = 0; kt < 4; ++kt) ST[kt] = *(const f32x4*)(sp + 16 * kt); }
    else {
#pragma unroll
        for (int kt = 0; kt < 4; ++kt) ST[kt] = (f32x4){0.f, 0.f, 0.f, 0.f}; }
    struct GRegs { v4u x0, x1, x2; v2u vv; };
#define SW_GLOAD(R, C) do { const unsigned char* ob_ = ws + WS_OPS + (size_t)(cu0 + (C)) * OPS_BLOCK + sl * 16; \
        R.x0 = *(const v4u*)ob_; R.x1 = *(const v4u*)(ob_ + 4096); if (sl < 160) R.x2 = *(const v4u*)(ob_ + 8192); \
        { const bf16* vp_ = siv + (size_t)(tokbase + 16 * (dir == 0 ? (C) : nch - 1 - (C)) + 4 * g4) * 512; \
          R.vv.x = (unsigned)vp_[0] | ((unsigned)vp_[512] << 16); R.vv.y = (unsigned)vp_[1024] | ((unsigned)vp_[1536] << 16); } } while (0)
#define SW_PARK(R, C) do { LAS unsigned char* sp_ = slot0 + ((C) & 1) * OPS_BLOCK + sl * 16; \
        *(LAS v4u*)sp_ = R.x0; *(LAS v4u*)(sp_ + 4096) = R.x1; if (sl < 160) *(LAS v4u*)(sp_ + 8192) = R.x2; } while (0)
#define SW_STEP(VV, C) do { const LAS unsigned char* sb_ = slot0 + ((C) & 1) * OPS_BLOCK; v2u im[20]; \
        _Pragma("unroll") for (int i = 0; i < 10; ++i) { const v4u pr_ = *(const LAS v4u*)(sb_ + i * 1024 + lane * 16); im[2 * i] = (v2u){pr_.x, pr_.y}; im[2 * i + 1] = (v2u){pr_.z, pr_.w}; } \
        f32x4 gC_[4]; _Pragma("unroll") for (int kt = 0; kt < 4; ++kt) gC_[kt] = *(const LAS f32x4*)(sb_ + 20 * 512 + (16 * kt + 4 * g4) * 4); \
        const v2u vB = VV; v2u sB[4]; \
        _Pragma("unroll") for (int kt = 0; kt < 4; ++kt) sB[kt] = pk4(ST[kt]); \
        f32x4 X = {0.f, 0.f, 0.f, 0.f}, Yt = {0.f, 0.f, 0.f, 0.f}; \
        _Pragma("unroll") for (int kt = 0; kt < 4; ++kt) { X = mfma16k(im[2 * kt], sB[kt], X); Yt = mfma16k(im[2 * kt + 1], sB[kt], Yt); } \
        X = mfma16k(im[16], vB, X); \
        const f32x4 P = mfma16k(im[17], pk4(X), (f32x4){0.f, 0.f, 0.f, 0.f}); const v2u pB = pk4(P); \
        Yt = mfma16k(im[18], pB, Yt); Yt = mfma16k(im[19], vB, Yt); \
        _Pragma("unroll") for (int e = 0; e < 4; ++e) Yo[(size_t)(tokbase + 16 * (dir == 0 ? (C) : nch - 1 - (C)) + 4 * g4 + e) * 512] = h1(Yt[e]); \
        _Pragma("unroll") for (int kt = 0; kt < 4; ++kt) { f32x4 n = ST[kt] * gC_[kt]; n = mfma16k(im[8 + 2 * kt], pB, n); n = mfma16k(im[9 + 2 * kt], vB, n); ST[kt] = n; } } while (0)
    { GRegs R0, R1, R2; v2u vcur;
      SW_GLOAD(R0, 0); SW_GLOAD(R1, 1); SW_GLOAD(R2, 2);
      SW_PARK(R0, 0); vcur = R0.vv;
      __syncthreads();
      for (int c = 0; c < nch; c += 3) {
          { v2u vn = vcur; if (c + 1 < nch) { SW_PARK(R1, c + 1); vn = R1.vv; } if (c + 3 < nch) SW_GLOAD(R0, c + 3); SW_STEP(vcur, c); vcur = vn; __syncthreads(); }
          if (c + 1 < nch) { v2u vn = vcur; if (c + 2 < nch) { SW_PARK(R2, c + 2); vn = R2.vv; } if (c + 4 < nch) SW_GLOAD(R1, c + 4); SW_STEP(vcur, c + 1); vcur = vn; __syncthreads(); }
          if (c + 2 < nch) { v2u vn = vcur; if (c + 3 < nch) { SW_PARK(R0, c + 3); vn = R0.vv; } if (c + 5 < nch) SW_GLOAD(R2, c + 5); SW_STEP(vcur, c + 2); vcur = vn; __syncthreads(); }
      } }
#undef SW_GLOAD
#undef SW_PARK
#undef SW_STEP
    if (!lat) { float* op = a.out + (dir == 0 ? OUT_RF : OUT_RB) + ((size_t)(b * 4 + l) * 8 + head) * 4096 + row * 64 + 4 * g4;
#pragma unroll
        for (int kt = 0; kt < 4; ++kt) *(f32x4*)(op + 16 * kt) = ST[kt]; }
}

constexpr int ATT_KP = 272, ATT_VP = 288, ATT_BUF = 64 * ATT_KP + 64 * ATT_VP;
template <int MODE> __device__ __forceinline__ void att_src(ArgsRef a, unsigned char* ws, int l, int b, int h, int c, int j, int rg, int skey, int sseg, const bf16*& kp, const bf16*& vp) {
    const bf16* F = (const bf16*)(ws + WS_F);
    if (MODE == 0 || MODE == 2) { const size_t ro = (size_t)(b * 256 + 32 * c + skey) * NINP + h * 128 + sseg * 8; kp = F + ro + (MODE == 0 ? C_NAK : C_DFK); vp = F + ro + (MODE == 0 ? C_NAV : C_DFV); }
    else if (MODE == 3) {
        if (c < 32) { kp = (const bf16*)(ws + WS_KR) + (size_t)(b * 1024 + 32 * c + skey) * 512 + h * 128 + sseg * 8; vp = F + (size_t)(NCTX + b * 1024 + 32 * c + skey) * NINP + C_DFV + h * 128 + sseg * 8; }
        else { const size_t ro = ((size_t)(b * 4 + l) * 256 + 32 * (c - 32) + skey) * 512 + h * 128 + sseg * 8; kp = (const bf16*)(ws + WS_CKDF) + ro; vp = (const bf16*)(ws + WS_CVDF) + ro; }
    } else {
        const int nloc = 12;
        if (c < nloc) { const int kr = (rg ? 4 : 0) + c; int kc0 = 16 * j - 8; kc0 = kc0 < 0 ? 0 : (kc0 > 32 ? 32 : kc0);
            const size_t ro = (size_t)(NCTX + b * 1024 + kr * 64 + kc0 + skey) * NINP + h * 128 + sseg * 8; kp = F + ro + C_NAK; vp = F + ro + C_NAV; }
        else { const size_t ro = ((size_t)(b * 4 + l) * 256 + 32 * (c - nloc) + skey) * 512 + h * 128 + sseg * 8; kp = (const bf16*)(ws + WS_CKNA) + ro; vp = (const bf16*)(ws + WS_CVNA) + ro; }
    }
}
template <int MODE> __device__ __forceinline__ void attn_unit(ArgsRef a, unsigned char* ws, int l, int uidx, LAS unsigned char* lds, int tid) {
    constexpr bool DIFF = (MODE == 2 || MODE == 3); constexpr int NS = DIFF ? 2 : 1;
    const int wave = __builtin_amdgcn_readfirstlane(tid >> 6), lane = tid & 63, q = lane & 15, g = lane >> 4, skey = tid >> 4, sseg = tid & 15;
    const bf16* F = (const bf16*)(ws + WS_F);
    int b, h, j = 0, rg = 0, nchunks, orow; const bf16* Qp;
    if (MODE == 0 || MODE == 2) { b = uidx >> 3; h = (uidx >> 1) & 3; const int half = uidx & 1; orow = b * 256 + half * 128 + wave * 16 + q; Qp = F + (size_t)orow * NINP + (MODE == 0 ? C_NAQ : C_DFQ) + h * 128; nchunks = 8; }
    else if (MODE == 3) { b = uidx >> 5; h = (uidx >> 3) & 3; const int qb = uidx & 7; const int lr = b * 1024 + qb * 128 + wave * 16 + q; orow = NCTX + lr; Qp = (const bf16*)(ws + WS_QR) + (size_t)lr * 512 + h * 128; nchunks = 40; }
    else { b = uidx >> 5; h = (uidx >> 3) & 3; j = (uidx >> 1) & 3; rg = uidx & 1; const int r = rg * 8 + wave; orow = NCTX + b * 1024 + r * 64 + 16 * j + q; Qp = F + (size_t)orow * NINP + C_NAQ + h * 128; nchunks = 12 + 8; }
    bf16x8 qf[4];
#pragma unroll
    for (int ks = 0; ks < 4; ++ks) qf[ks] = *(const bf16x8*)(Qp + 32 * ks + 8 * g);
    const float csc = (DIFF ? 0.125f : 0.08838834764831845f) * 1.4426950408889634f;
    float m[NS], ls[NS]; f32x4 o[NS][8];
#pragma unroll
    for (int n = 0; n < NS; ++n) { m[n] = -__builtin_inff(); ls[n] = 0.f;
#pragma unroll
        for (int d = 0; d < 8; ++d) o[n][d] = (f32x4){0.f, 0.f, 0.f, 0.f}; }
    const int nloc = 12, r = rg * 8 + wave, qc = 16 * j + q;
    int rs = r - 4; rs = rs < 0 ? 0 : (rs > 8 ? 8 : rs);
    int kc0 = 16 * j - 8; kc0 = kc0 < 0 ? 0 : (kc0 > 32 ? 32 : kc0);
    int wc0 = qc - 8; wc0 = wc0 < 0 ? 0 : (wc0 > 48 ? 48 : wc0);
    const float* rpb = a.in[13] + (size_t)(l * 4 + h) * 15 * 31;
    if (MODE == 1) { for (int i = tid; i < 15 * 31; i += 512) ((LAS float*)(lds + 2 * ATT_BUF))[i] = rpb[i] * 1.4426950408889634f; }
    v4u kreg, vreg, kreg1, vreg1;
    { const bf16 *kp, *vp; att_src<MODE>(a, ws, l, b, h, 0, j, rg, skey, sseg, kp, vp); kreg = *(const v4u*)kp; vreg = *(const v4u*)vp;
      att_src<MODE>(a, ws, l, b, h, 1, j, rg, skey, sseg, kp, vp); kreg1 = *(const v4u*)kp; vreg1 = *(const v4u*)vp; }
    for (int c2 = 0; c2 < nchunks / 2; ++c2) {
        LAS unsigned char* Kl0 = lds + (c2 & 1) * ATT_BUF; LAS unsigned char* Vl0 = Kl0 + 64 * ATT_KP;
        *(LAS v4u*)(Kl0 + skey * ATT_KP + sseg * 16) = kreg; *(LAS v4u*)(Vl0 + skey * ATT_VP + sseg * 16) = vreg;
        *(LAS v4u*)(Kl0 + (32 + skey) * ATT_KP + sseg * 16) = kreg1; *(LAS v4u*)(Vl0 + (32 + skey) * ATT_VP + sseg * 16) = vreg1;
        __syncthreads();
        if (2 * c2 + 2 < nchunks) { const bf16 *kp, *vp; att_src<MODE>(a, ws, l, b, h, 2 * c2 + 2, j, rg, skey, sseg, kp, vp); kreg = *(const v4u*)kp; vreg = *(const v4u*)vp;
            att_src<MODE>(a, ws, l, b, h, 2 * c2 + 3, j, rg, skey, sseg, kp, vp); kreg1 = *(const v4u*)kp; vreg1 = *(const v4u*)vp; }
#pragma unroll 1
      for (int sub = 0; sub < 2; ++sub) { const int c = 2 * c2 + sub;
        const LAS unsigned char* Kl = Kl0 + sub * 32 * ATT_KP; const LAS unsigned char* Vl = Vl0 + sub * 32 * ATT_VP;
        bool active = true; int kr = 0;
        if (MODE == 1 && c < nloc) { kr = (rg ? 4 : 0) + c; active = (kr >= rs) && (kr < rs + 8); }
        if (active) {
            f32x4 s[NS][2];
#pragma unroll
            for (int n = 0; n < NS; ++n) { s[n][0] = (f32x4){0.f, 0.f, 0.f, 0.f}; s[n][1] = s[n][0]; }
            { bf16x8 ka[2][4];
#pragma unroll
              for (int t = 0; t < 2; ++t)
#pragma unroll
                  for (int ks = 0; ks < 4; ++ks) ka[t][ks] = *(const LAS bf16x8*)(Kl + (16 * t + q) * ATT_KP + (32 * ks + 8 * g) * 2);
#pragma unroll
              for (int t = 0; t < 2; ++t)
#pragma unroll
                  for (int ks = 0; ks < 4; ++ks) { const int n = DIFF ? (ks >> 1) : 0; s[n][t] = mfma16(ka[t][ks], qf[ks], s[n][t]); }
              __builtin_amdgcn_sched_group_barrier(0x100, 4, 1);
#pragma unroll
              for (int k = 0; k < 4; ++k) { __builtin_amdgcn_sched_group_barrier(0x8, 1, 1); __builtin_amdgcn_sched_group_barrier(0x100, 1, 1); }
              __builtin_amdgcn_sched_group_barrier(0x8, 4, 1); }
            const bool biased = (MODE == 1 && c < nloc);
            if (biased) { const LAS float* rrow = (const LAS float*)(lds + 2 * ATT_BUF) + (kr - r + 7) * 31 + 15;
#pragma unroll
                for (int t = 0; t < 2; ++t)
#pragma unroll
                    for (int e = 0; e < 4; ++e) { const int kc = kc0 + 16 * t + 4 * g + e; int rel = kc - qc; rel = rel < -15 ? -15 : (rel > 15 ? 15 : rel);
                        const bool inw = (kc >= wc0) && (kc < wc0 + 16); s[0][t][e] = inw ? __builtin_fmaf(s[0][t][e], csc, rrow[rel]) : -__builtin_inff(); } }
            bf16x8 pb[NS];
#pragma unroll
            for (int n = 0; n < NS; ++n) {
                const float mx = fmaxf(fmaxf(fmaxf(s[n][0][0], s[n][0][1]), fmaxf(s[n][0][2], s[n][0][3])), fmaxf(fmaxf(s[n][1][0], s[n][1][1]), fmaxf(s[n][1][2], s[n][1][3])));
                const float mu = biased ? mx : mx * csc;
                if (__any(mu > m[n] + 8.0f)) {
                    const float mnew = fmaxf(m[n], xrow16_max(mu));
                    const float alpha = __builtin_amdgcn_exp2f(m[n] - ((mnew == -__builtin_inff()) ? 0.f : mnew)); m[n] = mnew;
                    ls[n] = ls[n] * alpha;
#pragma unroll
                    for (int d = 0; d < 8; ++d) o[n][d] = o[n][d] * alpha;
                }
                const float muse = (m[n] == -__builtin_inff()) ? 0.f : m[n];
                float p[8]; float psum = 0.f;
                if (biased) {
#pragma unroll
                    for (int e = 0; e < 4; ++e) { p[e] = __builtin_amdgcn_exp2f(s[n][0][e] - muse); p[4 + e] = __builtin_amdgcn_exp2f(s[n][1][e] - muse); psum += p[e] + p[4 + e]; } }
                else {
#pragma unroll
                    for (int e = 0; e < 4; ++e) { p[e] = __builtin_amdgcn_exp2f(__builtin_fmaf(s[n][0][e], csc, -muse)); p[4 + e] = __builtin_amdgcn_exp2f(__builtin_fmaf(s[n][1][e], csc, -muse)); psum += p[e] + p[4 + e]; } }
                ls[n] += psum;
                pb[n] = pack8(p);
            }
            bf16x8 vt[8];
#pragma unroll
            for (int d = 0; d < 8; ++d) {
                const LAS unsigned char* va = Vl + (4 * g + (q >> 2)) * ATT_VP + (16 * d + 4 * (q & 3)) * 2;
                const s16x4 lo = vtr(va), hi = vtr(va + 16 * ATT_VP);
                vt[d] = (bf16x8){lo[0], lo[1], lo[2], lo[3], hi[0], hi[1], hi[2], hi[3]}; }
#pragma unroll
            for (int d = 0; d < 8; ++d)
#pragma unroll
                for (int n = 0; n < NS; ++n) o[n][d] = mfma16(vt[d], pb[n], o[n][d]);
            __builtin_amdgcn_sched_group_barrier(0x100, 8, 0);
#pragma unroll
            for (int k = 0; k < 4; ++k) { __builtin_amdgcn_sched_group_barrier(0x8, NS, 0); __builtin_amdgcn_sched_group_barrier(0x100, 2, 0); }
            __builtin_amdgcn_sched_group_barrier(0x8, 4 * NS, 0);
        }
      }
    }
    bf16* O3 = (bf16*)(ws + WS_O3) + (size_t)orow * 1536 + (DIFF ? 512 : 0) + h * 128 + 4 * g;
    if constexpr (!DIFF) { const float inv = __builtin_amdgcn_rcpf(xrow16_sum(ls[0]));
#pragma unroll
        for (int d = 0; d < 8; ++d) { const f32x4 v = o[0][d] * inv; v2u w; w.x = cvt_pk_bf16(v[0], v[1]); w.y = cvt_pk_bf16(v[2], v[3]); *(v2u*)(O3 + 16 * d) = w; } }
    else { const float lam = ((const float*)(ws + WS_LAM))[l], li = lam_init_of(l);
        const float i0 = __builtin_amdgcn_rcpf(xrow16_sum(ls[0])), i1 = lam * __builtin_amdgcn_rcpf(xrow16_sum(ls[1])); float ss = 0.f;
#pragma unroll
        for (int d = 0; d < 8; ++d) { o[0][d] = o[0][d] * i0 - o[1][d] * i1; ss += (o[0][d][0] * o[0][d][0] + o[0][d][1] * o[0][d][1]) + (o[0][d][2] * o[0][d][2] + o[0][d][3] * o[0][d][3]); }
        ss = xrow16_sum(ss);
        const float rsn = __builtin_amdgcn_rsqf(ss * (1.f / 128.f) + LN_EPS) * (1.0f - li);
        const float* sub = a.in[15] + l * 512 + h * 128 + 4 * g;
#pragma unroll
        for (int d = 0; d < 8; ++d) { const f32x4 v = o[0][d] * rsn * *(const f32x4*)(sub + 16 * d); v2u w; w.x = cvt_pk_bf16(v[0], v[1]); w.y = cvt_pk_bf16(v[2], v[3]); *(v2u*)(O3 + 16 * d) = w; } }
    __syncthreads();
}

__device__ __forceinline__ void rb_wait(gu32* cnt, int ra, int rb, int tid) {
    if (tid == 0) {
        unsigned sp = 0u;
        if (rb > ra + 1) { for (int r = ra; r < rb; ++r) while (__hip_atomic_load(cnt + 64 * r, RLX_AGENT) < pg8::RB_NEED) { __builtin_amdgcn_s_sleep(1); if (++sp > (1u << 22)) break; } }
        else while (__hip_atomic_load(cnt + 64 * ra, RLX_AGENT) < pg8::RB_NEED || __hip_atomic_load(cnt + 64 * rb, RLX_AGENT) < pg8::RB_NEED) { __builtin_amdgcn_s_sleep(1); if (++sp > (1u << 22)) break; }
        __builtin_amdgcn_fence(__ATOMIC_ACQUIRE, "agent");
    }
    __syncthreads();
}

constexpr int MIX_SCL = 32, MIX_A3 = MIX_SCL + 128, MIX_A0 = MIX_A3 + 128, MIX_A1 = MIX_A0 + 128, MIX_A2 = MIX_A1 + 128, MIX_SCC = MIX_A2 + 128, MIX_END = MIX_SCC;
__device__ __forceinline__ void phase_mix(ArgsRef a, unsigned char* ws, int l, LAS unsigned char* lds, int tid, int rep) {
    gu32* head = (gu32*)(ws + WS_CTL) + CW_MIXQ + 64 * (l + 4 * rep);
    volatile LAS int* slot = (volatile LAS int*)(lds + MISC_OFF + 64);
    for (;;) {
        if (tid == 0) slot[0] = (int)__hip_atomic_fetch_add(head, 1u, __ATOMIC_RELAXED, __HIP_MEMORY_SCOPE_AGENT);
        __syncthreads();
        const int u = __builtin_amdgcn_readfirstlane(slot[0]);
        __syncthreads();
        if (u >= MIX_END) break;
        if (u < MIX_SCL) scan_wg(a, ws, l, true, u >> 3, u & 7, lds, tid);
        else if (u < MIX_A3) attn_unit<3>(a, ws, l, u - MIX_SCL, lds, tid);
        else if (u < MIX_A0) attn_unit<0>(a, ws, l, u - MIX_A3, lds, tid);
        else if (u < MIX_A1) attn_unit<1>(a, ws, l, u - MIX_A0, lds, tid);
        else if (u < MIX_A2) attn_unit<2>(a, ws, l, u - MIX_A1, lds, tid);
        else { const int v = u - MIX_A2; scan_wg(a, ws, l, false, v >> 3, v & 7, lds, tid); }
    }
}

__global__ void __launch_bounds__(NWAVES * 64, 2) fwd_kernel(Args args) {
    extern __shared__ __attribute__((aligned(16))) unsigned char lds_raw[];
    LAS unsigned char* lds = (LAS unsigned char*)lds_raw;
    const int tid = threadIdx.x; const int wave_s = __builtin_amdgcn_readfirstlane(tid >> 6);
    const int G = gridDim.x, bid = blockIdx.x, NGW = G * NWAVES;
    for (int u = tid; u < (LDS_BYTES - RING_BYTES) / 4; u += NWAVES * 64) ((LAS unsigned*)(lds + RING_BYTES))[u] = 0u;
    __syncthreads();
    unsigned* barw = (unsigned*)(args.ws + WS_CTL) + CW_BAR;
    XcdBarrier bar; bar.bar = barw; bar.x = 0; bar.st = nullptr;
    if (MK_SINGLE) bar = xcd_barrier_post(barw, (volatile LAS unsigned*)(lds + MISC_OFF) + 8);
    const int lo = args.ph_lo, hi = args.ph_hi;
#ifndef PH_MASK
#define PH_MASK 0xFFFFu
#endif
#define PM(i) (((PH_MASK) >> (i)) & 1u)
#ifndef DUP_MASK
#define DUP_MASK 0u
#endif
#define DUPN(i) ((((DUP_MASK) >> (i)) & 1u) ? 2 : 1)
#define IN(k) (lo <= (k) && (k) < hi)
#define SEAM(k) do { if (MK_SINGLE && IN(k) && IN((k) + 1)) xcd_barrier(bar); } while (0)
#define FRESH() int tid_, bid_ = bid, G_ = G; asm volatile("v_mbcnt_lo_u32_b32 %0, -1, 0\n\tv_mbcnt_hi_u32_b32 %0, -1, %0" : "=v"(tid_)); tid_ += wave_s * 64; const CAS Args* ap_ = (const CAS Args*)__builtin_amdgcn_kernarg_segment_ptr(); asm volatile("" : "+v"(tid_), "+s"(ap_), "+s"(bid_), "+s"(G_)); ArgsRef A_ = *ap_; unsigned char* ws = A_.ws; const int lane_ = tid_ & 63, wave_ = __builtin_amdgcn_readfirstlane(tid_ >> 6), gw_ = bid_ * NWAVES + wave_, NGW_ = G_ * NWAVES; (void)lane_; (void)gw_; (void)NGW_
    if (PM(0) && IN(0)) for (int rep = 0; rep < DUPN(0); ++rep) { FRESH(); phase_ada(A_, ws, lds, tid_, bid_, G_); __syncthreads(); phase_cvt(A_, ws, lds, tid_, bid_, G_); __syncthreads(); }
    SEAM(0);
    if (PM(1) && IN(1)) { FRESH(); phase_ln<0>(A_, ws, 0, gw_, NGW_, lane_); }
    SEAM(1);
    for (int l = 0; l < NL; ++l) {
        const int pb = 2 + 10 * l;
        if (PM(2) && IN(pb + 0)) { FRESH(); pg8::Gemm g{(const pg8::bf16_t*)(ws + WS_H), (const pg8::bf16_t*)(ws + WS_WIN) + (size_t)l * NINP * D, MT, NINP, D}; pg8::DepOrder S; S.init(MT, NINP, G_, bid_);
            S.cnt = (gu32*)(ws + WS_CTL) + CW_RB + 2048 * l; S.lead = (tid_ == 0); S.pend = -1;
            pg8::EpiF E{(pg8::bf16_t*)(ws + WS_F), A_.out, l, ws + WS_GF};
            pg8::gemm_phase<pg8::EpiF, pg8::DepOrder, true, true>(lds, g, S, E, tid_); S.flush(); }
        if (PM(3) && IN(pb + 1)) { FRESH(); gu32* cnt = (gu32*)(ws + WS_CTL) + CW_RB + 2048 * l; gu32* head = (gu32*)(ws + WS_CTL) + CW_PREQ + 64 * l; volatile LAS int* slot = (volatile LAS int*)(lds + MISC_OFF + 64);
            for (;;) {
                if (tid_ == 0) slot[0] = (int)__hip_atomic_fetch_add(head, 1u, __ATOMIC_RELAXED, __HIP_MEMORY_SCOPE_AGENT);
                __syncthreads();
                const int t = __builtin_amdgcn_readfirstlane(slot[0]);
                __syncthreads();
                if (t >= 512) break;
                const int tok0 = t * 16; rb_wait(cnt, (tok0 > 0 ? tok0 - 1 : 0) >> 8, (tok0 + 16 < MT ? tok0 + 16 : MT - 1) >> 8, tid_);
                pre_tile(A_, ws, l, t, lds, tid_); }
            rb_wait(cnt, 16, 32, tid_);
            phase_rope(ws, gw_, NGW_, lane_); }
        SEAM(pb + 1);
        if (PM(4) && IN(pb + 2)) for (int rep = 0; rep < DUPN(4); ++rep) { FRESH(); phase_mix(A_, ws, l, lds, tid_, rep); if (rep + 1 < DUPN(4)) xcd_barrier(bar); }
        SEAM(pb + 2);
        if (PM(5) && IN(pb + 3)) for (int rep = 0; rep < DUPN(5); ++rep) { FRESH(); phase_post(A_, ws, l, gw_, NGW_, lane_); }
        SEAM(pb + 3);
        if (PM(6) && IN(pb + 4)) for (int rep = 0; rep < DUPN(6); ++rep) { FRESH(); pg8::Gemm g{(const pg8::bf16_t*)(ws + WS_O3), (const pg8::bf16_t*)(ws + WS_WBR) + (size_t)l * D * 1536, MT, D, 1536}; pg8::StaticOrder S; S.init(MT, D, G_, bid_);
            pg8::EpiMerge E{ws + WS_GF, (pg8::bf16_t*)(ws + WS_MERGED)};
            pg8::gemm_phase<pg8::EpiMerge, pg8::StaticOrder, true, true, true>(lds, g, S, E, tid_); }
        SEAM(pb + 4);
        if (PM(7) && IN(pb + 5)) for (int rep = 0; rep < DUPN(7); ++rep) { FRESH(); pg8::Gemm g{(const pg8::bf16_t*)(ws + WS_MERGED), (const pg8::bf16_t*)(ws + WS_WO) + (size_t)l * D * D, MT, D, D}; pg8::StaticOrder S; S.init(MT, D, G_, bid_);
            const int gk = l == 0 ? 0 : 2 * l; pg8::EpiRes E{(const pg8::bf16_t*)(ws + (l == 0 ? WS_X : WS_MBUF)), l == 0 ? (const float*)nullptr : (const float*)(ws + WS_ST2), (const float*)(ws + WS_GB) + (size_t)gk * 2 * D, (const float*)(ws + WS_GB) + (size_t)gk * 2 * D + D,
                (const float*)(ws + WS_MOD) + (size_t)l * 5 * 12288 + 2 * D, (pg8::bf16_t*)(ws + WS_MBUF)};
            pg8::gemm_phase<pg8::EpiRes, pg8::StaticOrder, true, true>(lds, g, S, E, tid_); }
        SEAM(pb + 5);
        if (PM(8) && IN(pb + 6)) for (int rep = 0; rep < DUPN(8); ++rep) { FRESH(); phase_ln<1>(A_, ws, l, gw_, NGW_, lane_); }
        SEAM(pb + 6);
        if (PM(9) && IN(pb + 7)) for (int rep = 0; rep < DUPN(9); ++rep) { FRESH(); pg8::Gemm g{(const pg8::bf16_t*)(ws + WS_H), (const pg8::bf16_t*)(ws + WS_WFI) + (size_t)l * NFI * D, MT, NFI, D}; pg8::StaticOrder S; S.init(MT, NFI, G_, bid_);
            pg8::EpiSwiglu E{(pg8::bf16_t*)(ws + WS_F)};
            pg8::gemm_phase<pg8::EpiSwiglu, pg8::StaticOrder, true, true>(lds, g, S, E, tid_); }
        SEAM(pb + 7);
        if (PM(10) && IN(pb + 8)) for (int rep = 0; rep < DUPN(10); ++rep) { FRESH(); pg8::Gemm g{(const pg8::bf16_t*)(ws + WS_F), (const pg8::bf16_t*)(ws + WS_WFO) + (size_t)l * D * FF, MT, D, FF}; pg8::StaticOrder S; S.init(MT, D, G_, bid_);
            const int gk = 1 + 2 * l; pg8::EpiRes E{(const pg8::bf16_t*)(ws + WS_MBUF), (const float*)(ws + WS_ST1), (const float*)(ws + WS_GB) + (size_t)gk * 2 * D, (const float*)(ws + WS_GB) + (size_t)gk * 2 * D + D,
                (const float*)(ws + WS_MOD) + (size_t)l * 5 * 12288 + 5 * D, (pg8::bf16_t*)(ws + WS_MBUF)};
            pg8::gemm_phase<pg8::EpiRes, pg8::StaticOrder, true, true>(lds, g, S, E, tid_); }
        SEAM(pb + 8);
        if (PM(11) && IN(pb + 9)) for (int rep = 0; rep < DUPN(11); ++rep) { FRESH(); if (l < NL - 1) phase_ln<2>(A_, ws, l, gw_, NGW_, lane_); else phase_ln<3>(A_, ws, l, gw_, NGW_, lane_); }
        SEAM(pb + 9);
    }
#undef FRESH
#undef IN
#undef SEAM
}
constexpr int N_PHASES = 2 + 10 * NL;

extern "C" void kernel_launch(void* const* d_in, const int* in_sizes, int n_in, void* d_out, int out_size, void* d_ws, size_t ws_size, hipStream_t stream) {
    static int grid = 0;
    if (grid == 0) {
        if (n_in != 35 || out_size != (int)OUT_TOTAL || ws_size < WS_END) { fprintf(stderr, "kernel_launch: unexpected problem: n_in %d out %d ws %zu (need %zu)\n", n_in, out_size, ws_size, (size_t)WS_END); grid = -1; return; }
        int dev = 0, cus = 0, per_cu = 0;
        if (hipGetDevice(&dev) != hipSuccess || hipDeviceGetAttribute(&cus, hipDeviceAttributeMultiprocessorCount, dev) != hipSuccess) { grid = -1; return; }
        if (hipFuncSetAttribute((const void*)fwd_kernel, hipFuncAttributeMaxDynamicSharedMemorySize, LDS_BYTES) != hipSuccess) { fprintf(stderr, "kernel_launch: hipFuncSetAttribute failed\n"); grid = -1; return; }
        if (hipOccupancyMaxActiveBlocksPerMultiprocessor(&per_cu, (const void*)fwd_kernel, NWAVES * 64, LDS_BYTES) != hipSuccess || per_cu < 1) fprintf(stderr, "kernel_launch: occupancy query says %d\n", per_cu);
        (void)hipGetLastError();
        grid = cus;
    }
    if (grid < 0) return;
    (void)hipMemsetAsync((char*)d_ws + WS_CTL, 0, CTL_ZERO_BYTES, stream);
    Args a{};
    for (int i = 0; i < 35; ++i) a.in[i] = (const float*)d_in[i];
    a.out = (float*)d_out; a.ws = (unsigned char*)d_ws; a.l_lo = 0; a.l_hi = NL;
    if (MK_SINGLE) { a.ph_lo = 0; a.ph_hi = N_PHASES; hipLaunchKernelGGL(fwd_kernel, dim3(grid), dim3(NWAVES * 64), LDS_BYTES, stream, a); }
    else for (int p = 0; p < N_PHASES; ++p) { a.ph_lo = p; a.ph_hi = p + 1; hipLaunchKernelGGL(fwd_kernel, dim3(grid), dim3(NWAVES * 64), LDS_BYTES, stream, a); }
}
```

```cpp
#include <hip/hip_runtime.h>
#include <cstdio>
#include <cstdint>

#ifndef MK_SINGLE
#define MK_SINGLE 1
#endif

constexpr int D = 2048, MT = 8192, NCTX = 4096, NL = 4;
constexpr int NIN = 11136, NINP = 11264, FF = 5632, NFI = 11264;
constexpr int C_NAQ = 0, C_NAK = 512, C_NAV = 1024, C_DFQ = 1536, C_DFK = 2048, C_DFV = 2560, C_RW = 3072, C_GATE = 5120;
__host__ __device__ __forceinline__ constexpr unsigned gf_off(int i, int pm, int j, int wave) { return (unsigned)((((i * 32 + pm) * 8 + j) * 8 + wave) * 16) * 1024u; }
constexpr size_t OUT_YP = 0, OUT_NAK = 16777216, OUT_NAV = 25165824, OUT_DFK = 33554432, OUT_DFV = 41943040, OUT_RF = 50331648, OUT_RB = 52428800, OUT_TOTAL = 54525952;
constexpr float LN_EPS = 1e-5f;

namespace pg8 {
#define PG8_LAS __attribute__((address_space(3)))
typedef unsigned short bf16_t;
typedef short bf16x8 __attribute__((ext_vector_type(8)));
typedef float f32x4 __attribute__((ext_vector_type(4)));
typedef unsigned u32x4 __attribute__((ext_vector_type(4)));
constexpr int BM = 256, BK = 64, HALF = 128, HTB = HALF * BK * 2  , STAGE_BYTES = 8 * HTB, NXCD = 8, WGM = 8;

__host__ __device__ __forceinline__ int lds_byte(int r, int c) { const int st = (r >> 4) * 2 + (c >> 5), rr = r & 15, cc = c & 31, ob = rr * 64 + cc * 2; return st * 1024 + (ob ^ (((ob >> 9) & 1) << 5)); }
__host__ __device__ __forceinline__ void stage_rc(int b, int& R, int& C) { const int st = b / 1024, sb = b % 1024, swz = sb ^ (((sb >> 9) & 1) << 5); R = (st >> 1) * 16 + swz / 64; C = (st & 1) * 32 + (swz % 64) / 2; }
__host__ __device__ __forceinline__ int perm32(int rho) { const int n = rho >> 4, i = rho & 15; return 8 * (i >> 2) + 4 * n + (i & 3); }

struct Unit { int pm, pn; };
struct Gemm { const bf16_t* A; const bf16_t* Bt; int M, N, K; };

struct StaticOrder {
    int nM, nN, nwg, G, c;
    __host__ __device__ void init(int M, int N, int G_, int c_) { nM = M / BM; nN = N / BM; nwg = nM * nN; G = G_; c = c_; }
    __host__ __device__ bool next(int i, Unit& u) const {
        const long L = (long)i * G + c; if (L >= nwg) return false;
        int wgid = (int)L; { const int q = nwg / NXCD, r = nwg % NXCD, xcd = wgid % NXCD, off = wgid / NXCD; wgid = (xcd < r ? xcd * (q + 1) : r * (q + 1) + (xcd - r) * q) + off; }
        const int nig = WGM * nN, gid = wgid / nig, fm = gid * WGM, gsz = (nM - fm) < WGM ? (nM - fm) : WGM;
        u.pm = fm + ((wgid % nig) % gsz); u.pn = (wgid % nig) / gsz; return true;
    }
    __device__ __forceinline__ void a_ready(const Unit&) const {}
    __device__ __forceinline__ void done(const Unit&) const {}
};

typedef __attribute__((address_space(1))) unsigned gu32_;
typedef __attribute__((address_space(1))) unsigned long long gu64_;
__host__ __device__ __forceinline__ bool f_needed(int pn) { return (pn >= 6 && pn < 10) || (pn >= 12 && pn < 20); }
constexpr unsigned RB_NEED = 12u;
struct DepOrder : StaticOrder {
    gu32_* cnt; bool lead; mutable int pend;
    __device__ __forceinline__ void flush() const { if (pend >= 0 && lead) (void)__hip_atomic_fetch_add(cnt + 64 * pend, 1u, __ATOMIC_RELAXED, __HIP_MEMORY_SCOPE_AGENT); pend = -1; }
    __device__ __forceinline__ void done(const Unit& u) const { flush(); pend = f_needed(u.pn) ? u.pm : -1; }
};

__device__ __forceinline__ unsigned cvt_pk_bf16(float lo, float hi) { typedef _Float16 h2_ __attribute__((ext_vector_type(2))); typedef float f2_ __attribute__((ext_vector_type(2))); const f2_ v = {lo, hi}; return __builtin_bit_cast(unsigned, __builtin_convertvector(v, h2_)); }
typedef float f32x2 __attribute__((ext_vector_type(2)));
typedef unsigned u32x2 __attribute__((ext_vector_type(2)));
typedef _Float16 h16x2 __attribute__((ext_vector_type(2)));
typedef _Float16 h16x8 __attribute__((ext_vector_type(8)));
__device__ __forceinline__ float bf_lo(unsigned w) { return (float)__builtin_bit_cast(h16x2, w)[0]; }
__device__ __forceinline__ float bf_hi(unsigned w) { return (float)__builtin_bit_cast(h16x2, w)[1]; }
__device__ __forceinline__ float sigm(float x) { return __builtin_amdgcn_rcpf(1.0f + __expf(-x)); }

struct EpiF {
    static constexpr bool PERM = true, AFTER_DRAIN = false;
    bf16_t* F; float* out; int layer; unsigned char* GF;
    __device__ __forceinline__ void operator()(const f32x4 (&acc)[2][2][4][2], const Unit& u, int wr, int wc, int fr, int fq) const {
        const int row0 = u.pm * BM + wr * 64 + fr, col0 = u.pn * BM + wc * 32 + 8 * fq;
        float* ob = nullptr;
        if (u.pm < 16) { const int seg = u.pn >> 1;
            if (seg == 1) ob = out + OUT_NAK; else if (seg == 2) ob = out + OUT_NAV; else if (seg == 4) ob = out + OUT_DFK; else if (seg == 5) ob = out + OUT_DFV; }
        const __amdgpu_buffer_rsrc_t frs = __builtin_amdgcn_make_buffer_rsrc(F, 0, MT * NINP * 2, 0x00020000);
        const bool gt = u.pn >= 20; const unsigned gbase = gt ? gf_off((u.pn - 20) >> 3, u.pm, (u.pn - 20) & 7, wr * 4 + wc) + (unsigned)(fr + 16 * fq) * 16u : 0u;
        const bool wt = f_needed(u.pn);
        const int cseg = (u.pn & 1) * 256 + wc * 32 + 8 * fq;
#pragma unroll
        for (int ai = 0; ai < 2; ++ai)
#pragma unroll
            for (int m = 0; m < 4; ++m) { const int row = row0 + ai * HALF + m * 16; bf16_t* rowp = F + (size_t)row * NINP + col0;
#pragma unroll
                for (int bj = 0; bj < 2; ++bj) { const f32x4 v0 = acc[ai][bj][m][0], v1 = acc[ai][bj][m][1];
                    u32x4 w; w.x = cvt_pk_bf16(v0[0], v0[1]); w.y = cvt_pk_bf16(v0[2], v0[3]); w.z = cvt_pk_bf16(v1[0], v1[1]); w.w = cvt_pk_bf16(v1[2], v1[3]);
                    if (gt) *(u32x4*)(GF + gbase + (unsigned)(ai * 8 + m * 2 + bj) * 1024u) = w;
                    else if (wt) __builtin_amdgcn_raw_buffer_store_b128(w, frs, (unsigned)(((unsigned)row * NINP + col0 + bj * HALF) * 2u), 0,   16);
                    else *(u32x4*)(rowp + bj * HALF) = w;
                    if (ob) { float* dst = ob + ((size_t)((row >> 8) * 4 + layer) * 256 + (row & 255)) * 512 + cseg + bj * HALF; *(f32x4*)dst = v0; *(f32x4*)(dst + 4) = v1; } } }
    }
};
struct EpiMerge {
    static constexpr bool PERM = true, AFTER_DRAIN = false;
    const unsigned char* GF; bf16_t* merged;
    __device__ __forceinline__ static float egate(float x) { return __expf(-fminf(fmaxf(x, -30.f), 30.f)); }
    __device__ __forceinline__ void mid(f32x4 (&acc)[2][2][4][2], const Unit& u, int i, int wr, int wc, int fr, int fq) const {
        unsigned off0 = gf_off(i, u.pm, u.pn, wr * 4 + wc) + (unsigned)(fr + 16 * fq) * 16u;
        asm volatile("" : "+v"(off0));
        u32x4 ga[2][2], gb[2][2];
        { const unsigned char* gp = GF + off0;
#pragma unroll
          for (int bj = 0; bj < 2; ++bj) { ga[0][bj] = *(const u32x4*)(gp + bj * 1024); gb[0][bj] = *(const u32x4*)(gp + gf_off(1, 0, 0, 0) + bj * 1024); } }
#pragma unroll
        for (int k = 0; k < 8; ++k) { const int ai = k >> 2, m = k & 3, cb = k & 1, nb = cb ^ 1;
            if (k < 7) { const unsigned char* gp = GF + (off0 + (unsigned)((k + 1) * 2) * 1024u);
#pragma unroll
                for (int bj = 0; bj < 2; ++bj) { ga[nb][bj] = *(const u32x4*)(gp + bj * 1024); gb[nb][bj] = *(const u32x4*)(gp + gf_off(1, 0, 0, 0) + bj * 1024); } }
            asm volatile("" ::: "memory");
#pragma unroll
            for (int bj = 0; bj < 2; ++bj) { const u32x4 xa = ga[cb][bj], xb = gb[cb][bj];
                f32x4 r0, r1;
                r0[0] = (1.f + egate(bf_lo(xb.x))) * __builtin_amdgcn_rcpf(1.f + egate(bf_lo(xa.x))); r0[1] = (1.f + egate(bf_hi(xb.x))) * __builtin_amdgcn_rcpf(1.f + egate(bf_hi(xa.x)));
                r0[2] = (1.f + egate(bf_lo(xb.y))) * __builtin_amdgcn_rcpf(1.f + egate(bf_lo(xa.y))); r0[3] = (1.f + egate(bf_hi(xb.y))) * __builtin_amdgcn_rcpf(1.f + egate(bf_hi(xa.y)));
                r1[0] = (1.f + egate(bf_lo(xb.z))) * __builtin_amdgcn_rcpf(1.f + egate(bf_lo(xa.z))); r1[1] = (1.f + egate(bf_hi(xb.z))) * __builtin_amdgcn_rcpf(1.f + egate(bf_hi(xa.z)));
                r1[2] = (1.f + egate(bf_lo(xb.w))) * __builtin_amdgcn_rcpf(1.f + egate(bf_lo(xa.w))); r1[3] = (1.f + egate(bf_hi(xb.w))) * __builtin_amdgcn_rcpf(1.f + egate(bf_hi(xa.w)));
                acc[ai][bj][m][0] *= r0; acc[ai][bj][m][1] *= r1; }
            asm volatile("" ::: "memory"); }
    }
    __device__ __forceinline__ void operator()(const f32x4 (&acc)[2][2][4][2], const Unit& u, int wr, int wc, int fr, int fq) const {
        const int row0 = u.pm * BM + wr * 64 + fr, col0 = u.pn * BM + wc * 32 + 8 * fq;
#pragma unroll
        for (int ai = 0; ai < 2; ++ai) {
            u32x4 gin[4][2];
#pragma unroll
            for (int m = 0; m < 4; ++m)
#pragma unroll
                for (int bj = 0; bj < 2; ++bj) gin[m][bj] = *(const u32x4*)(GF + gf_off(2, u.pm, u.pn, wr * 4 + wc) + (unsigned)(fr + 16 * fq) * 16u + (unsigned)(ai * 8 + m * 2 + bj) * 1024u);
#pragma unroll
            for (int m = 0; m < 4; ++m) { const int row = row0 + ai * HALF + m * 16;
#pragma unroll
                for (int bj = 0; bj < 2; ++bj) { const int col = col0 + bj * HALF;
                    const u32x4 gw = gin[m][bj];
                    f32x4 g0, g1; g0[0] = __builtin_amdgcn_rcpf(1.f + egate(bf_lo(gw.x))); g0[1] = __builtin_amdgcn_rcpf(1.f + egate(bf_hi(gw.x))); g0[2] = __builtin_amdgcn_rcpf(1.f + egate(bf_lo(gw.y))); g0[3] = __builtin_amdgcn_rcpf(1.f + egate(bf_hi(gw.y)));
                    g1[0] = __builtin_amdgcn_rcpf(1.f + egate(bf_lo(gw.z))); g1[1] = __builtin_amdgcn_rcpf(1.f + egate(bf_hi(gw.z))); g1[2] = __builtin_amdgcn_rcpf(1.f + egate(bf_lo(gw.w))); g1[3] = __builtin_amdgcn_rcpf(1.f + egate(bf_hi(gw.w)));
                    const f32x4 v0 = acc[ai][bj][m][0] * g0, v1 = acc[ai][bj][m][1] * g1;
                    u32x4 w; w.x = cvt_pk_bf16(v0[0], v0[1]); w.y = cvt_pk_bf16(v0[2], v0[3]); w.z = cvt_pk_bf16(v1[0], v1[1]); w.w = cvt_pk_bf16(v1[2], v1[3]);
                    *(u32x4*)(merged + (size_t)row * D + col) = w; } } }
    }
};
struct EpiRes {
    static constexpr bool PERM = true, AFTER_DRAIN = false;
    const bf16_t* src; const float* st; const float* gam; const float* bet; const float* gate; bf16_t* out;
    __device__ __forceinline__ void operator()(const f32x4 (&acc)[2][2][4][2], const Unit& u, int wr, int wc, int fr, int fq) const {
        const int row0 = u.pm * BM + wr * 64 + fr, col0 = u.pn * BM + wc * 32 + 8 * fq;
        const int cidx = u.pm < 16 ? 0 : 1 + ((u.pm - 16) >> 2);
        const float* gp = gate + (size_t)cidx * 12288 + col0;
        f32x2 rs[2][4];
#pragma unroll
        for (int ai = 0; ai < 2; ++ai)
#pragma unroll
            for (int m = 0; m < 4; ++m) { rs[ai][m] = (f32x2){1.f, 0.f}; if (st) rs[ai][m] = *(const f32x2*)(st + 2 * (row0 + ai * HALF + m * 16)); }
#pragma unroll
        for (int bj = 0; bj < 2; ++bj) {
            const f32x4 g0 = *(const f32x4*)(gp + bj * HALF), g1 = *(const f32x4*)(gp + bj * HALF + 4);
            const f32x4 ga0 = *(const f32x4*)(gam + col0 + bj * HALF), ga1 = *(const f32x4*)(gam + col0 + bj * HALF + 4);
            const f32x4 be0 = *(const f32x4*)(bet + col0 + bj * HALF), be1 = *(const f32x4*)(bet + col0 + bj * HALF + 4);
            u32x4 xin[2][4];
            if (bj == 1) {
#pragma unroll
                for (int ai = 0; ai < 2; ++ai)
#pragma unroll
                    for (int m = 0; m < 4; ++m) xin[ai][m] = *(const u32x4*)(src + (size_t)(row0 + ai * HALF + m * 16) * D + col0 + bj * HALF); }
#pragma unroll
            for (int ai = 0; ai < 2; ++ai) {
                if (bj == 0) {
#pragma unroll
                    for (int m = 0; m < 4; ++m) xin[ai][m] = *(const u32x4*)(src + (size_t)(row0 + ai * HALF + m * 16) * D + col0 + bj * HALF); }
#pragma unroll
                for (int m = 0; m < 4; ++m) { const size_t off = (size_t)(row0 + ai * HALF + m * 16) * D + col0 + bj * HALF;
                    const u32x4 xw = xin[ai][m]; const float r = rs[ai][m][0], mr = rs[ai][m][1];
                    const f32x4 x0 = {bf_lo(xw.x), bf_hi(xw.x), bf_lo(xw.y), bf_hi(xw.y)}, x1 = {bf_lo(xw.z), bf_hi(xw.z), bf_lo(xw.w), bf_hi(xw.w)};
                    const f32x4 v0 = (x0 * r - mr) * ga0 + be0 + g0 * acc[ai][bj][m][0], v1 = (x1 * r - mr) * ga1 + be1 + g1 * acc[ai][bj][m][1];
                    u32x4 w; w.x = cvt_pk_bf16(v0[0], v0[1]); w.y = cvt_pk_bf16(v0[2], v0[3]); w.z = cvt_pk_bf16(v1[0], v1[1]); w.w = cvt_pk_bf16(v1[2], v1[3]);
                    *(u32x4*)(out + off) = w; } }
        }
    }
};
struct EpiSwiglu {
    static constexpr bool PERM = true, AFTER_DRAIN = false;
    bf16_t* act;
    __device__ __forceinline__ void operator()(const f32x4 (&acc)[2][2][4][2], const Unit& u, int wr, int wc, int fr, int fq) const {
        const int row0 = u.pm * BM + wr * 64 + fr, col0 = u.pn * HALF + wc * 32 + 8 * fq;
#pragma unroll
        for (int ai = 0; ai < 2; ++ai)
#pragma unroll
            for (int m = 0; m < 4; ++m) { const int row = row0 + ai * HALF + m * 16;
                f32x4 r0, r1;
#pragma unroll
                for (int e = 0; e < 4; ++e) { const float g0 = acc[ai][0][m][0][e], g1 = acc[ai][0][m][1][e];
                    r0[e] = g0 * sigm(g0) * acc[ai][1][m][0][e]; r1[e] = g1 * sigm(g1) * acc[ai][1][m][1][e]; }
                u32x4 w; w.x = cvt_pk_bf16(r0[0], r0[1]); w.y = cvt_pk_bf16(r0[2], r0[3]); w.z = cvt_pk_bf16(r1[0], r1[1]); w.w = cvt_pk_bf16(r1[2], r1[3]);
                *(u32x4*)(act + (size_t)row * FF + col0) = w; }
    }
};

template <class Epi, class Sched, bool ALIGN_EPI = false, bool SP2 = false, bool HOOK = false>
__device__ __forceinline__ void gemm_phase(PG8_LAS unsigned char* lds, const Gemm g, const Sched& S, const Epi& E, const int tid) {
    const int wid = __builtin_amdgcn_readfirstlane(tid >> 6), lane = tid & 63, wr = wid >> 2, wc = wid & 3, fr = lane & 15, fq = lane >> 4;
    const int K = g.K, nt = K / BK;
    unsigned voffA[2], voffB[2];
#pragma unroll
    for (int i = 0; i < 2; ++i) { int R, C; stage_rc(tid * 16 + i * 8192, R, C); const int Rb = Epi::PERM ? ((R & ~31) + perm32(R & 31)) : R;
        voffA[i] = (unsigned)(R * K + C) * 2u; voffB[i] = (unsigned)(Rb * K + C) * 2u; }
    const size_t kstep = (size_t)(BK * 2);
    const size_t hstep = (size_t)HALF * K * 2;
    const size_t tstep = 2 * hstep;
    const unsigned ldsw = (unsigned)wid * 1024u;
    const int aoff = lds_byte(wr * 64 + fr, fq * 8), boff = lds_byte(wc * 32 + fr, fq * 8);
#define PG8_SA(b, h) (((b) * 2 + (h)) * HTB)
#define PG8_SB(b, h) ((4 + (b) * 2 + (h)) * HTB)
#define PG8_STAGE(bufoff, gbase, voff) do { _Pragma("unroll") for (int _i = 0; _i < 2; ++_i) \
        __builtin_amdgcn_global_load_lds((const unsigned*)((const char*)(gbase) + (voff)[_i]), (PG8_LAS unsigned*)(lds + (bufoff) + ldsw + _i * 8192), 16, 0, 0); } while (0)
#define PG8_LDA(dst, b, h) do { _Pragma("unroll") for (int m = 0; m < 4; ++m) _Pragma("unroll") for (int k = 0; k < 2; ++k) dst[m][k] = *(const PG8_LAS bf16x8*)(lds + PG8_SA(b, h) + aoff + m * 2048 + k * 1024); } while (0)
#define PG8_LDB(dst, b, h) do { _Pragma("unroll") for (int n = 0; n < 2; ++n) _Pragma("unroll") for (int k = 0; k < 2; ++k) dst[n][k] = *(const PG8_LAS bf16x8*)(lds + PG8_SB(b, h) + boff + n * 2048 + k * 1024); } while (0)
#define PG8_MMA(ai, bj, At, Bt) do { __builtin_amdgcn_s_setprio(1); _Pragma("unroll") for (int m = 0; m < 4; ++m) _Pragma("unroll") for (int n = 0; n < 2; ++n) _Pragma("unroll") for (int k = 0; k < 2; ++k) \
        acc[ai][bj][m][n] = __builtin_amdgcn_mfma_f32_16x16x32_f16(__builtin_bit_cast(h16x8, Bt[n][k]), __builtin_bit_cast(h16x8, At[m][k]), acc[ai][bj][m][n], 0, 0, 0); __builtin_amdgcn_s_setprio(0); } while (0)
#define PG8_WAIT_V(n) asm volatile("s_waitcnt vmcnt(" #n ")" ::: "memory")
#define PG8_WAIT_L(n) asm volatile("s_waitcnt lgkmcnt(" #n ")" ::: "memory")
#define PG8_BAR __builtin_amdgcn_s_barrier()
#define PG8_SCHED __builtin_amdgcn_sched_barrier(0)
    Unit cur, nxt; int ui = 0;
    if (!S.next(0, cur)) return;
    f32x4 acc[2][2][4][2];
#pragma unroll
    for (int a = 0; a < 2; ++a)
#pragma unroll
        for (int b = 0; b < 2; ++b)
#pragma unroll
            for (int m = 0; m < 4; ++m)
#pragma unroll
                for (int n = 0; n < 2; ++n) acc[a][b][m][n] = (f32x4){0.f, 0.f, 0.f, 0.f};
    bf16x8 At[4][2], B0[2][2], B1[2][2];
    const char* cA = (const char*)g.A + (size_t)cur.pm * tstep; const char* cB = (const char*)g.Bt + (size_t)cur.pn * tstep;
    S.a_ready(cur);
    if constexpr (SP2) {
        PG8_STAGE(PG8_SB(0, 0), cB, voffB); PG8_STAGE(PG8_SB(0, 1), cB + hstep, voffB); PG8_STAGE(PG8_SA(0, 0), cA, voffA); PG8_STAGE(PG8_SA(0, 1), cA + hstep, voffA);
        PG8_STAGE(PG8_SB(1, 0), cB + kstep, voffB); PG8_STAGE(PG8_SA(1, 0), cA + kstep, voffA); PG8_STAGE(PG8_SB(1, 1), cB + hstep + kstep, voffB);
        if (wr == 1) PG8_BAR;
        PG8_WAIT_V(8); PG8_BAR;
        PG8_WAIT_V(6); PG8_BAR;
    } else {
        PG8_STAGE(PG8_SB(0, 0), cB, voffB); PG8_STAGE(PG8_SA(0, 0), cA, voffA); PG8_STAGE(PG8_SB(0, 1), cB + hstep, voffB); PG8_STAGE(PG8_SA(0, 1), cA + hstep, voffA);
        if (wr == 1) PG8_BAR;
        PG8_WAIT_V(4); PG8_BAR;
        PG8_STAGE(PG8_SB(1, 0), cB + kstep, voffB); PG8_STAGE(PG8_SA(1, 0), cA + kstep, voffA); PG8_STAGE(PG8_SB(1, 1), cB + hstep + kstep, voffB);
        PG8_WAIT_V(6); PG8_BAR;
    }
    for (;;) {
        const bool has_next = S.next(ui + 1, nxt);
        const char* nA = has_next ? (const char*)g.A + (size_t)nxt.pm * tstep : cA; const char* nB = has_next ? (const char*)g.Bt + (size_t)nxt.pn * tstep : cB;
        for (int t = 0; t < nt; t += 2) {
            if constexpr (HOOK) { if (t == 8 || t == 16) E.mid(acc, cur, (t >> 3) - 1, wr, wc, fr, fq); }
            const bool last = (t == nt - 2);
            const char* a1 = cA + (size_t)(t + 1) * kstep;
            const char* a2 = last ? nA : cA + (size_t)(t + 2) * kstep; const char* b2 = last ? nB : cB + (size_t)(t + 2) * kstep;
            const char* a3 = a2 + kstep; const char* b3 = b2 + kstep;
            if (last && has_next) S.a_ready(nxt);
            if constexpr (SP2) {
            PG8_LDB(B0, 0, 0); PG8_LDB(B1, 0, 1); PG8_SCHED; PG8_LDA(At, 0, 0); PG8_STAGE(PG8_SA(1, 1), a1 + hstep, voffA);
            PG8_WAIT_V(8); PG8_WAIT_L(0); PG8_BAR; PG8_MMA(0, 0, At, B0); PG8_MMA(0, 1, At, B1); PG8_BAR; PG8_SCHED;
            PG8_LDA(At, 0, 1); PG8_STAGE(PG8_SB(0, 0), b2, voffB); PG8_STAGE(PG8_SB(0, 1), b2 + hstep, voffB); PG8_STAGE(PG8_SA(0, 0), a2, voffA);
            PG8_WAIT_V(8); PG8_WAIT_L(0); PG8_BAR; PG8_MMA(1, 0, At, B0); PG8_MMA(1, 1, At, B1); PG8_BAR; PG8_SCHED;
            PG8_LDB(B0, 1, 0); PG8_LDB(B1, 1, 1); PG8_SCHED; PG8_LDA(At, 1, 0); PG8_STAGE(PG8_SA(0, 1), a2 + hstep, voffA);
            PG8_WAIT_V(8); PG8_WAIT_L(0); PG8_BAR; PG8_MMA(0, 0, At, B0); PG8_MMA(0, 1, At, B1); PG8_BAR; PG8_SCHED;
            PG8_LDA(At, 1, 1); PG8_STAGE(PG8_SB(1, 0), b3, voffB); PG8_STAGE(PG8_SB(1, 1), b3 + hstep, voffB); PG8_STAGE(PG8_SA(1, 0), a3, voffA);
            PG8_WAIT_V(8); PG8_WAIT_L(0); PG8_BAR; PG8_MMA(1, 0, At, B0); PG8_MMA(1, 1, At, B1); PG8_BAR; PG8_SCHED;
            } else {
            PG8_LDB(B0, 0, 0); PG8_SCHED; PG8_LDA(At, 0, 0); PG8_STAGE(PG8_SA(1, 1), a1 + hstep, voffA);
            PG8_WAIT_L(8); PG8_BAR; PG8_WAIT_L(0); PG8_MMA(0, 0, At, B0); PG8_BAR; PG8_SCHED;
            PG8_LDB(B1, 0, 1); PG8_STAGE(PG8_SB(0, 0), b2, voffB);
            PG8_BAR; PG8_WAIT_L(0); PG8_MMA(0, 1, At, B1); PG8_BAR;
            PG8_LDA(At, 0, 1); PG8_STAGE(PG8_SA(0, 0), a2, voffA);
            PG8_BAR; PG8_WAIT_L(0); PG8_MMA(1, 0, At, B0); PG8_BAR; PG8_SCHED;
            PG8_STAGE(PG8_SB(0, 1), b2 + hstep, voffB);
            PG8_WAIT_V(6); PG8_BAR; PG8_MMA(1, 1, At, B1); PG8_BAR;
            PG8_LDB(B0, 1, 0); PG8_SCHED; PG8_LDA(At, 1, 0); PG8_STAGE(PG8_SA(0, 1), a2 + hstep, voffA);
            PG8_WAIT_L(8); PG8_BAR; PG8_WAIT_L(0); PG8_MMA(0, 0, At, B0); PG8_BAR; PG8_SCHED;
            PG8_LDB(B1, 1, 1); PG8_STAGE(PG8_SB(1, 0), b3, voffB);
            PG8_BAR; PG8_WAIT_L(0); PG8_MMA(0, 1, At, B1); PG8_BAR;
            PG8_LDA(At, 1, 1); PG8_STAGE(PG8_SA(1, 0), a3, voffA);
            PG8_BAR; PG8_WAIT_L(0); PG8_MMA(1, 0, At, B0); PG8_BAR; PG8_SCHED;
            PG8_STAGE(PG8_SB(1, 1), b3 + hstep, voffB);
            PG8_WAIT_V(6); PG8_BAR; PG8_MMA(1, 1, At, B1); PG8_BAR;
            }
        }
        if constexpr (ALIGN_EPI) { if (wr == 0) PG8_BAR; }
        if constexpr (!Epi::AFTER_DRAIN) { E(acc, cur, wr, wc, fr, fq); S.done(cur); }
        if (!has_next) break;
#pragma unroll
        for (int a = 0; a < 2; ++a)
#pragma unroll
            for (int b = 0; b < 2; ++b)
#pragma unroll
                for (int m = 0; m < 4; ++m)
#pragma unroll
                    for (int n = 0; n < 2; ++n) acc[a][b][m][n] = (f32x4){0.f, 0.f, 0.f, 0.f};
        cur = nxt; cA = nA; cB = nB; ++ui;
        if constexpr (ALIGN_EPI) { if (wr == 1) PG8_BAR; }
    }
    PG8_WAIT_V(0);
    if constexpr (!ALIGN_EPI) { if (wr == 0) PG8_BAR; }
    PG8_BAR;
    if constexpr (Epi::AFTER_DRAIN) { E.fused(acc, cur, wr, wc, fr, fq, lds, wid, lane); S.done(cur); }
#undef PG8_SA
#undef PG8_SB
#undef PG8_STAGE
#undef PG8_LDA
#undef PG8_LDB
#undef PG8_MMA
#undef PG8_WAIT_V
#undef PG8_WAIT_L
#undef PG8_BAR
#undef PG8_SCHED
}
}

#define GAS __attribute__((address_space(1)))
#define LAS __attribute__((address_space(3)))
typedef unsigned short bf16;
typedef unsigned v4u __attribute__((ext_vector_type(4)));
typedef float f32x4 __attribute__((ext_vector_type(4)));
typedef short bf16x8 __attribute__((ext_vector_type(8)));
typedef GAS unsigned gu32;
typedef GAS unsigned long long gu64;
#define RLX_AGENT __ATOMIC_RELAXED, __HIP_MEMORY_SCOPE_AGENT
#define LDS_WAIT() asm volatile("s_waitcnt lgkmcnt(0)" ::: "memory")
#define VM_WAIT() asm volatile("s_waitcnt vmcnt(0)" ::: "memory")
__device__ __forceinline__ unsigned long long rt() { return __builtin_amdgcn_s_memrealtime(); }
__device__ __forceinline__ unsigned f2bf(float f) { unsigned u = __builtin_bit_cast(unsigned, f); return (u + 0x7fffu + ((u >> 16) & 1u)) >> 16; }
__device__ __forceinline__ unsigned pk2(float lo, float hi) { return f2bf(lo) | (f2bf(hi) << 16); }

#define XB_TMO      128
#define XB_XCNT(j)  (256  + 64 * (j))
#define XB_XSUB(j)  (1280 + 64 * (j))
#define XB_XGEN(j)  (2304 + 64 * (j))
#define XB_TOP      3328
#define XB_TOPGEN   3392
#define XCD_BAR_WORDS 3456
#define XB_SPIN_CAP (1u << 18)

__device__ __forceinline__ unsigned xb_ld(unsigned* p)              { return __hip_atomic_load(p, __ATOMIC_RELAXED, __HIP_MEMORY_SCOPE_AGENT); }
__device__ __forceinline__ unsigned xb_add(unsigned* p, unsigned v) { return __hip_atomic_fetch_add(p, v, __ATOMIC_RELAXED, __HIP_MEMORY_SCOPE_AGENT); }
__device__ __forceinline__ unsigned xb_xcc_id() { return (unsigned)__builtin_amdgcn_s_getreg((3 << 11) | 20) & 0xFu; }
#define XB_SPIN(cond, bar) do { unsigned _sp = 0; while (cond) { __builtin_amdgcn_s_sleep(1); \
    if ((++_sp & 255u) == 0u) { if (xb_ld(&(bar)[XB_TMO])) break; if (_sp > XB_SPIN_CAP) { atomicAdd(&(bar)[XB_TMO], 1u); break; } } } } while (0)

struct XcdBarrier {
    unsigned* bar; unsigned x;
    volatile LAS unsigned* st;
};

__device__ __forceinline__ XcdBarrier xcd_barrier_post(unsigned* bar, volatile LAS unsigned* st) {
    XcdBarrier b; b.bar = bar; b.x = xb_xcc_id(); b.st = st;
    if (threadIdx.x == 0) (void)xb_add(&bar[XB_XCNT(b.x)], 1u);
    return b;
}
__device__ __forceinline__ void xcd_barrier_complete(unsigned* bar, unsigned x, unsigned& nloc, unsigned& nx) {
    const unsigned G = gridDim.x * gridDim.y * gridDim.z;
    unsigned sum, cnt, mine, sp = 0u;
    for (;;) {
        sum = 0u; cnt = 0u; mine = 0u;
#pragma unroll
        for (unsigned j = 0; j < 16; ++j) { const unsigned c = xb_ld(&bar[XB_XCNT(j)]); sum += c; cnt += (c > 0u) ? 1u : 0u; mine = (j == x) ? c : mine; }
        if (sum == G) break;
        __builtin_amdgcn_s_sleep(1);
        if ((++sp & 255u) == 0u) { if (xb_ld(&bar[XB_TMO])) break; if (sp > XB_SPIN_CAP) { atomicAdd(&bar[XB_TMO], 1u); break; } }
    }
    nloc = mine > 0u ? mine : 1u; nx = cnt > 0u ? cnt : 1u;
}

__device__ __forceinline__ void xcd_barrier(const XcdBarrier& b) {
    asm volatile("s_waitcnt vmcnt(0)" ::: "memory");
    __syncthreads();
    if (threadIdx.x == 0) {
        unsigned* bar = b.bar;
        __builtin_amdgcn_s_waitcnt(0);
        unsigned nloc = b.st[0], nx = b.st[1];
        if (nloc == 0u) { xcd_barrier_complete(bar, b.x, nloc, nx); b.st[0] = nloc; b.st[1] = nx; }
        const unsigned old = xb_add(&bar[XB_XSUB(b.x)], 1u);
        const unsigned gen = old / nloc;
        if (old + 1u == (gen + 1u) * nloc) {
            __builtin_amdgcn_fence(__ATOMIC_RELEASE, "agent");
            asm volatile("s_waitcnt vmcnt(0)" ::: "memory");
            const unsigned og = xb_add(&bar[XB_TOP], 1u);
            const unsigned tg = og / nx;
            if (og + 1u == (tg + 1u) * nx) xb_add(&bar[XB_TOPGEN], 1u);
            else XB_SPIN(xb_ld(&bar[XB_TOPGEN]) == tg, bar);
            __builtin_amdgcn_fence(__ATOMIC_ACQUIRE, "agent");
            xb_add(&bar[XB_XGEN(b.x)], 1u);
            asm volatile("s_waitcnt vmcnt(0)" ::: "memory");
        } else {
            XB_SPIN(xb_ld(&bar[XB_XGEN(b.x)]) == gen, bar);
            __builtin_amdgcn_fence(__ATOMIC_ACQUIRE, "agent");
            asm volatile("s_waitcnt vmcnt(0)" ::: "memory");
        }
    }
    __syncthreads();
}

constexpr float DN_ALPHA = 1.681792830507429f;
constexpr size_t MiB = 1u << 20;
constexpr size_t WS_CTL = 0, CTL_ZERO_BYTES = 1 * MiB;
constexpr size_t WS_MOD = 1 * MiB;
constexpr size_t WS_LAM = 2 * MiB, WS_ROPE = 2 * MiB + 4096, WS_W2T = 2 * MiB + 65536, WS_A2T = WS_W2T + 524288, WS_G2T = WS_A2T + 524288;
constexpr size_t WS_CKNA = 4 * MiB, WS_CVNA = 8 * MiB, WS_CKDF = 12 * MiB, WS_CVDF = 16 * MiB;
constexpr size_t WS_WIN = 20 * MiB, WS_WBR = 196 * MiB, WS_WO = 220 * MiB, WS_WFI = 252 * MiB, WS_WFO = 428 * MiB;
constexpr size_t WS_H = 516 * MiB;
constexpr size_t WS_F = 548 * MiB;
constexpr size_t WS_O3 = 724 * MiB;
constexpr size_t WS_MBUF = 748 * MiB;
constexpr size_t WS_MERGED = 812 * MiB;
constexpr size_t WS_X = 844 * MiB;
constexpr size_t WS_ST1 = 876 * MiB, WS_ST2 = 877 * MiB;
constexpr size_t WS_GB = 878 * MiB;
constexpr size_t WS_GF = 920 * MiB;
constexpr size_t WS_SI = 908 * MiB;
constexpr size_t WS_Y = 1100 * MiB;
constexpr size_t WS_G = 1132 * MiB;
constexpr size_t WS_BON = 1148 * MiB;
constexpr size_t WS_QR = 1149 * MiB, WS_KR = 1153 * MiB;
constexpr size_t WS_END = 1245 * MiB;
constexpr int CW_BAR = 4096, CW_MIXQ = 16384, CW_RB = 32768, CW_PREQ = 49152;

constexpr int RING_BYTES = 131072, MISC_OFF = RING_BYTES + 320, LDS_BYTES = 147456;
constexpr int NWAVES = 8;

struct Args { const float* in[35]; float* out; unsigned char* ws; int l_lo, l_hi, ph_lo, ph_hi; };
#define CAS __attribute__((address_space(4)))
typedef const CAS Args& ArgsRef;

typedef unsigned v2u __attribute__((ext_vector_type(2)));
typedef short s16x4 __attribute__((ext_vector_type(4)));
typedef short v4i16_t __attribute__((ext_vector_type(4)));
using pg8::cvt_pk_bf16; using pg8::bf_lo; using pg8::bf_hi; using pg8::sigm;

__device__ __forceinline__ bf16 f2h(float v) { return __builtin_bit_cast(unsigned short, (_Float16)v); }
template <int CTRL> __device__ __forceinline__ float dpp(float x) { return __builtin_bit_cast(float, __builtin_amdgcn_mov_dpp(__builtin_bit_cast(int, x), CTRL, 0xf, 0xf, true)); }
template <int CTRL> __device__ __forceinline__ float dppf(float x) { return __builtin_bit_cast(float, __builtin_amdgcn_update_dpp(0x3f800000, __builtin_bit_cast(int, x), CTRL, 0xf, 0xf, false)); }
__device__ __forceinline__ float red8(float x) { x += dpp<0xB1>(x); x += dpp<0x4E>(x); x += dpp<0x141>(x); return x; }
__device__ __forceinline__ float xrow16_max(float x) { x = fmaxf(x, __shfl_xor(x, 16)); x = fmaxf(x, __shfl_xor(x, 32)); return x; }
__device__ __forceinline__ float xrow16_sum(float x) { x += __shfl_xor(x, 16); x += __shfl_xor(x, 32); return x; }
__device__ __forceinline__ float wave_sum(float v) {
    v += dpp<0xB1>(v); v += dpp<0x4E>(v); v += dpp<0x141>(v); v += dpp<0x128>(v);
    return xrow16_sum(v);
}
__device__ __forceinline__ s16x4 vtr(const LAS unsigned char* p) { return __builtin_bit_cast(s16x4, __builtin_amdgcn_ds_read_tr16_b64_v4i16((LAS v4i16_t*)p)); }
__device__ __forceinline__ f32x4 mfma16(bf16x8 a, bf16x8 b, f32x4 c) { return __builtin_amdgcn_mfma_f32_16x16x32_f16(__builtin_bit_cast(pg8::h16x8, a), __builtin_bit_cast(pg8::h16x8, b), c, 0, 0, 0); }

__device__ __forceinline__ void phase_ada(ArgsRef a, unsigned char* ws, LAS unsigned char* lds, int tid, int bid, int G) {
    LAS float* sc = (LAS float*)lds;
    LAS float* red = sc + 5 * 2048;
    const float* cvec = a.in[8]; const float* cctx = a.in[9];
    for (int i = tid; i < 5 * 2048; i += 512) { const int c = i >> 11, k = i & 2047; const float v = c == 0 ? cctx[k] : cvec[(c - 1) * 2048 + k]; sc[i] = v / (1.0f + expf(-v)); }
    __syncthreads();
    const int wave = tid >> 6, lane = tid & 63;
    float* MOD = (float*)(ws + WS_MOD);
    for (int unit = bid; unit < NL * 96; unit += G) {
        const int l = unit / 96, n0 = (unit % 96) * 128;
        const float* W = a.in[10] + (size_t)l * 2048 * 12288 + n0 + 2 * lane;
        float acc[5][2];
#pragma unroll
        for (int c = 0; c < 5; ++c) { acc[c][0] = 0.f; acc[c][1] = 0.f; }
        const int k0 = wave * 256;
        for (int kk = 0; kk < 256; kk += 8) {
            pg8::f32x2 w[8];
#pragma unroll
            for (int j = 0; j < 8; ++j) w[j] = *(const pg8::f32x2*)(W + (size_t)(k0 + kk + j) * 12288);
#pragma unroll
            for (int j = 0; j < 8; ++j)
#pragma unroll
                for (int c = 0; c < 5; ++c) { const float s = sc[c * 2048 + k0 + kk + j]; acc[c][0] += s * w[j].x; acc[c][1] += s * w[j].y; }
        }
#pragma unroll
        for (int c = 0; c < 5; ++c) { red[(wave * 5 + c) * 128 + 2 * lane] = acc[c][0]; red[(wave * 5 + c) * 128 + 2 * lane + 1] = acc[c][1]; }
        __syncthreads();
        for (int i = tid; i < 5 * 128; i += 512) { const int c = i >> 7, n = i & 127; float s = 0.f;
#pragma unroll
            for (int w = 0; w < 8; ++w) s += red[(w * 5 + c) * 128 + n];
            MOD[((size_t)l * 5 + c) * 12288 + n0 + n] = s + a.in[11][(size_t)l * 12288 + n0 + n]; }
        __syncthreads();
    }
}

__device__ __forceinline__ void transpose_item(const float* W, int K, int N, bf16* WT, int k0, int n0, int drow0, LAS float* scr, int lane, int ldk = 0) {
    if (ldk == 0) ldk = K;
    { f32x4 r[8];
#pragma unroll
      for (int i = 0; i < 8; ++i) r[i] = *(const f32x4*)(W + (size_t)(k0 + 8 * i + (lane >> 3)) * N + n0 + 4 * (lane & 7));
#pragma unroll
      for (int i = 0; i < 8; ++i) { LAS float* d = scr + (8 * i + (lane >> 3)) * 33 + 4 * (lane & 7); d[0] = r[i][0]; d[1] = r[i][1]; d[2] = r[i][2]; d[3] = r[i][3]; } }
    LDS_WAIT(); asm volatile("" ::: "memory");
    const int c = lane & 7;
#pragma unroll
    for (int j = 0; j < 4; ++j) { const int n = (lane >> 3) + 8 * j; const LAS float* s = scr + (8 * c) * 33 + n;
        v4u o; o.x = cvt_pk_bf16(s[0 * 33], s[1 * 33]); o.y = cvt_pk_bf16(s[2 * 33], s[3 * 33]); o.z = cvt_pk_bf16(s[4 * 33], s[5 * 33]); o.w = cvt_pk_bf16(s[6 * 33], s[7 * 33]);
        *(v4u*)(WT + (size_t)(drow0 + n) * ldk + k0 + 8 * c) = o; }
    LDS_WAIT(); asm volatile("" ::: "memory");
}
constexpr int IT_WIN = 32 * 348, IT_WBR = 3 * 8 * 64, IT_WO = 32 * 64, IT_WFI = 32 * 352, IT_WFO = 88 * 64, IT_LAYER = IT_WIN + IT_WBR + IT_WO + IT_WFI + IT_WFO;
__device__ __forceinline__ void phase_cvt(ArgsRef a, unsigned char* ws, LAS unsigned char* lds, int tid, int bid, int G) {
    const int wave = tid >> 6, lane = tid & 63;
    LAS float* scr = (LAS float*)(lds + wave * 16384);
    const int gw = bid * NWAVES + wave, NGW = G * NWAVES;
    constexpr int IT_ALL = NL * IT_LAYER, IT_EVEN = 56 * 2048;
    const bool skew = (G == 256);
    for (int it = gw, st2 = 0; ; ) {
        if (!skew) { if (it >= IT_ALL) break; }
        else if (!st2) { if (it >= IT_EVEN) { st2 = 1; if (bid < 128) break; it = IT_EVEN + (gw - 1024); continue; } }
        else if (it >= IT_ALL) break;
        const int it_next = it + ((skew && st2) ? 1024 : NGW);
        const int l = it / IT_LAYER; int r = it - l * IT_LAYER;
        if (r < IT_WIN) { const int kb = r / 348, nb = r - kb * 348, n0 = 32 * nb;
            transpose_item(a.in[12] + (size_t)l * D * NIN, D, NIN, (bf16*)(ws + WS_WIN) + (size_t)l * NINP * D, 64 * kb, n0, n0 + (n0 >= 4992 ? 128 : 0), scr, lane); it = it_next; continue; }
        r -= IT_WIN;
        if (r < IT_WBR) { const int i = r >> 9, rr = r & 511, kb = rr >> 6, nb = rr & 63;
            transpose_item(a.in[27] + (size_t)(l * 3 + i) * 512 * D, 512, D, (bf16*)(ws + WS_WBR) + (size_t)l * D * 1536 + i * 512, 64 * kb, 32 * nb, 32 * nb, scr, lane, 1536); it = it_next; continue; }
        r -= IT_WBR;
        if (r < IT_WO) { const int kb = r >> 6, nb = r & 63;
            transpose_item(a.in[28] + (size_t)l * D * D, D, D, (bf16*)(ws + WS_WO) + (size_t)l * D * D, 64 * kb, 32 * nb, 32 * nb, scr, lane); it = it_next; continue; }
        r -= IT_WO;
        if (r < IT_WFI) { const int kb = r / 352, nb = r - kb * 352, n0 = 32 * nb;
            const int dr = n0 < FF ? (n0 >> 7) * 256 + (n0 & 127) : ((n0 - FF) >> 7) * 256 + 128 + ((n0 - FF) & 127);
            transpose_item(a.in[31] + (size_t)l * D * NFI, D, NFI, (bf16*)(ws + WS_WFI) + (size_t)l * NFI * D, 64 * kb, n0, dr, scr, lane); it = it_next; continue; }
        r -= IT_WFI;
        { const int kb = r >> 6, nb = r & 63;
            transpose_item(a.in[32] + (size_t)l * FF * D, FF, D, (bf16*)(ws + WS_WFO) + (size_t)l * D * FF, 64 * kb, 32 * nb, 32 * nb, scr, lane); }
        it = it_next;
    }
    const int gt = bid * 512 + tid, NGT = G * 512;
    for (int i = gt; i < 4 * 262144; i += NGT) { const int t = i >> 18, e = (i & 262143) * 8;
        const float* src = a.in[2 + t] + e; const f32x4 x0 = *(const f32x4*)src, x1 = *(const f32x4*)(src + 4);
        v4u o; o.x = cvt_pk_bf16(x0[0], x0[1]); o.y = cvt_pk_bf16(x0[2], x0[3]); o.z = cvt_pk_bf16(x1[0], x1[1]); o.w = cvt_pk_bf16(x1[2], x1[3]);
        *(v4u*)((bf16*)(ws + WS_CKNA + (size_t)t * 4 * MiB) + e) = o; }
    for (int i = gt; i < 3 * 262144; i += NGT) { const int t = i >> 18, e = i & 262143;
        if (t < 2) { const int j = e & 63, c = (e >> 6) & 511, ld = e >> 15;
            const float v = a.in[t == 0 ? 18 : 20][((size_t)ld * 64 + j) * 512 + c];
            ((bf16*)(ws + (t == 0 ? WS_W2T : WS_A2T)))[e] = f2h(v); }
        else { const int j = e & 127, c = (e >> 7) & 511, l = e >> 16;
            ((bf16*)(ws + WS_G2T))[e] = f2h(a.in[21][((size_t)l * 128 + j) * 512 + c]); } }
    for (int i = gt; i < 64 * 16; i += NGT) { const int pos = i >> 4, f = i & 15; const float inv = powf(10000.0f, -(float)f / 16.0f); const float ang = (float)pos * inv;
        float* rp = (float*)(ws + WS_ROPE) + 2 * i; rp[0] = cosf(ang); rp[1] = sinf(ang); }
    for (int i = gt; i < 9 * D; i += NGT) { const int k = i / D, c = i - k * D; float gv = 1.f, bv = 0.f;
        if (k > 0) { const int l = (k - 1) >> 1; if ((k - 1) & 1) { gv = a.in[33][l * D + c]; bv = a.in[34][l * D + c]; } else { gv = a.in[29][l * D + c]; bv = a.in[30][l * D + c]; } }
        float* gb = (float*)(ws + WS_GB) + (size_t)k * 2 * D; gb[c] = DN_ALPHA * gv; gb[D + c] = DN_ALPHA * bv; }
    if (gw < NL) { const float* lp = a.in[14] + gw * 256; const float s1 = wave_sum(lp[lane] * lp[64 + lane]), s2 = wave_sum(lp[128 + lane] * lp[192 + lane]);
        const float li = gw == 0 ? 0.2f : gw == 1 ? 0.355509067590969f : gw == 2 ? 0.470713018343584f : 0.556058204155641f;
        if (lane == 0) ((float*)(ws + WS_LAM))[gw] = expf(s1) - expf(s2) + li; }
}
__device__ __forceinline__ float lam_init_of(int l) { return l == 0 ? 0.2f : l == 1 ? 0.355509067590969f : l == 2 ? 0.470713018343584f : 0.556058204155641f; }

template <int MODE> __device__ __forceinline__ void phase_ln(ArgsRef a, unsigned char* ws, int l, int gw, int NGW, int lane) {
    const float* MODp = (const float*)(ws + WS_MOD);
    bf16* X = (bf16*)(ws + WS_X); bf16* H = (bf16*)(ws + WS_H);
    const float* lg = MODE == 1 ? a.in[29] + l * D : a.in[33] + l * D; const float* lb = MODE == 1 ? a.in[30] + l * D : a.in[34] + l * D;
    const int ml = MODE == 2 ? l + 1 : l, mi = MODE == 1 ? 3 : 0;
    for (int row = gw; row < MT; row += NGW) {
        f32x4 v[8]; float s = 0.f;
        if (MODE == 0) { const float* src = (row < NCTX ? a.in[0] + (size_t)row * D : a.in[1] + (size_t)(row - NCTX) * D) + 8 * lane;
#pragma unroll
            for (int j = 0; j < 4; ++j) { v[2 * j] = *(const f32x4*)(src + 512 * j); v[2 * j + 1] = *(const f32x4*)(src + 512 * j + 4); } }
        else { const bf16* src = (const bf16*)(ws + WS_MBUF) + (size_t)row * D + 8 * lane;
#pragma unroll
            for (int j = 0; j < 4; ++j) { const v4u w = *(const v4u*)(src + 512 * j);
                v[2 * j] = (f32x4){bf_lo(w.x), bf_hi(w.x), bf_lo(w.y), bf_hi(w.y)}; v[2 * j + 1] = (f32x4){bf_lo(w.z), bf_hi(w.z), bf_lo(w.w), bf_hi(w.w)}; } }
#pragma unroll
        for (int j = 0; j < 8; ++j) s += (v[j][0] + v[j][1]) + (v[j][2] + v[j][3]);
        if (MODE != 0) {
            const float mean = wave_sum(s) * (1.f / D); float s2 = 0.f;
#pragma unroll
            for (int j = 0; j < 8; ++j) { v[j] = v[j] - mean; s2 += (v[j][0] * v[j][0] + v[j][1] * v[j][1]) + (v[j][2] * v[j][2] + v[j][3] * v[j][3]); }
            const float rstd = __builtin_amdgcn_rsqf(wave_sum(s2) * (1.f / D) + LN_EPS);
            if (MODE != 3 && lane == 0) *(pg8::f32x2*)((float*)(ws + (MODE == 1 ? WS_ST1 : WS_ST2)) + 2 * row) = (pg8::f32x2){rstd, mean * rstd};
            s = 0.f;
#pragma unroll
            for (int j = 0; j < 8; ++j) { const int co = 8 * lane + 512 * (j >> 1) + 4 * (j & 1); const f32x4 gg = *(const f32x4*)(lg + co), bb = *(const f32x4*)(lb + co);
                v[j] = v[j] * rstd * gg + bb; s += (v[j][0] + v[j][1]) + (v[j][2] + v[j][3]); }
        }
        if (MODE == 3) { float* xo = a.out + (size_t)row * D + 8 * lane;
#pragma unroll
            for (int j = 0; j < 4; ++j) { *(f32x4*)(xo + 512 * j) = v[2 * j]; *(f32x4*)(xo + 512 * j + 4) = v[2 * j + 1]; } }
        else if (MODE == 0) { bf16* xo = X + (size_t)row * D + 8 * lane;
#pragma unroll
            for (int j = 0; j < 4; ++j) { v4u w; w.x = cvt_pk_bf16(v[2 * j][0], v[2 * j][1]); w.y = cvt_pk_bf16(v[2 * j][2], v[2 * j][3]); w.z = cvt_pk_bf16(v[2 * j + 1][0], v[2 * j + 1][1]); w.w = cvt_pk_bf16(v[2 * j + 1][2], v[2 * j + 1][3]);
                *(v4u*)(xo + 512 * j) = w; } }
        if (MODE != 3) {
            const float mean = wave_sum(s) * (1.f / D); float s2 = 0.f;
#pragma unroll
            for (int j = 0; j < 8; ++j) { v[j] = v[j] - mean; s2 += (v[j][0] * v[j][0] + v[j][1] * v[j][1]) + (v[j][2] * v[j][2] + v[j][3] * v[j][3]); }
            const float rstd = __builtin_amdgcn_rsqf(wave_sum(s2) * (1.f / D) + LN_EPS);
            const int cidx = row < NCTX ? 0 : 1 + ((row - NCTX) >> 10);
            const float* shp = MODp + ((size_t)ml * 5 + cidx) * 12288 + mi * D; const float* scp = shp + D;
            bf16* ho = H + (size_t)row * D + 8 * lane;
#pragma unroll
            for (int j = 0; j < 4; ++j) { const int co = 8 * lane + 512 * j;
                const f32x4 h0 = v[2 * j] * rstd * (*(const f32x4*)(scp + co) + 1.0f) + *(const f32x4*)(shp + co), h1 = v[2 * j + 1] * rstd * (*(const f32x4*)(scp + co + 4) + 1.0f) + *(const f32x4*)(shp + co + 4);
                v4u w; w.x = cvt_pk_bf16(h0[0], h0[1]); w.y = cvt_pk_bf16(h0[2], h0[3]); w.z = cvt_pk_bf16(h1[0], h1[1]); w.w = cvt_pk_bf16(h1[2], h1[3]);
                *(v4u*)(ho + 512 * j) = w; }
        }
    }
}

__device__ __forceinline__ void shift8(const bf16* F, unsigned fo, bool hp, bool hn, const float* mix, unsigned mo, float (&o)[8]) {
    const v4u c = *(const v4u*)(F + fo); v4u p = {0u, 0u, 0u, 0u}, n = {0u, 0u, 0u, 0u};
    if (hp) p = *(const v4u*)(F + (fo - NINP)); if (hn) n = *(const v4u*)(F + (fo + NINP));
    const f32x4 m0a = *(const f32x4*)(mix + mo), m0b = *(const f32x4*)(mix + (mo + 4)), m1a = *(const f32x4*)(mix + (mo + 1920)), m1b = *(const f32x4*)(mix + (mo + 1924));
#pragma unroll
    for (int w = 0; w < 4; ++w) { const unsigned cw = c[w], pw = p[w], nw = n[w];
        const float f0 = bf_lo(cw), f1 = bf_hi(cw); const float m00 = w < 2 ? m0a[2 * w] : m0b[2 * w - 4], m01 = w < 2 ? m0a[2 * w + 1] : m0b[2 * w - 3];
        const float m10 = w < 2 ? m1a[2 * w] : m1b[2 * w - 4], m11 = w < 2 ? m1a[2 * w + 1] : m1b[2 * w - 3];
        o[2 * w] = f0 + m00 * (bf_lo(pw) - f0) + m10 * (bf_lo(nw) - f0); o[2 * w + 1] = f1 + m01 * (bf_hi(pw) - f1) + m11 * (bf_hi(nw) - f1); }
}
__device__ __forceinline__ f32x4 shift4(const bf16* F, unsigned fo, bool hp, bool hn, const float* mix, unsigned mo) {
    const v2u c = *(const v2u*)(F + fo); v2u p = {0u, 0u}, n = {0u, 0u};
    if (hp) p = *(const v2u*)(F + (fo - NINP)); if (hn) n = *(const v2u*)(F + (fo + NINP));
    const f32x4 m0 = *(const f32x4*)(mix + mo), m1 = *(const f32x4*)(mix + (mo + 1920));
    f32x4 f, pv, nv; f[0] = bf_lo(c.x); f[1] = bf_hi(c.x); f[2] = bf_lo(c.y); f[3] = bf_hi(c.y);
    pv[0] = bf_lo(p.x); pv[1] = bf_hi(p.x); pv[2] = bf_lo(p.y); pv[3] = bf_hi(p.y); nv[0] = bf_lo(n.x); nv[1] = bf_hi(n.x); nv[2] = bf_lo(n.y); nv[3] = bf_hi(n.y);
    return f + m0 * (pv - f) + m1 * (nv - f);
}
__device__ __forceinline__ float ftanh(float x) { return 1.0f - 2.0f * __builtin_amdgcn_rcpf(1.0f + __expf(2.0f * x)); }
__device__ __forceinline__ bf16x8 pack8(const float (&o)[8]) { v4u w; w.x = cvt_pk_bf16(o[0], o[1]); w.y = cvt_pk_bf16(o[2], o[3]); w.z = cvt_pk_bf16(o[4], o[5]); w.w = cvt_pk_bf16(o[6], o[7]); return __builtin_bit_cast(bf16x8, w); }
__device__ __forceinline__ float logsigmoid(float z) { const float e = __expf(-fabsf(z)); return fminf(z, 0.f) - __logf(1.0f + e); }

__device__ __forceinline__ void phase_pre(ArgsRef a, unsigned char* ws, int l, int gw, int NGW, int lane) {
    const bf16* F = (const bf16*)(ws + WS_F);
    const float* mix = a.in[16] + (size_t)l * 2 * 1920;
    const float* w0 = a.in[17] + l * 1024; const float* a0 = a.in[19] + l * 1024;
    const float* kkw = a.in[22] + l * 512; const float* kaw = a.in[23] + l * 512; const float* rkw = a.in[24] + l * 512;
    const bf16* W2T = (const bf16*)(ws + WS_W2T) + (size_t)l * 2 * 512 * 64; const bf16* A2T = (const bf16*)(ws + WS_A2T) + (size_t)l * 2 * 512 * 64;
    const bf16* G2T = (const bf16*)(ws + WS_G2T) + (size_t)l * 512 * 128;
    float* SI = (float*)(ws + WS_SI); float* Gb = (float*)(ws + WS_G); float* BON = (float*)(ws + WS_BON);
    for (int u = 4096 + gw; u < 4096 + 8192; u += NGW) {
        int q = lane & 15, g = lane >> 4; asm volatile("" : "+v"(q), "+v"(g));
        if (u < 4096) {
            const int tile = u >> 3, hh = u & 7, row = tile * 16 + q;
            const int T = row < NCTX ? 256 : 1024, pos = row & (T - 1); const bool hp = pos > 0, hn = pos < T - 1;
            const unsigned fo = (unsigned)row * NINP + C_RW;
            float t8[8]; f32x4 af[4], ab[4];
            const unsigned ao = (unsigned)(hh * 64 + q) * 64 + 8 * g, go = (unsigned)(hh * 64 + q) * 128 + 8 * g;
            const unsigned c40 = hh * 64 + 4 * g;
            const unsigned so = ((unsigned)hh * MT + row) * 384 + 4 * g;
#pragma unroll
            for (int d = 0; d < 2; ++d) { f32x4 acc[4];
#pragma unroll
                for (int rb = 0; rb < 4; ++rb) acc[rb] = (f32x4){0.f, 0.f, 0.f, 0.f};
#pragma unroll
                for (int ks = 0; ks < 2; ++ks) { const unsigned cb = 32 * ks + 8 * g; shift8(F, fo + 1536 + 64 * d + cb, hp, hn, mix, 1536 + 64 * d + cb, t8);
#pragma unroll
                    for (int e = 0; e < 8; ++e) t8[e] = ftanh(t8[e]);
                    const bf16x8 bop = pack8(t8);
#pragma unroll
                    for (int rb = 0; rb < 4; ++rb) acc[rb] = mfma16(*(const bf16x8*)(W2T + (ao + 32768 * d + 1024 * rb + 32 * ks)), bop, acc[rb]); }
#pragma unroll
                for (int rb = 0; rb < 4; ++rb) { const f32x4 wz = *(const f32x4*)(w0 + (512 * d + c40 + 16 * rb)); f32x4 dec;
#pragma unroll
                    for (int e = 0; e < 4; ++e) dec[e] = __expf(-__expf(logsigmoid(wz[e] + acc[rb][e]) - 0.5f));
                    *(f32x4*)(SI + (so + 8u * MT * 384u * d + 16 * rb + 64)) = dec; }
                asm volatile("" ::: "memory"); }
#pragma unroll
            for (int d = 0; d < 2; ++d) { f32x4 acc[4];
#pragma unroll
                for (int rb = 0; rb < 4; ++rb) acc[rb] = (f32x4){0.f, 0.f, 0.f, 0.f};
#pragma unroll
                for (int ks = 0; ks < 2; ++ks) { const unsigned cb = 32 * ks + 8 * g; shift8(F, fo + 1664 + 64 * d + cb, hp, hn, mix, 1664 + 64 * d + cb, t8);
                    const bf16x8 bop = pack8(t8);
#pragma unroll
                    for (int rb = 0; rb < 4; ++rb) acc[rb] = mfma16(*(const bf16x8*)(A2T + (ao + 32768 * d + 1024 * rb + 32 * ks)), bop, acc[rb]); }
#pragma unroll
                for (int rb = 0; rb < 4; ++rb) { const f32x4 az = *(const f32x4*)(a0 + (512 * d + c40 + 16 * rb));
#pragma unroll
                    for (int e = 0; e < 4; ++e) { const float v = sigm(az[e] + acc[rb][e]); if (d == 0) af[rb][e] = v; else ab[rb][e] = v; } }
                asm volatile("" ::: "memory"); }
            { f32x4 acc[4];
#pragma unroll
                for (int rb = 0; rb < 4; ++rb) acc[rb] = (f32x4){0.f, 0.f, 0.f, 0.f};
#pragma unroll
                for (int ks = 0; ks < 4; ++ks) { const unsigned cb = 32 * ks + 8 * g; shift8(F, fo + 1792 + cb, hp, hn, mix, 1792 + cb, t8);
#pragma unroll
                    for (int e = 0; e < 8; ++e) t8[e] = sigm(t8[e]);
                    const bf16x8 bop = pack8(t8);
#pragma unroll
                    for (int rb = 0; rb < 4; ++rb) acc[rb] = mfma16(*(const bf16x8*)(G2T + (go + 2048 * rb + 32 * ks)), bop, acc[rb]); }
#pragma unroll
                for (int rb = 0; rb < 4; ++rb) *(f32x4*)(Gb + ((unsigned)row * 512 + c40 + 16 * rb)) = acc[rb];
                asm volatile("" ::: "memory"); }
            float ss = 0.f;
#pragma unroll
            for (int rb = 0; rb < 4; ++rb) { const unsigned c4 = c40 + 16 * rb;
                const f32x4 kv = shift4(F, fo + 512 + c4, hp, hn, mix, 512 + c4) * *(const f32x4*)(kkw + c4); ss += (kv[0] * kv[0] + kv[1] * kv[1]) + (kv[2] * kv[2] + kv[3] * kv[3]); }
            ss = xrow16_sum(ss);
            const float kinv = __builtin_amdgcn_rcpf(fmaxf(__builtin_amdgcn_sqrtf(ss), 1e-12f));
            float bonus = 0.f;
            asm volatile("" ::: "memory");
#pragma unroll
            for (int rb = 0; rb < 4; ++rb) { const unsigned c4 = c40 + 16 * rb;
                const f32x4 rr = shift4(F, fo + c4, hp, hn, mix, c4), kh = shift4(F, fo + 512 + c4, hp, hn, mix, 512 + c4), vv = shift4(F, fo + 1024 + c4, hp, hn, mix, 1024 + c4);
                const f32x4 kkv = kh * *(const f32x4*)(kkw + c4);
                const f32x4 kav = *(const f32x4*)(kaw + c4), rkv = *(const f32x4*)(rkw + c4);
                f32x4 kdf, kdb, bf, bb, nkk;
#pragma unroll
                for (int e = 0; e < 4; ++e) {
                    kdf[e] = kh[e] * (1.0f + (af[rb][e] - 1.0f) * kav[e]); kdb[e] = kh[e] * (1.0f + (ab[rb][e] - 1.0f) * kav[e]);
                    const float kn = kkv[e] * kinv; nkk[e] = -kn; bf[e] = kn * af[rb][e]; bb[e] = kn * ab[rb][e];
                    bonus += rr[e] * rkv[e] * (kdf[e] + kdb[e]); }
                const unsigned s0 = so + 16 * rb, s1 = s0 + 8u * MT * 384u;
                *(f32x4*)(SI + s0) = rr; *(f32x4*)(SI + (s0 + 128)) = kdf; *(f32x4*)(SI + (s0 + 192)) = vv; *(f32x4*)(SI + (s0 + 256)) = nkk; *(f32x4*)(SI + (s0 + 320)) = bf;
                *(f32x4*)(SI + s1) = rr; *(f32x4*)(SI + (s1 + 128)) = kdb; *(f32x4*)(SI + (s1 + 192)) = vv; *(f32x4*)(SI + (s1 + 256)) = nkk; *(f32x4*)(SI + (s1 + 320)) = bb;
                asm volatile("" ::: "memory"); }
            bonus = xrow16_sum(bonus);
            if (g == 0) BON[(size_t)row * 8 + hh] = bonus;
        } else {
            const int v = u - 4096, lr = v >> 1, isk = v & 1;
            const bf16* src = F + (size_t)(NCTX + lr) * NINP + (isk ? C_DFK : C_DFQ) + 8 * lane;
            const v4u x = *(const v4u*)src; v4u xp; xp.x = __shfl_xor(x.x, 2); xp.y = __shfl_xor(x.y, 2); xp.z = __shfl_xor(x.z, 2); xp.w = __shfl_xor(x.w, 2);
            const int seg = lane & 7, tpos = lr & 1023, pos = seg < 4 ? (tpos >> 6) : (tpos & 63); const bool second = (seg & 2) != 0;
            const float* rp = (const float*)(ws + WS_ROPE) + ((size_t)pos * 16 + 8 * (seg & 1)) * 2;
            float o[8];
#pragma unroll
            for (int w = 0; w < 4; ++w) { const unsigned xw = x[w], pw = xp[w];
                const float c0 = rp[4 * w], s0 = rp[4 * w + 1], c1 = rp[4 * w + 2], s1 = rp[4 * w + 3];
                o[2 * w] = second ? bf_lo(xw) * c0 + bf_lo(pw) * s0 : bf_lo(xw) * c0 - bf_lo(pw) * s0;
                o[2 * w + 1] = second ? bf_hi(xw) * c1 + bf_hi(pw) * s1 : bf_hi(xw) * c1 - bf_hi(pw) * s1; }
            v4u ow; ow.x = cvt_pk_bf16(o[0], o[1]); ow.y = cvt_pk_bf16(o[2], o[3]); ow.z = cvt_pk_bf16(o[4], o[5]); ow.w = cvt_pk_bf16(o[6], o[7]);
            *(v4u*)((bf16*)(ws + (isk ? WS_KR : WS_QR)) + (size_t)lr * 512 + 8 * lane) = ow;
        }
    }
}

__device__ __forceinline__ void phase_rope(unsigned char* ws, int gw, int NGW, int lane) {
    const bf16* F = (const bf16*)(ws + WS_F); const float* ropet = (const float*)(ws + WS_ROPE);
    const int seg = lane & 7; const bool second = (seg & 2) != 0;
    for (int u0 = gw; u0 < 8192; u0 += 4 * NGW) {
        v4u x[4]; f32x4 t[4][4];
#pragma unroll
        for (int i = 0; i < 4; ++i) { const int v = u0 + i * NGW; if (v < 8192) { const int lr = v >> 1, isk = v & 1, tpos = lr & 1023, pos = seg < 4 ? (tpos >> 6) : (tpos & 63);
                x[i] = *(const v4u*)(F + (size_t)(NCTX + lr) * NINP + (isk ? C_DFK : C_DFQ) + 8 * lane);
                const float* rp = ropet + ((size_t)pos * 16 + 8 * (seg & 1)) * 2;
#pragma unroll
                for (int w = 0; w < 4; ++w) t[i][w] = *(const f32x4*)(rp + 4 * w); } }
#pragma unroll
        for (int i = 0; i < 4; ++i) { const int v = u0 + i * NGW; if (v < 8192) { const int lr = v >> 1, isk = v & 1;
                v4u xp; xp.x = __shfl_xor(x[i].x, 2); xp.y = __shfl_xor(x[i].y, 2); xp.z = __shfl_xor(x[i].z, 2); xp.w = __shfl_xor(x[i].w, 2);
                v4u ow;
#pragma unroll
                for (int w = 0; w < 4; ++w) { const unsigned xw = x[i][w], pw = xp[w]; const f32x4 cs = t[i][w];
                    const float o0 = second ? bf_lo(xw) * cs[0] + bf_lo(pw) * cs[1] : bf_lo(xw) * cs[0] - bf_lo(pw) * cs[1];
                    const float o1 = second ? bf_hi(xw) * cs[2] + bf_hi(pw) * cs[3] : bf_hi(xw) * cs[2] - bf_hi(pw) * cs[3];
                    ow[w] = cvt_pk_bf16(o0, o1); }
                *(v4u*)((bf16*)(ws + (isk ? WS_KR : WS_QR)) + (size_t)lr * 512 + 8 * lane) = ow; } }
    }
}

constexpr size_t WS_OPS = 1157 * MiB; constexpr int OPS_BLOCK = 21 * 512, N_CHUNKS = 8192;
#define IMO(i) ((((i) >> 1) * 1024) + (((i) & 1) * 8))
typedef _Float16 h16x4 __attribute__((ext_vector_type(4)));
__device__ __forceinline__ f32x4 mfma16k(v2u a, v2u b, f32x4 c) { return __builtin_amdgcn_mfma_f32_16x16x16f16(__builtin_bit_cast(h16x4, a), __builtin_bit_cast(h16x4, b), c, 0, 0, 0); }
__device__ __forceinline__ v2u pk4(f32x4 v) { v2u r; r.x = cvt_pk_bf16(v[0], v[1]); r.y = cvt_pk_bf16(v[2], v[3]); return r; }
__device__ __forceinline__ unsigned short h1(float v) { return __builtin_bit_cast(unsigned short, (_Float16)v); }
struct ChunkId { int dh, T, tokbase, c; };
__device__ __forceinline__ ChunkId chunk_decode(int cu) { ChunkId k; k.dh = cu >> 9; const int cid = cu & 511;
    if (cid < 256) { k.T = 256; k.tokbase = (cid >> 4) * 256; k.c = cid & 15; } else { k.T = 1024; k.tokbase = NCTX + ((cid - 256) >> 6) * 1024; k.c = (cid - 256) & 63; } return k; }
constexpr size_t WS_V = WS_SI;
constexpr int FT_PITCH = 3856, MX_OFF = 18 * FT_PITCH, BO_OFF = MX_OFF + 2 * 1920 * 4, PRE_LDS = BO_OFF + 12 * 1024;
static_assert(MX_OFF % 16 == 0 && PRE_LDS <= RING_BYTES, "pre-pass LDS map");
__device__ __forceinline__ void shift8_lds(const LAS unsigned char* ft  , const LAS float* mx  , float (&o)[8]) {
    const v4u c = *(const LAS v4u*)ft, p = *(const LAS v4u*)(ft - FT_PITCH), n = *(const LAS v4u*)(ft + FT_PITCH);
    const f32x4 m0a = *(const LAS f32x4*)mx, m0b = *(const LAS f32x4*)(mx + 4), m1a = *(const LAS f32x4*)(mx + 1920), m1b = *(const LAS f32x4*)(mx + 1924);
#pragma unroll
    for (int w = 0; w < 4; ++w) { const unsigned cw = c[w], pw = p[w], nw = n[w];
        const float f0 = bf_lo(cw), f1 = bf_hi(cw); const float m00 = w < 2 ? m0a[2 * w] : m0b[2 * w - 4], m01 = w < 2 ? m0a[2 * w + 1] : m0b[2 * w - 3];
        const float m10 = w < 2 ? m1a[2 * w] : m1b[2 * w - 4], m11 = w < 2 ? m1a[2 * w + 1] : m1b[2 * w - 3];
        o[2 * w] = f0 + m00 * (bf_lo(pw) - f0) + m10 * (bf_lo(nw) - f0); o[2 * w + 1] = f1 + m01 * (bf_hi(pw) - f1) + m11 * (bf_hi(nw) - f1); }
}
__device__ __forceinline__ f32x4 shift4_lds(const LAS unsigned char* ft, const LAS float* mx) {
    const v2u c = *(const LAS v2u*)ft, p = *(const LAS v2u*)(ft - FT_PITCH), n = *(const LAS v2u*)(ft + FT_PITCH);
    const f32x4 m0 = *(const LAS f32x4*)mx, m1 = *(const LAS f32x4*)(mx + 1920);
    f32x4 f, pv, nv; f[0] = bf_lo(c.x); f[1] = bf_hi(c.x); f[2] = bf_lo(c.y); f[3] = bf_hi(c.y);
    pv[0] = bf_lo(p.x); pv[1] = bf_hi(p.x); pv[2] = bf_lo(p.y); pv[3] = bf_hi(p.y); nv[0] = bf_lo(n.x); nv[1] = bf_hi(n.x); nv[2] = bf_lo(n.y); nv[3] = bf_hi(n.y);
    return f + m0 * (pv - f) + m1 * (nv - f);
}
__device__ __forceinline__ void pre_tile(ArgsRef a, unsigned char* ws, int l, int tile, LAS unsigned char* lds, int tid) {
    const bf16* F = (const bf16*)(ws + WS_F);
    const float* mix = a.in[16] + (size_t)l * 2 * 1920;
    const float* w0 = a.in[17] + l * 1024; const float* a0 = a.in[19] + l * 1024;
    const float* kkw = a.in[22] + l * 512; const float* kaw = a.in[23] + l * 512; const float* rkw = a.in[24] + l * 512;
    const bf16* W2T = (const bf16*)(ws + WS_W2T) + (size_t)l * 2 * 512 * 64; const bf16* A2T = (const bf16*)(ws + WS_A2T) + (size_t)l * 2 * 512 * 64;
    const bf16* G2T = (const bf16*)(ws + WS_G2T) + (size_t)l * 512 * 128;
    float* SI = (float*)(ws + WS_SI); float* Gb = (float*)(ws + WS_G); float* BON = (float*)(ws + WS_BON);
    const int hh = __builtin_amdgcn_readfirstlane(tid >> 6), lane = tid & 63;
    int q = lane & 15, g = lane >> 4; asm volatile("" : "+v"(q), "+v"(g));
    const int tok0 = tile * 16, T = tok0 < NCTX ? 256 : 1024, pos0 = tok0 & (T - 1);
    for (int i = tid; i < 18 * 240; i += 512) { const int r = i / 240, c = i - r * 240, pos = pos0 + r - 1;
        v4u v = {0u, 0u, 0u, 0u}; if (pos >= 0 && pos < T) v = *(const v4u*)(F + (size_t)(tok0 + r - 1) * NINP + C_RW + c * 8);
        *(LAS v4u*)(lds + r * FT_PITCH + c * 16) = v; }
    for (int i = tid; i < 960; i += 512) *(LAS f32x4*)(lds + MX_OFF + 16 * i) = *(const f32x4*)(mix + 4 * i);
    __syncthreads();
    const LAS unsigned char* ftq = lds + (q + 1) * FT_PITCH; const LAS float* mx = (const LAS float*)(lds + MX_OFF);
    float t8[8];
    for (int op = hh; op < 12; op += 8) {
        const int chb = op < 2 ? 1536 : (op < 4 ? 1600 : (op < 6 ? 1664 : (op < 8 ? 1728 : 1792))), ks = op < 8 ? (op & 1) : (op - 8), ch = chb + 32 * ks + 8 * g;
        shift8_lds(ftq + ch * 2, mx + ch, t8);
        if (op < 4) {
#pragma unroll
            for (int e = 0; e < 8; ++e) t8[e] = ftanh(t8[e]); }
        else if (op >= 8) {
#pragma unroll
            for (int e = 0; e < 8; ++e) t8[e] = sigm(t8[e]); }
        *(LAS bf16x8*)(lds + BO_OFF + op * 1024 + lane * 16) = pack8(t8);
    }
    __syncthreads();
    const LAS unsigned char* bo = lds + BO_OFF + lane * 16;
    const int row = tok0 + q;
    const unsigned ao = (unsigned)(hh * 64 + q) * 64 + 8 * g, go = (unsigned)(hh * 64 + q) * 128 + 8 * g;
    const unsigned c40 = hh * 64 + 4 * g;
    { f32x4 acc[4];
#pragma unroll
        for (int rb = 0; rb < 4; ++rb) acc[rb] = (f32x4){0.f, 0.f, 0.f, 0.f};
#pragma unroll
        for (int ks = 0; ks < 4; ++ks) { const bf16x8 bop = *(const LAS bf16x8*)(bo + (8 + ks) * 1024);
#pragma unroll
            for (int rb = 0; rb < 4; ++rb) acc[rb] = mfma16(*(const bf16x8*)(G2T + (go + 2048 * rb + 32 * ks)), bop, acc[rb]); }
#pragma unroll
        for (int rb = 0; rb < 4; ++rb) *(v2u*)((bf16*)Gb + ((unsigned)row * 512 + c40 + 16 * rb)) = pk4(acc[rb]);
        asm volatile("" ::: "memory"); }
    float ss = 0.f;
#pragma unroll
    for (int rb = 0; rb < 4; ++rb) { const unsigned c4 = c40 + 16 * rb;
        const f32x4 kv = shift4_lds(ftq + (512 + c4) * 2, mx + 512 + c4) * *(const f32x4*)(kkw + c4); ss += (kv[0] * kv[0] + kv[1] * kv[1]) + (kv[2] * kv[2] + kv[3] * kv[3]); }
    ss = xrow16_sum(ss);
    const float kinv = __builtin_amdgcn_rcpf(fmaxf(__builtin_amdgcn_sqrtf(ss), 1e-12f));
    float bonus = 0.f;
    const int tq = tile < 256 ? (tile & 15) : ((tile - 256) & 63), nct = tile < 256 ? 16 : 64, sb = tile < 256 ? (tile >> 4) : ((tile - 256) >> 6);
    const int cid_f = (tile < 256 ? sb * 16 : 256 + sb * 64) + tq, cid_b = (tile < 256 ? sb * 16 : 256 + sb * 64) + (nct - 1 - tq);
    const f32x4 z4 = {0.f, 0.f, 0.f, 0.f};
    v2u idop; { f32x4 idv;
#pragma unroll
        for (int e = 0; e < 4; ++e) idv[e] = (4 * g + e == q) ? 1.f : 0.f; idop = pk4(idv); }
#pragma unroll
    for (int d = 0; d < 2; ++d) {
        f32x4 cBe = z4, cBt = z4, cKa = z4, cRb = z4, cRk = z4;
        f32x4 decd[4], asd[4];
        { f32x4 acc[4];
#pragma unroll
          for (int rb = 0; rb < 4; ++rb) acc[rb] = z4;
#pragma unroll
          for (int ks = 0; ks < 2; ++ks) { const bf16x8 bop = *(const LAS bf16x8*)(bo + (2 * d + ks) * 1024);
#pragma unroll
              for (int rb = 0; rb < 4; ++rb) acc[rb] = mfma16(*(const bf16x8*)(W2T + (ao + 32768 * d + 1024 * rb + 32 * ks)), bop, acc[rb]); }
#pragma unroll
          for (int rb = 0; rb < 4; ++rb) { const f32x4 wz = *(const f32x4*)(w0 + (512 * d + c40 + 16 * rb));
#pragma unroll
              for (int e = 0; e < 4; ++e) decd[rb][e] = __expf(-__expf(logsigmoid(wz[e] + acc[rb][e]) - 0.5f)); }
          asm volatile("" ::: "memory");
#pragma unroll
          for (int rb = 0; rb < 4; ++rb) acc[rb] = z4;
#pragma unroll
          for (int ks = 0; ks < 2; ++ks) { const bf16x8 bop = *(const LAS bf16x8*)(bo + (4 + 2 * d + ks) * 1024);
#pragma unroll
              for (int rb = 0; rb < 4; ++rb) acc[rb] = mfma16(*(const bf16x8*)(A2T + (ao + 32768 * d + 1024 * rb + 32 * ks)), bop, acc[rb]); }
#pragma unroll
          for (int rb = 0; rb < 4; ++rb) { const f32x4 az = *(const f32x4*)(a0 + (512 * d + c40 + 16 * rb));
#pragma unroll
              for (int e = 0; e < 4; ++e) asd[rb][e] = sigm(az[e] + acc[rb][e]); }
          asm volatile("" ::: "memory"); }
        unsigned oo = (unsigned)((d * 8 + hh) * 512 + (d == 0 ? cid_f : cid_b)) * OPS_BLOCK + lane * 16;
        unsigned char* ops = ws + WS_OPS + oo;
#pragma unroll
        for (int rb = 0; rb < 4; ++rb) { const unsigned c4 = c40 + 16 * rb;
            const f32x4 rr = shift4_lds(ftq + c4 * 2, mx + c4), kh = shift4_lds(ftq + (512 + c4) * 2, mx + 512 + c4);
            const f32x4 kkv = kh * *(const f32x4*)(kkw + c4), kav = *(const f32x4*)(kaw + c4);
            const f32x4 as = asd[rb], wv = decd[rb];
            f32x4 kd, bv, nkk;
#pragma unroll
            for (int e = 0; e < 4; ++e) { kd[e] = kh[e] * (1.0f + (as[e] - 1.0f) * kav[e]); const float kn = kkv[e] * kinv; nkk[e] = -kn; bv[e] = kn * as[e]; }
            { const f32x4 rkv = *(const f32x4*)(rkw + c4);
#pragma unroll
              for (int e = 0; e < 4; ++e) bonus += rr[e] * rkv[e] * kd[e]; }
            if (d == 0) *(v2u*)((bf16*)(ws + WS_V) + ((unsigned)row * 512 + c4)) = pk4(shift4_lds(ftq + (1024 + c4) * 2, mx + 1024 + c4));
            f32x4 gi, gx, gc;
#pragma unroll
            for (int e = 0; e < 4; ++e) { float x = wv[e];
                if (d == 0) { x *= dppf<0x111>(x); x *= dppf<0x112>(x); x *= dppf<0x114>(x); x *= dppf<0x118>(x); gx[e] = dppf<0x111>(x); }
                else        { x *= dppf<0x101>(x); x *= dppf<0x102>(x); x *= dppf<0x104>(x); x *= dppf<0x108>(x); gx[e] = dppf<0x101>(x); }
                gi[e] = x; gc[e] = __shfl(x, (lane & 48) | (d == 0 ? 15 : 0)); }
            f32x4 ginv;
#pragma unroll
            for (int e = 0; e < 4; ++e) ginv[e] = __builtin_amdgcn_rcpf(gi[e]);
            const v2u aop = pk4(gx * nkk), rop = pk4(gi * rr), bop = pk4(bv * ginv), kop = pk4(kd * ginv), btop = pk4(bv * ginv * gc), ktop = pk4(kd * ginv * gc);
            { const v2u bt_ = pk4(mfma16k(btop, idop, z4)), kt_ = pk4(mfma16k(ktop, idop, z4));
              *(v4u*)(ops + rb * 1024) = (v4u){aop.x, aop.y, rop.x, rop.y}; *(v4u*)(ops + (4 + rb) * 1024) = (v4u){bt_.x, bt_.y, kt_.x, kt_.y}; }
            if (q == (d == 0 ? 15 : 0)) *(f32x4*)(ops - lane * 16 + 20 * 512 + (16 * rb + 4 * g) * 4) = gi;
            cBe = mfma16k(bop, aop, cBe); cBt = mfma16k(aop, bop, cBt); cKa = mfma16k(kop, aop, cKa); cRb = mfma16k(bop, rop, cRb); cRk = mfma16k(kop, rop, cRk);
            asm volatile("" ::: "memory"); }
        f32x4 Beta = cBe, BetaT = cBt, Kap = cKa, Rb = cRb, Rk = cRk, Id;
#pragma unroll
        for (int e = 0; e < 4; ++e) { const int rw = 4 * g + e;
            const bool jt = d == 0 ? rw < q : rw > q, tj = d == 0 ? q < rw : q > rw, je = d == 0 ? rw <= q : rw >= q;
            if (!jt) { Beta[e] = 0.f; Kap[e] = 0.f; } if (!tj) BetaT[e] = 0.f; if (!je) { Rb[e] = 0.f; Rk[e] = 0.f; }
            Id[e] = rw == q ? 1.f : 0.f; }
        const v2u kap_ = pk4(Kap), rb_ = pk4(Rb), rk_ = pk4(Rk);
        const f32x4 B2 = mfma16k(pk4(BetaT), pk4(Beta), z4), B2T = mfma16k(pk4(Beta), pk4(BetaT), z4);
        const f32x4 B4 = mfma16k(pk4(B2T), pk4(B2), z4), B4T = mfma16k(pk4(B2), pk4(B2T), z4);
        const f32x4 B8 = mfma16k(pk4(B4T), pk4(B4), z4);
        const f32x4 T1 = mfma16k(pk4(Id + BetaT), pk4(Id + B2), z4), T1T = mfma16k(pk4(Id + B2), pk4(Id + BetaT), z4);
        const f32x4 T2 = mfma16k(pk4(Id + B4T), pk4(Id + B8), z4);
        { const v2u tt_ = pk4(mfma16k(pk4(T1T), pk4(T2), z4)); *(v4u*)(ops + 8 * 1024) = (v4u){kap_.x, kap_.y, tt_.x, tt_.y}; *(v4u*)(ops + 9 * 1024) = (v4u){rb_.x, rb_.y, rk_.x, rk_.y}; }
        asm volatile("" ::: "memory"); }
    bonus = xrow16_sum(bonus);
    if (g == 0) BON[(size_t)row * 8 + hh] = bonus;
    __syncthreads();
}

__device__ __forceinline__ void phase_post(ArgsRef a, unsigned char* ws, int l, int gw, int NGW, int lane) {
    const bf16* Y = (const bf16*)(ws + WS_Y); const bf16* Gb = (const bf16*)(ws + WS_G); const bf16* Vb = (const bf16*)(ws + WS_V); const float* BON = (const float*)(ws + WS_BON);
    bf16* O3 = (bf16*)(ws + WS_O3) + 1024;
    const float* lng = a.in[25] + l * 512; const float* lnb = a.in[26] + l * 512;
    const int c = 8 * lane, hh = lane >> 3;
    for (int row0 = gw; row0 < MT; row0 += 4 * NGW) {
        v4u yfw[4], ybw[4], vw[4], gw4[4]; float bon[4];
#pragma unroll
        for (int i = 0; i < 4; ++i) { const int row = row0 + i * NGW; if (row < MT) {
            yfw[i] = *(const v4u*)(Y + (size_t)row * 512 + c); ybw[i] = *(const v4u*)(Y + (size_t)(MT + row) * 512 + c);
            vw[i] = *(const v4u*)(Vb + (size_t)row * 512 + c); gw4[i] = *(const v4u*)(Gb + (size_t)row * 512 + c); bon[i] = BON[(size_t)row * 8 + hh]; } }
#pragma unroll
        for (int i = 0; i < 4; ++i) { const int row = row0 + i * NGW; if (row < MT) {
            f32x4 y0 = {bf_lo(yfw[i].x) + bf_lo(ybw[i].x), bf_hi(yfw[i].x) + bf_hi(ybw[i].x), bf_lo(yfw[i].y) + bf_lo(ybw[i].y), bf_hi(yfw[i].y) + bf_hi(ybw[i].y)};
            f32x4 y1 = {bf_lo(yfw[i].z) + bf_lo(ybw[i].z), bf_hi(yfw[i].z) + bf_hi(ybw[i].z), bf_lo(yfw[i].w) + bf_lo(ybw[i].w), bf_hi(yfw[i].w) + bf_hi(ybw[i].w)};
            float s = (y0[0] + y0[1]) + (y0[2] + y0[3]) + (y1[0] + y1[1]) + (y1[2] + y1[3]); s = red8(s);
            const float mu = s * (1.f / 64.f); y0 = y0 - mu; y1 = y1 - mu;
            float s2 = (y0[0] * y0[0] + y0[1] * y0[1]) + (y0[2] * y0[2] + y0[3] * y0[3]) + (y1[0] * y1[0] + y1[1] * y1[1]) + (y1[2] * y1[2] + y1[3] * y1[3]); s2 = red8(s2);
            const float rstd = __builtin_amdgcn_rsqf(s2 * (1.f / 64.f) + 64e-5f);
            const f32x4 v0 = {bf_lo(vw[i].x), bf_hi(vw[i].x), bf_lo(vw[i].y), bf_hi(vw[i].y)}, v1 = {bf_lo(vw[i].z), bf_hi(vw[i].z), bf_lo(vw[i].w), bf_hi(vw[i].w)};
            const f32x4 g0 = {bf_lo(gw4[i].x), bf_hi(gw4[i].x), bf_lo(gw4[i].y), bf_hi(gw4[i].y)}, g1 = {bf_lo(gw4[i].z), bf_hi(gw4[i].z), bf_lo(gw4[i].w), bf_hi(gw4[i].w)};
            const f32x4 o0 = (y0 * rstd * *(const f32x4*)(lng + c) + *(const f32x4*)(lnb + c) + v0 * bon[i]) * g0;
            const f32x4 o1 = (y1 * rstd * *(const f32x4*)(lng + c + 4) + *(const f32x4*)(lnb + c + 4) + v1 * bon[i]) * g1;
            v4u w; w.x = cvt_pk_bf16(o0[0], o0[1]); w.y = cvt_pk_bf16(o0[2], o0[3]); w.z = cvt_pk_bf16(o1[0], o1[1]); w.w = cvt_pk_bf16(o1[2], o1[3]);
            *(v4u*)(O3 + (size_t)row * 1536 + c) = w; } }
    }
}

__device__ __forceinline__ void scan_unit(ArgsRef a, unsigned char* ws, int l, bool lat, int b, int head, int dir, int half, LAS unsigned char* lds, int tid) {
    const int T = lat ? 1024 : 256, tokbase = lat ? NCTX + b * 1024 : b * 256, nch = T / 32;
    const bool active = !lat || tid < 256;
    const int row = (lat ? 32 * half : 0) + ((lat ? (tid & 255) : tid) >> 3), kseg = tid & 7;
    const float* si = (const float*)(ws + WS_SI) + ((size_t)(dir * 8 + head) * MT + tokbase) * 384;
    float* Yo = (float*)(ws + WS_Y) + ((size_t)dir * MT + tokbase) * 512 + head * 64;
    pg8::f32x2 S2[4];
    if (lat) { const float* sp = a.in[dir == 0 ? 6 : 7] + ((size_t)(b * 4 + l) * 8 + head) * 4096 + row * 64 + 8 * kseg;
        const f32x4 s0 = *(const f32x4*)sp, s1 = *(const f32x4*)(sp + 4); S2[0] = (pg8::f32x2){s0[0], s0[1]}; S2[1] = (pg8::f32x2){s0[2], s0[3]}; S2[2] = (pg8::f32x2){s1[0], s1[1]}; S2[3] = (pg8::f32x2){s1[2], s1[3]}; }
    else {
#pragma unroll
        for (int i = 0; i < 4; ++i) S2[i] = (pg8::f32x2){0.f, 0.f}; }
    LAS float* buf0 = (LAS float*)lds; LAS float* ybuf0 = (LAS float*)(lds + 98304);
    f32x4 pre[6];
    { const int tok0 = dir == 0 ? 0 : T - 32; const f32x4* s4 = (const f32x4*)(si + (size_t)tok0 * 384);
#pragma unroll
      for (int j = 0; j < 6; ++j) pre[j] = s4[tid + 512 * j]; }
    for (int c = 0; c < nch; ++c) {
        LAS float* buf = buf0 + (c & 1) * 12288; LAS float* yb = ybuf0 + (c & 1) * 2048;
#pragma unroll
        for (int j = 0; j < 6; ++j) *(LAS f32x4*)(buf + 4 * (tid + 512 * j)) = pre[j];
        __syncthreads();
        if (c > 0) { const int tp = dir == 0 ? 32 * (c - 1) : T - 32 * c; LAS float* ybp = ybuf0 + ((c - 1) & 1) * 2048;
            if (!lat) *(f32x4*)(Yo + (size_t)(tp + (tid >> 4)) * 512 + 4 * (tid & 15)) = *(LAS f32x4*)(ybp + 4 * tid);
            else if (tid < 256) *(f32x4*)(Yo + (size_t)(tp + (tid >> 3)) * 512 + 32 * half + 4 * (tid & 7)) = *(LAS f32x4*)(ybp + (tid >> 3) * 64 + 32 * half + 4 * (tid & 7)); }
        if (c + 1 < nch) { const int tok0 = dir == 0 ? 32 * (c + 1) : T - 32 * (c + 2); const f32x4* s4 = (const f32x4*)(si + (size_t)tok0 * 384);
#pragma unroll
            for (int j = 0; j < 6; ++j) pre[j] = s4[tid + 512 * j]; }
        if (active)
#pragma unroll 2
        for (int s = 0; s < 32; ++s) {
            const int ti = dir == 0 ? s : 31 - s; const LAS float* rec = buf + ti * 384 + 8 * kseg;
            typedef pg8::f32x2 f2;
            const f32x4 a0 = *(const LAS f32x4*)(rec + 256), a1 = *(const LAS f32x4*)(rec + 260);
            const f32x4 w0 = *(const LAS f32x4*)(rec + 64), w1 = *(const LAS f32x4*)(rec + 68), b0 = *(const LAS f32x4*)(rec + 320), b1 = *(const LAS f32x4*)(rec + 324);
            const f32x4 k0 = *(const LAS f32x4*)(rec + 128), k1 = *(const LAS f32x4*)(rec + 132), r0 = *(const LAS f32x4*)(rec), r1 = *(const LAS f32x4*)(rec + 4);
            const float vv = buf[ti * 384 + 192 + row];
            f2 t = S2[0] * (f2){a0[0], a0[1]}; t = S2[1] * (f2){a0[2], a0[3]} + t; t = S2[2] * (f2){a1[0], a1[1]} + t; t = S2[3] * (f2){a1[2], a1[3]} + t;
            const float sa = red8(t.x + t.y);
            const f2 sa2 = {sa, sa}, vv2 = {vv, vv};
            S2[0] = S2[0] * (f2){w0[0], w0[1]} + sa2 * (f2){b0[0], b0[1]} + vv2 * (f2){k0[0], k0[1]};
            S2[1] = S2[1] * (f2){w0[2], w0[3]} + sa2 * (f2){b0[2], b0[3]} + vv2 * (f2){k0[2], k0[3]};
            S2[2] = S2[2] * (f2){w1[0], w1[1]} + sa2 * (f2){b1[0], b1[1]} + vv2 * (f2){k1[0], k1[1]};
            S2[3] = S2[3] * (f2){w1[2], w1[3]} + sa2 * (f2){b1[2], b1[3]} + vv2 * (f2){k1[2], k1[3]};
            f2 u = S2[0] * (f2){r0[0], r0[1]}; u = S2[1] * (f2){r0[2], r0[3]} + u; u = S2[2] * (f2){r1[0], r1[1]} + u; u = S2[3] * (f2){r1[2], r1[3]} + u;
            const float y = red8(u.x + u.y);
            if (kseg == 0) yb[ti * 64 + row] = y;
        }
    }
    __syncthreads();
    { const int tp = dir == 0 ? 32 * (nch - 1) : 0; LAS float* ybp = ybuf0 + ((nch - 1) & 1) * 2048;
      if (!lat) *(f32x4*)(Yo + (size_t)(tp + (tid >> 4)) * 512 + 4 * (tid & 15)) = *(LAS f32x4*)(ybp + 4 * tid);
      else if (tid < 256) *(f32x4*)(Yo + (size_t)(tp + (tid >> 3)) * 512 + 32 * half + 4 * (tid & 7)) = *(LAS f32x4*)(ybp + (tid >> 3) * 64 + 32 * half + 4 * (tid & 7)); }
    if (!lat) { float* op = a.out + (dir == 0 ? OUT_RF : OUT_RB) + ((size_t)(b * 4 + l) * 8 + head) * 4096 + row * 64 + 8 * kseg;
        *(f32x4*)op = (f32x4){S2[0].x, S2[0].y, S2[1].x, S2[1].y}; *(f32x4*)(op + 4) = (f32x4){S2[2].x, S2[2].y, S2[3].x, S2[3].y}; }
    __syncthreads();
}

__device__ __forceinline__ void scan_pair_ctx(ArgsRef a, unsigned char* ws, int l, int b, int head, LAS unsigned char* lds, int tid) {
    typedef pg8::f32x2 f2;
    const int d = tid >> 8, gt = tid & 255, lr = gt >> 3, kseg = gt & 7, tokbase = b * 256;
    const float* si = (const float*)(ws + WS_SI) + ((size_t)(d * 8 + head) * MT + tokbase) * 384;
    float* Yo = (float*)(ws + WS_Y) + ((size_t)d * MT + tokbase) * 512 + head * 64;
    LAS float* buf0 = (LAS float*)(lds + d * 57344); LAS float* ybuf0 = (LAS float*)(lds + d * 57344 + 49152);
    f2 SA[4], SB[4];
#pragma unroll
    for (int i = 0; i < 4; ++i) { SA[i] = (f2){0.f, 0.f}; SB[i] = (f2){0.f, 0.f}; }
    f32x4 pre[6];
    { const int tok0 = d == 0 ? 0 : 256 - 16; const f32x4* s4 = (const f32x4*)(si + (size_t)tok0 * 384);
#pragma unroll
      for (int j = 0; j < 6; ++j) pre[j] = s4[gt + 256 * j]; }
    for (int c = 0; c < 16; ++c) {
        LAS float* buf = buf0 + (c & 1) * 6144; LAS float* yb = ybuf0 + (c & 1) * 1024;
#pragma unroll
        for (int j = 0; j < 6; ++j) *(LAS f32x4*)(buf + 4 * (gt + 256 * j)) = pre[j];
        __syncthreads();
        if (c > 0) { const int tp = d == 0 ? 16 * (c - 1) : 256 - 16 * c; LAS float* ybp = ybuf0 + ((c - 1) & 1) * 1024;
            *(f32x4*)(Yo + (size_t)(tp + (gt >> 4)) * 512 + 4 * (gt & 15)) = *(LAS f32x4*)(ybp + 4 * gt); }
        if (c + 1 < 16) { const int tok0 = d == 0 ? 16 * (c + 1) : 256 - 16 * (c + 2); const f32x4* s4 = (const f32x4*)(si + (size_t)tok0 * 384);
#pragma unroll
            for (int j = 0; j < 6; ++j) pre[j] = s4[gt + 256 * j]; }
#pragma unroll 2
        for (int s = 0; s < 16; ++s) {
            const int ti = d == 0 ? s : 15 - s; const LAS float* rec = buf + ti * 384 + 8 * kseg;
            const f32x4 a0 = *(const LAS f32x4*)(rec + 256), a1 = *(const LAS f32x4*)(rec + 260);
            const f32x4 w0 = *(const LAS f32x4*)(rec + 64), w1 = *(const LAS f32x4*)(rec + 68), b0 = *(const LAS f32x4*)(rec + 320), b1 = *(const LAS f32x4*)(rec + 324);
            const f32x4 k0 = *(const LAS f32x4*)(rec + 128), k1 = *(const LAS f32x4*)(rec + 132), r0 = *(const LAS f32x4*)(rec), r1 = *(const LAS f32x4*)(rec + 4);
            const f2 v2 = *(const LAS f2*)(buf + ti * 384 + 192 + 2 * lr);
            const f2 a01 = {a0[0], a0[1]}, a23 = {a0[2], a0[3]}, a45 = {a1[0], a1[1]}, a67 = {a1[2], a1[3]};
            f2 tA = SA[0] * a01; tA = SA[1] * a23 + tA; tA = SA[2] * a45 + tA; tA = SA[3] * a67 + tA;
            f2 tB = SB[0] * a01; tB = SB[1] * a23 + tB; tB = SB[2] * a45 + tB; tB = SB[3] * a67 + tB;
            const float saA = red8(tA.x + tA.y), saB = red8(tB.x + tB.y);
            const f2 sA2 = {saA, saA}, sB2 = {saB, saB}, vA2 = {v2.x, v2.x}, vB2 = {v2.y, v2.y};
            const f2 w01 = {w0[0], w0[1]}, w23 = {w0[2], w0[3]}, w45 = {w1[0], w1[1]}, w67 = {w1[2], w1[3]};
            const f2 b01 = {b0[0], b0[1]}, b23 = {b0[2], b0[3]}, b45 = {b1[0], b1[1]}, b67 = {b1[2], b1[3]};
            const f2 k01 = {k0[0], k0[1]}, k23 = {k0[2], k0[3]}, k45 = {k1[0], k1[1]}, k67 = {k1[2], k1[3]};
            SA[0] = SA[0] * w01 + sA2 * b01 + vA2 * k01; SA[1] = SA[1] * w23 + sA2 * b23 + vA2 * k23; SA[2] = SA[2] * w45 + sA2 * b45 + vA2 * k45; SA[3] = SA[3] * w67 + sA2 * b67 + vA2 * k67;
            SB[0] = SB[0] * w01 + sB2 * b01 + vB2 * k01; SB[1] = SB[1] * w23 + sB2 * b23 + vB2 * k23; SB[2] = SB[2] * w45 + sB2 * b45 + vB2 * k45; SB[3] = SB[3] * w67 + sB2 * b67 + vB2 * k67;
            const f2 r01 = {r0[0], r0[1]}, r23 = {r0[2], r0[3]}, r45 = {r1[0], r1[1]}, r67 = {r1[2], r1[3]};
            f2 uA = SA[0] * r01; uA = SA[1] * r23 + uA; uA = SA[2] * r45 + uA; uA = SA[3] * r67 + uA;
            f2 uB = SB[0] * r01; uB = SB[1] * r23 + uB; uB = SB[2] * r45 + uB; uB = SB[3] * r67 + uB;
            const float yA = red8(uA.x + uA.y), yB = red8(uB.x + uB.y);
            if (kseg == 0) *(LAS f2*)(yb + ti * 64 + 2 * lr) = (f2){yA, yB};
        }
    }
    __syncthreads();
    { const int tp = d == 0 ? 16 * 15 : 0; LAS float* ybp = ybuf0 + (15 & 1) * 1024;
      *(f32x4*)(Yo + (size_t)(tp + (gt >> 4)) * 512 + 4 * (gt & 15)) = *(LAS f32x4*)(ybp + 4 * gt); }
    { float* op = a.out + (d == 0 ? OUT_RF : OUT_RB) + ((size_t)(b * 4 + l) * 8 + head) * 4096 + (2 * lr) * 64 + 8 * kseg;
      *(f32x4*)op = (f32x4){SA[0].x, SA[0].y, SA[1].x, SA[1].y}; *(f32x4*)(op + 4) = (f32x4){SA[2].x, SA[2].y, SA[3].x, SA[3].y};
      *(f32x4*)(op + 64) = (f32x4){SB[0].x, SB[0].y, SB[1].x, SB[1].y}; *(f32x4*)(op + 68) = (f32x4){SB[2].x, SB[2].y, SB[3].x, SB[3].y}; }
    __syncthreads();
}

__device__ __forceinline__ void scan_wave(ArgsRef a, unsigned char* ws, int l, bool lat, int b, int head, int dir, int rg, int lane) {
    const int T = lat ? 1024 : 256, tokbase = lat ? NCTX + b * 1024 : b * 256, nch = T / 16, dh = dir * 8 + head;
    const int cu0 = dh * 512 + (lat ? 256 + b * 64 : b * 16);
    const int q = lane & 15, g4 = lane >> 4, row = 16 * rg + q;
    const float* siv = (const float*)(ws + WS_V) + head * 64 + row;
    float* Yo = (float*)(ws + WS_Y) + (size_t)dir * MT * 512 + head * 64 + row;
    f32x4 ST[4];
    if (lat) { const float* sp = a.in[dir == 0 ? 6 : 7] + ((size_t)(b * 4 + l) * 8 + head) * 4096 + row * 64 + 4 * g4;
#pragma unroll
        for (int kt = 0; kt < 4; ++kt) ST[kt] = *(const f32x4*)(sp + 16 * kt); }
    else {
#pragma unroll
        for (int kt = 0; kt < 4; ++kt) ST[kt] = (f32x4){0.f, 0.f, 0.f, 0.f}; }
    struct COps { v2u im[20]; f32x4 gC[4]; f32x4 vv; };
#define CH_LOAD(O, C) do { const unsigned char* ops_ = ws + WS_OPS + (size_t)(cu0 + (C)) * OPS_BLOCK; \
        _Pragma("unroll") for (int i = 0; i < 10; ++i) { const v4u pr_ = *(const v4u*)(ops_ + i * 1024 + lane * 16); O.im[2 * i] = (v2u){pr_.x, pr_.y}; O.im[2 * i + 1] = (v2u){pr_.z, pr_.w}; } \
        _Pragma("unroll") for (int kt = 0; kt < 4; ++kt) O.gC[kt] = *(const f32x4*)(ops_ + 20 * 512 + (16 * kt + 4 * g4) * 4); \
        _Pragma("unroll") for (int e = 0; e < 4; ++e) { O.vv[e] = siv[(size_t)(tokbase + 16 * (dir == 0 ? (C) : nch - 1 - (C)) + 4 * g4 + e) * 512]; } } while (0)
#define CH_STEP(O, C) do { const v2u vB = pk4(O.vv); v2u sB[4]; \
        _Pragma("unroll") for (int kt = 0; kt < 4; ++kt) sB[kt] = pk4(ST[kt]); \
        f32x4 X = {0.f, 0.f, 0.f, 0.f}, Yt = {0.f, 0.f, 0.f, 0.f}; \
        _Pragma("unroll") for (int kt = 0; kt < 4; ++kt) { X = mfma16k(O.im[kt], sB[kt], X); Yt = mfma16k(O.im[4 + kt], sB[kt], Yt); } \
        X = mfma16k(O.im[16], vB, X); \
        const f32x4 P = mfma16k(O.im[17], pk4(X), (f32x4){0.f, 0.f, 0.f, 0.f}); const v2u pB = pk4(P); \
        Yt = mfma16k(O.im[18], pB, Yt); Yt = mfma16k(O.im[19], vB, Yt); \
        _Pragma("unroll") for (int e = 0; e < 4; ++e) { Yo[(size_t)(tokbase + 16 * (dir == 0 ? (C) : nch - 1 - (C)) + 4 * g4 + e) * 512] = Yt[e]; } \
        _Pragma("unroll") for (int kt = 0; kt < 4; ++kt) { f32x4 n = ST[kt] * O.gC[kt]; n = mfma16k(O.im[8 + kt], pB, n); n = mfma16k(O.im[12 + kt], vB, n); ST[kt] = n; } } while (0)
    { COps A, B; CH_LOAD(A, 0);
      for (int c = 0; c < nch; c += 2) {
          CH_LOAD(B, c + 1);
          CH_STEP(A, c);
          if (c + 2 < nch) CH_LOAD(A, c + 2);
          CH_STEP(B, c + 1);
      } }
#undef CH_LOAD
#undef CH_STEP
    if (!lat) { float* op = a.out + (dir == 0 ? OUT_RF : OUT_RB) + ((size_t)(b * 4 + l) * 8 + head) * 4096 + row * 64 + 4 * g4;
#pragma unroll
        for (int kt = 0; kt < 4; ++kt) *(f32x4*)(op + 16 * kt) = ST[kt]; }
}

__device__ __forceinline__ void scan_wg(ArgsRef a, unsigned char* ws, int l, bool lat, int b, int head, LAS unsigned char* lds, int tid) {
    const int lane = tid & 63, wv = __builtin_amdgcn_readfirstlane(tid >> 6), dir = wv >> 2, rg = wv & 3, sl = tid & 255;
    const int T = lat ? 1024 : 256, tokbase = lat ? NCTX + b * 1024 : b * 256, nch = T / 16, dh = dir * 8 + head;
    const int cu0 = dh * 512 + (lat ? 256 + b * 64 : b * 16);
    const int q = lane & 15, g4 = lane >> 4, row = 16 * rg + q;
    const bf16* siv = (const bf16*)(ws + WS_V) + head * 64 + row;
    bf16* Yo = (bf16*)(ws + WS_Y) + (size_t)dir * MT * 512 + head * 64 + row;
    LAS unsigned char* slot0 = lds + dir * (2 * OPS_BLOCK);
    f32x4 ST[4];
    if (lat) { const float* sp = a.in[dir == 0 ? 6 : 7] + ((size_t)(b * 4 + l) * 8 + head) * 4096 + row * 64 + 4 * g4;
#pragma unroll
        for (int kt = 0; kt < 4; ++kt) ST[kt] = *(const f32x4*)(sp + 16 * kt); }
    else {
#pragma unroll
        for (int kt = 0; kt < 4; ++kt) ST[kt] = (f32x4){0.f, 0.f, 0.f, 0.f}; }
    struct GRegs { v4u x0, x1, x2; v2u vv; };
#define SW_GLOAD(R, C) do { const unsigned char* ob_ = ws + WS_OPS + (size_t)(cu0 + (C)) * OPS_BLOCK + sl * 16; \
        R.x0 = *(const v4u*)ob_; R.x1 = *(const v4u*)(ob_ + 4096); if (sl < 160) R.x2 = *(const v4u*)(ob_ + 8192); \
        { const bf16* vp_ = siv + (size_t)(tokbase + 16 * (dir == 0 ? (C) : nch - 1 - (C)) + 4 * g4) * 512; \
          R.vv.x = (unsigned)vp_[0] | ((unsigned)vp_[512] << 16); R.vv.y = (unsigned)vp_[1024] | ((unsigned)vp_[1536] << 16); } } while (0)
#define SW_PARK(R, C) do { LAS unsigned char* sp_ = slot0 + ((C) & 1) * OPS_BLOCK + sl * 16; \
        *(LAS v4u*)sp_ = R.x0; *(LAS v4u*)(sp_ + 4096) = R.x1; if (sl < 160) *(LAS v4u*)(sp_ + 8192) = R.x2; } while (0)
#define SW_STEP(VV, C) do { const LAS unsigned char* sb_ = slot0 + ((C) & 1) * OPS_BLOCK; v2u im[20]; \
        _Pragma("unroll") for (int i = 0; i < 10; ++i) { const v4u pr_ = *(const LAS v4u*)(sb_ + i * 1024 + lane * 16); im[2 * i] = (v2u){pr_.x, pr_.y}; im[2 * i + 1] = (v2u){pr_.z, pr_.w}; } \
        f32x4 gC_[4]; _Pragma("unroll") for (int kt = 0; kt < 4; ++kt) gC_[kt] = *(const LAS f32x4*)(sb_ + 20 * 512 + (16 * kt + 4 * g4) * 4); \
        const v2u vB = VV; v2u sB[4]; \
        _Pragma("unroll") for (int kt = 0; kt < 4; ++kt) sB[kt] = pk4(ST[kt]); \
        f32x4 X = {0.f, 0.f, 0.f, 0.f}, Yt = {0.f, 0.f, 0.f, 0.f}; \
        _Pragma("unroll") for (int kt = 0; kt < 4; ++kt) { X = mfma16k(im[2 * kt], sB[kt], X); Yt = mfma16k(im[2 * kt + 1], sB[kt], Yt); } \
        X = mfma16k(im[16], vB, X); \
        const f32x4 P = mfma16k(im[17], pk4(X), (f32x4){0.f, 0.f, 0.f, 0.f}); const v2u pB = pk4(P); \
        Yt = mfma16k(im[18], pB, Yt); Yt = mfma16k(im[19], vB, Yt); \
        _Pragma("unroll") for (int e = 0; e < 4; ++e) Yo[(size_t)(tokbase + 16 * (dir == 0 ? (C) : nch - 1 - (C)) + 4 * g4 + e) * 512] = h1(Yt[e]); \
        _Pragma("unroll") for (int kt = 0; kt < 4; ++kt) { f32x4 n = ST[kt] * gC_[kt]; n = mfma16k(im[8 + 2 * kt], pB, n); n = mfma16k(im[9 + 2 * kt], vB, n); ST[kt] = n; } } while (0)
    { GRegs R0, R1, R2; v2u vcur;
      SW_GLOAD(R0, 0); SW_GLOAD(R1, 1); SW_GLOAD(R2, 2);
      SW_PARK(R0, 0); vcur = R0.vv;
      __syncthreads();
      for (int c = 0; c < nch; c += 3) {
          { v2u vn = vcur; if (c + 1 < nch) { SW_PARK(R1, c + 1); vn = R1.vv; } if (c + 3 < nch) SW_GLOAD(R0, c + 3); SW_STEP(vcur, c); vcur = vn; __syncthreads(); }
          if (c + 1 < nch) { v2u vn = vcur; if (c + 2 < nch) { SW_PARK(R2, c + 2); vn = R2.vv; } if (c + 4 < nch) SW_GLOAD(R1, c + 4); SW_STEP(vcur, c + 1); vcur = vn; __syncthreads(); }
          if (c + 2 < nch) { v2u vn = vcur; if (c + 3 < nch) { SW_PARK(R0, c + 3); vn = R0.vv; } if (c + 5 < nch) SW_GLOAD(R2, c + 5); SW_STEP(vcur, c + 2); vcur = vn; __syncthreads(); }
      } }
#undef SW_GLOAD
#undef SW_PARK
#undef SW_STEP
    if (!lat) { float* op = a.out + (dir == 0 ? OUT_RF : OUT_RB) + ((size_t)(b * 4 + l) * 8 + head) * 4096 + row * 64 + 4 * g4;
#pragma unroll
        for (int kt = 0; kt < 4; ++kt) *(f32x4*)(op + 16 * kt) = ST[kt]; }
}

constexpr int ATT_KP = 272, ATT_VP = 288, ATT_BUF = 64 * ATT_KP + 64 * ATT_VP;
template <int MODE> __device__ __forceinline__ void att_src(ArgsRef a, unsigned char* ws, int l, int b, int h, int c, int j, int rg, int skey, int sseg, const bf16*& kp, const bf16*& vp) {
    const bf16* F = (const bf16*)(ws + WS_F);
    if (MODE == 0 || MODE == 2) { const size_t ro = (size_t)(b * 256 + 32 * c + skey) * NINP + h * 128 + sseg * 8; kp = F + ro + (MODE == 0 ? C_NAK : C_DFK); vp = F + ro + (MODE == 0 ? C_NAV : C_DFV); }
    else if (MODE == 3) {
        if (c < 32) { kp = (const bf16*)(ws + WS_KR) + (size_t)(b * 1024 + 32 * c + skey) * 512 + h * 128 + sseg * 8; vp = F + (size_t)(NCTX + b * 1024 + 32 * c + skey) * NINP + C_DFV + h * 128 + sseg * 8; }
        else { const size_t ro = ((size_t)(b * 4 + l) * 256 + 32 * (c - 32) + skey) * 512 + h * 128 + sseg * 8; kp = (const bf16*)(ws + WS_CKDF) + ro; vp = (const bf16*)(ws + WS_CVDF) + ro; }
    } else {
        const int nloc = 12;
        if (c < nloc) { const int kr = (rg ? 4 : 0) + c; int kc0 = 16 * j - 8; kc0 = kc0 < 0 ? 0 : (kc0 > 32 ? 32 : kc0);
            const size_t ro = (size_t)(NCTX + b * 1024 + kr * 64 + kc0 + skey) * NINP + h * 128 + sseg * 8; kp = F + ro + C_NAK; vp = F + ro + C_NAV; }
        else { const size_t ro = ((size_t)(b * 4 + l) * 256 + 32 * (c - nloc) + skey) * 512 + h * 128 + sseg * 8; kp = (const bf16*)(ws + WS_CKNA) + ro; vp = (const bf16*)(ws + WS_CVNA) + ro; }
    }
}
template <int MODE> __device__ __forceinline__ void attn_unit(ArgsRef a, unsigned char* ws, int l, int uidx, LAS unsigned char* lds, int tid) {
    constexpr bool DIFF = (MODE == 2 || MODE == 3); constexpr int NS = DIFF ? 2 : 1;
    const int wave = __builtin_amdgcn_readfirstlane(tid >> 6), lane = tid & 63, q = lane & 15, g = lane >> 4, skey = tid >> 4, sseg = tid & 15;
    const bf16* F = (const bf16*)(ws + WS_F);
    int b, h, j = 0, rg = 0, nchunks, orow; const bf16* Qp;
    if (MODE == 0 || MODE == 2) { b = uidx >> 3; h = (uidx >> 1) & 3; const int half = uidx & 1; orow = b * 256 + half * 128 + wave * 16 + q; Qp = F + (size_t)orow * NINP + (MODE == 0 ? C_NAQ : C_DFQ) + h * 128; nchunks = 8; }
    else if (MODE == 3) { b = uidx >> 5; h = (uidx >> 3) & 3; const int qb = uidx & 7; const int lr = b * 1024 + qb * 128 + wave * 16 + q; orow = NCTX + lr; Qp = (const bf16*)(ws + WS_QR) + (size_t)lr * 512 + h * 128; nchunks = 40; }
    else { b = uidx >> 5; h = (uidx >> 3) & 3; j = (uidx >> 1) & 3; rg = uidx & 1; const int r = rg * 8 + wave; orow = NCTX + b * 1024 + r * 64 + 16 * j + q; Qp = F + (size_t)orow * NINP + C_NAQ + h * 128; nchunks = 12 + 8; }
    bf16x8 qf[4];
#pragma unroll
    for (int ks = 0; ks < 4; ++ks) qf[ks] = *(const bf16x8*)(Qp + 32 * ks + 8 * g);
    const float csc = (DIFF ? 0.125f : 0.08838834764831845f) * 1.4426950408889634f;
    float m[NS], ls[NS]; f32x4 o[NS][8];
#pragma unroll
    for (int n = 0; n < NS; ++n) { m[n] = -__builtin_inff(); ls[n] = 0.f;
#pragma unroll
        for (int d = 0; d < 8; ++d) o[n][d] = (f32x4){0.f, 0.f, 0.f, 0.f}; }
    const int nloc = 12, r = rg * 8 + wave, qc = 16 * j + q;
    int rs = r - 4; rs = rs < 0 ? 0 : (rs > 8 ? 8 : rs);
    int kc0 = 16 * j - 8; kc0 = kc0 < 0 ? 0 : (kc0 > 32 ? 32 : kc0);
    int wc0 = qc - 8; wc0 = wc0 < 0 ? 0 : (wc0 > 48 ? 48 : wc0);
    const float* rpb = a.in[13] + (size_t)(l * 4 + h) * 15 * 31;
    if (MODE == 1) { for (int i = tid; i < 15 * 31; i += 512) ((LAS float*)(lds + 2 * ATT_BUF))[i] = rpb[i] * 1.4426950408889634f; }
    v4u kreg, vreg, kreg1, vreg1;
    { const bf16 *kp, *vp; att_src<MODE>(a, ws, l, b, h, 0, j, rg, skey, sseg, kp, vp); kreg = *(const v4u*)kp; vreg = *(const v4u*)vp;
      att_src<MODE>(a, ws, l, b, h, 1, j, rg, skey, sseg, kp, vp); kreg1 = *(const v4u*)kp; vreg1 = *(const v4u*)vp; }
    for (int c2 = 0; c2 < nchunks / 2; ++c2) {
        LAS unsigned char* Kl0 = lds + (c2 & 1) * ATT_BUF; LAS unsigned char* Vl0 = Kl0 + 64 * ATT_KP;
        *(LAS v4u*)(Kl0 + skey * ATT_KP + sseg * 16) = kreg; *(LAS v4u*)(Vl0 + skey * ATT_VP + sseg * 16) = vreg;
        *(LAS v4u*)(Kl0 + (32 + skey) * ATT_KP + sseg * 16) = kreg1; *(LAS v4u*)(Vl0 + (32 + skey) * ATT_VP + sseg * 16) = vreg1;
        __syncthreads();
        if (2 * c2 + 2 < nchunks) { const bf16 *kp, *vp; att_src<MODE>(a, ws, l, b, h, 2 * c2 + 2, j, rg, skey, sseg, kp, vp); kreg = *(const v4u*)kp; vreg = *(const v4u*)vp;
            att_src<MODE>(a, ws, l, b, h, 2 * c2 + 3, j, rg, skey, sseg, kp, vp); kreg1 = *(const v4u*)kp; vreg1 = *(const v4u*)vp; }
#pragma unroll 1
      for (int sub = 0; sub < 2; ++sub) { const int c = 2 * c2 + sub;
        const LAS unsigned char* Kl = Kl0 + sub * 32 * ATT_KP; const LAS unsigned char* Vl = Vl0 + sub * 32 * ATT_VP;
        bool active = true; int kr = 0;
        if (MODE == 1 && c < nloc) { kr = (rg ? 4 : 0) + c; active = (kr >= rs) && (kr < rs + 8); }
        if (active) {
            f32x4 s[NS][2];
#pragma unroll
            for (int n = 0; n < NS; ++n) { s[n][0] = (f32x4){0.f, 0.f, 0.f, 0.f}; s[n][1] = s[n][0]; }
            { bf16x8 ka[2][4];
#pragma unroll
              for (int t = 0; t < 2; ++t)
#pragma unroll
                  for (int ks = 0; ks < 4; ++ks) ka[t][ks] = *(const LAS bf16x8*)(Kl + (16 * t + q) * ATT_KP + (32 * ks + 8 * g) * 2);
#pragma unroll
              for (int t = 0; t < 2; ++t)
#pragma unroll
                  for (int ks = 0; ks < 4; ++ks) { const int n = DIFF ? (ks >> 1) : 0; s[n][t] = mfma16(ka[t][ks], qf[ks], s[n][t]); }
              __builtin_amdgcn_sched_group_barrier(0x100, 4, 1);
#pragma unroll
              for (int k = 0; k < 4; ++k) { __builtin_amdgcn_sched_group_barrier(0x8, 1, 1); __builtin_amdgcn_sched_group_barrier(0x100, 1, 1); }
              __builtin_amdgcn_sched_group_barrier(0x8, 4, 1); }
            const bool biased = (MODE == 1 && c < nloc);
            if (biased) { const LAS float* rrow = (const LAS float*)(lds + 2 * ATT_BUF) + (kr - r + 7) * 31 + 15;
#pragma unroll
                for (int t = 0; t < 2; ++t)
#pragma unroll
                    for (int e = 0; e < 4; ++e) { const int kc = kc0 + 16 * t + 4 * g + e; int rel = kc - qc; rel = rel < -15 ? -15 : (rel > 15 ? 15 : rel);
                        const bool inw = (kc >= wc0) && (kc < wc0 + 16); s[0][t][e] = inw ? __builtin_fmaf(s[0][t][e], csc, rrow[rel]) : -__builtin_inff(); } }
            bf16x8 pb[NS];
#pragma unroll
            for (int n = 0; n < NS; ++n) {
                const float PINF = __builtin_inff();
                const float mx = __builtin_amdgcn_fmed3f(__builtin_amdgcn_fmed3f(__builtin_amdgcn_fmed3f(s[n][0][0], s[n][0][1], PINF), __builtin_amdgcn_fmed3f(s[n][0][2], s[n][0][3], PINF), PINF),
                                                         __builtin_amdgcn_fmed3f(__builtin_amdgcn_fmed3f(s[n][1][0], s[n][1][1], PINF), __builtin_amdgcn_fmed3f(s[n][1][2], s[n][1][3], PINF), PINF), PINF);
                const float mu = biased ? mx : mx * csc;
                if (__any(mu > m[n] + 8.0f)) {
                    const float mnew = fmaxf(m[n], xrow16_max(mu));
                    const float alpha = __builtin_amdgcn_exp2f(m[n] - ((mnew == -__builtin_inff()) ? 0.f : mnew)); m[n] = mnew;
                    ls[n] = ls[n] * alpha;
#pragma unroll
                    for (int d = 0; d < 8; ++d) o[n][d] = o[n][d] * alpha;
                }
                const float muse = (m[n] == -__builtin_inff()) ? 0.f : m[n];
                float p[8]; float psum = 0.f;
                if (biased) {
#pragma unroll
                    for (int e = 0; e < 4; ++e) { p[e] = __builtin_amdgcn_exp2f(s[n][0][e] - muse); p[4 + e] = __builtin_amdgcn_exp2f(s[n][1][e] - muse); psum += p[e] + p[4 + e]; } }
                else {
#pragma unroll
                    for (int e = 0; e < 4; ++e) { p[e] = __builtin_amdgcn_exp2f(__builtin_fmaf(s[n][0][e], csc, -muse)); p[4 + e] = __builtin_amdgcn_exp2f(__builtin_fmaf(s[n][1][e], csc, -muse)); psum += p[e] + p[4 + e]; } }
                ls[n] += psum;
                pb[n] = pack8(p);
            }
            bf16x8 vt[8];
#pragma unroll
            for (int d = 0; d < 8; ++d) {
                const LAS unsigned char* va = Vl + (4 * g + (q >> 2)) * ATT_VP + (16 * d + 4 * (q & 3)) * 2;
                const s16x4 lo = vtr(va), hi = vtr(va + 16 * ATT_VP);
                vt[d] = (bf16x8){lo[0], lo[1], lo[2], lo[3], hi[0], hi[1], hi[2], hi[3]}; }
#pragma unroll
            for (int d = 0; d < 8; ++d)
#pragma unroll
                for (int n = 0; n < NS; ++n) o[n][d] = mfma16(vt[d], pb[n], o[n][d]);
            __builtin_amdgcn_sched_group_barrier(0x100, 8, 0);
#pragma unroll
            for (int k = 0; k < 4; ++k) { __builtin_amdgcn_sched_group_barrier(0x8, NS, 0); __builtin_amdgcn_sched_group_barrier(0x100, 2, 0); }
            __builtin_amdgcn_sched_group_barrier(0x8, 4 * NS, 0);
        }
      }
    }
    bf16* O3 = (bf16*)(ws + WS_O3) + (size_t)orow * 1536 + (DIFF ? 512 : 0) + h * 128 + 4 * g;
    if constexpr (!DIFF) { const float inv = __builtin_amdgcn_rcpf(xrow16_sum(ls[0]));
#pragma unroll
        for (int d = 0; d < 8; ++d) { const f32x4 v = o[0][d] * inv; v2u w; w.x = cvt_pk_bf16(v[0], v[1]); w.y = cvt_pk_bf16(v[2], v[3]); *(v2u*)(O3 + 16 * d) = w; } }
    else { const float lam = ((const float*)(ws + WS_LAM))[l], li = lam_init_of(l);
        const float i0 = __builtin_amdgcn_rcpf(xrow16_sum(ls[0])), i1 = lam * __builtin_amdgcn_rcpf(xrow16_sum(ls[1])); float ss = 0.f;
#pragma unroll
        for (int d = 0; d < 8; ++d) { o[0][d] = o[0][d] * i0 - o[1][d] * i1; ss += (o[0][d][0] * o[0][d][0] + o[0][d][1] * o[0][d][1]) + (o[0][d][2] * o[0][d][2] + o[0][d][3] * o[0][d][3]); }
        ss = xrow16_sum(ss);
        const float rsn = __builtin_amdgcn_rsqf(ss * (1.f / 128.f) + LN_EPS) * (1.0f - li);
        const float* sub = a.in[15] + l * 512 + h * 128 + 4 * g;
#pragma unroll
        for (int d = 0; d < 8; ++d) { const f32x4 v = o[0][d] * rsn * *(const f32x4*)(sub + 16 * d); v2u w; w.x = cvt_pk_bf16(v[0], v[1]); w.y = cvt_pk_bf16(v[2], v[3]); *(v2u*)(O3 + 16 * d) = w; } }
    __syncthreads();
}

__device__ __forceinline__ void rb_wait(gu32* cnt, int ra, int rb, int tid) {
    if (tid == 0) {
        unsigned sp = 0u;
        if (rb > ra + 1) { for (int r = ra; r < rb; ++r) while (__hip_atomic_load(cnt + 64 * r, RLX_AGENT) < pg8::RB_NEED) { __builtin_amdgcn_s_sleep(1); if (++sp > (1u << 22)) break; } }
        else while (__hip_atomic_load(cnt + 64 * ra, RLX_AGENT) < pg8::RB_NEED || __hip_atomic_load(cnt + 64 * rb, RLX_AGENT) < pg8::RB_NEED) { __builtin_amdgcn_s_sleep(1); if (++sp > (1u << 22)) break; }
        __builtin_amdgcn_fence(__ATOMIC_ACQUIRE, "agent");
    }
    __syncthreads();
}

constexpr int MIX_SCL = 32, MIX_A3 = MIX_SCL + 128, MIX_A0 = MIX_A3 + 128, MIX_A1 = MIX_A0 + 128, MIX_A2 = MIX_A1 + 128, MIX_SCC = MIX_A2 + 128, MIX_END = MIX_SCC;
__device__ __forceinline__ void phase_mix(ArgsRef a, unsigned char* ws, int l, LAS unsigned char* lds, int tid, int rep) {
    gu32* head = (gu32*)(ws + WS_CTL) + CW_MIXQ + 64 * (l + 4 * rep);
    volatile LAS int* slot = (volatile LAS int*)(lds + MISC_OFF + 64);
    for (;;) {
        if (tid == 0) slot[0] = (int)__hip_atomic_fetch_add(head, 1u, __ATOMIC_RELAXED, __HIP_MEMORY_SCOPE_AGENT);
        __syncthreads();
        const int u = __builtin_amdgcn_readfirstlane(slot[0]);
        __syncthreads();
        if (u >= MIX_END) break;
        if (u < MIX_SCL) scan_wg(a, ws, l, true, u >> 3, u & 7, lds, tid);
        else if (u < MIX_A3) attn_unit<3>(a, ws, l, u - MIX_SCL, lds, tid);
        else if (u < MIX_A0) attn_unit<0>(a, ws, l, u - MIX_A3, lds, tid);
        else if (u < MIX_A1) attn_unit<1>(a, ws, l, u - MIX_A0, lds, tid);
        else if (u < MIX_A2) attn_unit<2>(a, ws, l, u - MIX_A1, lds, tid);
        else { const int v = u - MIX_A2; scan_wg(a, ws, l, false, v >> 3, v & 7, lds, tid); }
    }
}

__global__ void __launch_bounds__(NWAVES * 64, 2) fwd_kernel(Args args) {
    extern __shared__ __attribute__((aligned(16))) unsigned char lds_raw[];
    LAS unsigned char* lds = (LAS unsigned char*)lds_raw;
    const int tid = threadIdx.x; const int wave_s = __builtin_amdgcn_readfirstlane(tid >> 6);
    const int G = gridDim.x, bid = blockIdx.x, NGW = G * NWAVES;
    for (int u = tid; u < (LDS_BYTES - RING_BYTES) / 4; u += NWAVES * 64) ((LAS unsigned*)(lds + RING_BYTES))[u] = 0u;
    __syncthreads();
    unsigned* barw = (unsigned*)(args.ws + WS_CTL) + CW_BAR;
    XcdBarrier bar; bar.bar = barw; bar.x = 0; bar.st = nullptr;
    if (MK_SINGLE) bar = xcd_barrier_post(barw, (volatile LAS unsigned*)(lds + MISC_OFF) + 8);
    const int lo = args.ph_lo, hi = args.ph_hi;
#ifndef PH_MASK
#define PH_MASK 0xFFFFu
#endif
#define PM(i) (((PH_MASK) >> (i)) & 1u)
#ifndef DUP_MASK
#define DUP_MASK 0u
#endif
#define DUPN(i) ((((DUP_MASK) >> (i)) & 1u) ? 2 : 1)
#define IN(k) (lo <= (k) && (k) < hi)
#define SEAM(k) do { if (MK_SINGLE && IN(k) && IN((k) + 1)) xcd_barrier(bar); } while (0)
#define FRESH() int tid_, bid_ = bid, G_ = G; asm volatile("v_mbcnt_lo_u32_b32 %0, -1, 0\n\tv_mbcnt_hi_u32_b32 %0, -1, %0" : "=v"(tid_)); tid_ += wave_s * 64; const CAS Args* ap_ = (const CAS Args*)__builtin_amdgcn_kernarg_segment_ptr(); asm volatile("" : "+v"(tid_), "+s"(ap_), "+s"(bid_), "+s"(G_)); ArgsRef A_ = *ap_; unsigned char* ws = A_.ws; const int lane_ = tid_ & 63, wave_ = __builtin_amdgcn_readfirstlane(tid_ >> 6), gw_ = bid_ * NWAVES + wave_, NGW_ = G_ * NWAVES; (void)lane_; (void)gw_; (void)NGW_
    if (PM(0) && IN(0)) for (int rep = 0; rep < DUPN(0); ++rep) { FRESH(); phase_ada(A_, ws, lds, tid_, bid_, G_); __syncthreads(); phase_cvt(A_, ws, lds, tid_, bid_, G_); __syncthreads(); }
    SEAM(0);
    if (PM(1) && IN(1)) { FRESH(); phase_ln<0>(A_, ws, 0, gw_, NGW_, lane_); }
    SEAM(1);
    for (int l = 0; l < NL; ++l) {
        const int pb = 2 + 10 * l;
        if (PM(2) && IN(pb + 0)) { FRESH(); pg8::Gemm g{(const pg8::bf16_t*)(ws + WS_H), (const pg8::bf16_t*)(ws + WS_WIN) + (size_t)l * NINP * D, MT, NINP, D}; pg8::DepOrder S; S.init(MT, NINP, G_, bid_);
            S.cnt = (gu32*)(ws + WS_CTL) + CW_RB + 2048 * l; S.lead = (tid_ == 0); S.pend = -1;
            pg8::EpiF E{(pg8::bf16_t*)(ws + WS_F), A_.out, l, ws + WS_GF};
            pg8::gemm_phase<pg8::EpiF, pg8::DepOrder, true, true>(lds, g, S, E, tid_); S.flush(); }
        if (PM(3) && IN(pb + 1)) { FRESH(); gu32* cnt = (gu32*)(ws + WS_CTL) + CW_RB + 2048 * l; gu32* head = (gu32*)(ws + WS_CTL) + CW_PREQ + 64 * l; volatile LAS int* slot = (volatile LAS int*)(lds + MISC_OFF + 64);
            for (;;) {
                if (tid_ == 0) slot[0] = (int)__hip_atomic_fetch_add(head, 1u, __ATOMIC_RELAXED, __HIP_MEMORY_SCOPE_AGENT);
                __syncthreads();
                const int t = __builtin_amdgcn_readfirstlane(slot[0]);
                __syncthreads();
                if (t >= 512) break;
                const int tok0 = t * 16; rb_wait(cnt, (tok0 > 0 ? tok0 - 1 : 0) >> 8, (tok0 + 16 < MT ? tok0 + 16 : MT - 1) >> 8, tid_);
                pre_tile(A_, ws, l, t, lds, tid_); }
            rb_wait(cnt, 16, 32, tid_);
            phase_rope(ws, gw_, NGW_, lane_); }
        SEAM(pb + 1);
        if (PM(4) && IN(pb + 2)) for (int rep = 0; rep < DUPN(4); ++rep) { FRESH(); phase_mix(A_, ws, l, lds, tid_, rep); if (rep + 1 < DUPN(4)) xcd_barrier(bar); }
        SEAM(pb + 2);
        if (PM(5) && IN(pb + 3)) for (int rep = 0; rep < DUPN(5); ++rep) { FRESH(); phase_post(A_, ws, l, gw_, NGW_, lane_); }
        SEAM(pb + 3);
        if (PM(6) && IN(pb + 4)) for (int rep = 0; rep < DUPN(6); ++rep) { FRESH(); pg8::Gemm g{(const pg8::bf16_t*)(ws + WS_O3), (const pg8::bf16_t*)(ws + WS_WBR) + (size_t)l * D * 1536, MT, D, 1536}; pg8::StaticOrder S; S.init(MT, D, G_, bid_);
            pg8::EpiMerge E{ws + WS_GF, (pg8::bf16_t*)(ws + WS_MERGED)};
            pg8::gemm_phase<pg8::EpiMerge, pg8::StaticOrder, true, true, true>(lds, g, S, E, tid_); }
        SEAM(pb + 4);
        if (PM(7) && IN(pb + 5)) for (int rep = 0; rep < DUPN(7); ++rep) { FRESH(); pg8::Gemm g{(const pg8::bf16_t*)(ws + WS_MERGED), (const pg8::bf16_t*)(ws + WS_WO) + (size_t)l * D * D, MT, D, D}; pg8::StaticOrder S; S.init(MT, D, G_, bid_);
            const int gk = l == 0 ? 0 : 2 * l; pg8::EpiRes E{(const pg8::bf16_t*)(ws + (l == 0 ? WS_X : WS_MBUF)), l == 0 ? (const float*)nullptr : (const float*)(ws + WS_ST2), (const float*)(ws + WS_GB) + (size_t)gk * 2 * D, (const float*)(ws + WS_GB) + (size_t)gk * 2 * D + D,
                (const float*)(ws + WS_MOD) + (size_t)l * 5 * 12288 + 2 * D, (pg8::bf16_t*)(ws + WS_MBUF)};
            pg8::gemm_phase<pg8::EpiRes, pg8::StaticOrder, true, true>(lds, g, S, E, tid_); }
        SEAM(pb + 5);
        if (PM(8) && IN(pb + 6)) for (int rep = 0; rep < DUPN(8); ++rep) { FRESH(); phase_ln<1>(A_, ws, l, gw_, NGW_, lane_); }
        SEAM(pb + 6);
        if (PM(9) && IN(pb + 7)) for (int rep = 0; rep < DUPN(9); ++rep) { FRESH(); pg8::Gemm g{(const pg8::bf16_t*)(ws + WS_H), (const pg8::bf16_t*)(ws + WS_WFI) + (size_t)l * NFI * D, MT, NFI, D}; pg8::StaticOrder S; S.init(MT, NFI, G_, bid_);
            pg8::EpiSwiglu E{(pg8::bf16_t*)(ws + WS_F)};
            pg8::gemm_phase<pg8::EpiSwiglu, pg8::StaticOrder, true, true>(lds, g, S, E, tid_); }
        SEAM(pb + 7);
        if (PM(10) && IN(pb + 8)) for (int rep = 0; rep < DUPN(10); ++rep) { FRESH(); pg8::Gemm g{(const pg8::bf16_t*)(ws + WS_F), (const pg8::bf16_t*)(ws + WS_WFO) + (size_t)l * D * FF, MT, D, FF}; pg8::StaticOrder S; S.init(MT, D, G_, bid_);
            const int gk = 1 + 2 * l; pg8::EpiRes E{(const pg8::bf16_t*)(ws + WS_MBUF), (const float*)(ws + WS_ST1), (const float*)(ws + WS_GB) + (size_t)gk * 2 * D, (const float*)(ws + WS_GB) + (size_t)gk * 2 * D + D,
                (const float*)(ws + WS_MOD) + (size_t)l * 5 * 12288 + 5 * D, (pg8::bf16_t*)(ws + WS_MBUF)};
            pg8::gemm_phase<pg8::EpiRes, pg8::StaticOrder, true, true>(lds, g, S, E, tid_); }
        SEAM(pb + 8);
        if (PM(11) && IN(pb + 9)) for (int rep = 0; rep < DUPN(11); ++rep) { FRESH(); if (l < NL - 1) phase_ln<2>(A_, ws, l, gw_, NGW_, lane_); else phase_ln<3>(A_, ws, l, gw_, NGW_, lane_); }
        SEAM(pb + 9);
    }
#undef FRESH
#undef IN
#undef SEAM
}
constexpr int N_PHASES = 2 + 10 * NL;

extern "C" void kernel_launch(void* const* d_in, const int* in_sizes, int n_in, void* d_out, int out_size, void* d_ws, size_t ws_size, hipStream_t stream) {
    static int grid = 0;
    if (grid == 0) {
        if (n_in != 35 || out_size != (int)OUT_TOTAL || ws_size < WS_END) { fprintf(stderr, "kernel_launch: unexpected problem: n_in %d out %d ws %zu (need %zu)\n", n_in, out_size, ws_size, (size_t)WS_END); grid = -1; return; }
        int dev = 0, cus = 0, per_cu = 0;
        if (hipGetDevice(&dev) != hipSuccess || hipDeviceGetAttribute(&cus, hipDeviceAttributeMultiprocessorCount, dev) != hipSuccess) { grid = -1; return; }
        if (hipFuncSetAttribute((const void*)fwd_kernel, hipFuncAttributeMaxDynamicSharedMemorySize, LDS_BYTES) != hipSuccess) { fprintf(stderr, "kernel_launch: hipFuncSetAttribute failed\n"); grid = -1; return; }
        if (hipOccupancyMaxActiveBlocksPerMultiprocessor(&per_cu, (const void*)fwd_kernel, NWAVES * 64, LDS_BYTES) != hipSuccess || per_cu < 1) fprintf(stderr, "kernel_launch: occupancy query says %d\n", per_cu);
        (void)hipGetLastError();
        grid = cus;
    }
    if (grid < 0) return;
    (void)hipMemsetAsync((char*)d_ws + WS_CTL, 0, CTL_ZERO_BYTES, stream);
    Args a{};
    for (int i = 0; i < 35; ++i) a.in[i] = (const float*)d_in[i];
    a.out = (float*)d_out; a.ws = (unsigned char*)d_ws; a.l_lo = 0; a.l_hi = NL;
    if (MK_SINGLE) { a.ph_lo = 0; a.ph_hi = N_PHASES; hipLaunchKernelGGL(fwd_kernel, dim3(grid), dim3(NWAVES * 64), LDS_BYTES, stream, a); }
    else for (int p = 0; p < N_PHASES; ++p) { a.ph_lo = p; a.ph_hi = p + 1; hipLaunchKernelGGL(fwd_kernel, dim3(grid), dim3(NWAVES * 64), LDS_BYTES, stream, a); }
}
```

```cpp
#include <hip/hip_runtime.h>
#include <cstdio>
#include <cstdint>

#ifndef MK_SINGLE
#define MK_SINGLE 1
#endif

constexpr int D = 2048, MT = 8192, NCTX = 4096, NL = 4;
constexpr int NIN = 11136, NINP = 11264, FF = 5632, NFI = 11264;
constexpr int C_NAQ = 0, C_NAK = 512, C_NAV = 1024, C_DFQ = 1536, C_DFK = 2048, C_DFV = 2560, C_RW = 3072, C_GATE = 5120;
__host__ __device__ __forceinline__ constexpr unsigned gf_off(int i, int pm, int j, int wave) { return (unsigned)((((i * 32 + pm) * 8 + j) * 8 + wave) * 16) * 1024u; }
constexpr size_t OUT_YP = 0, OUT_NAK = 16777216, OUT_NAV = 25165824, OUT_DFK = 33554432, OUT_DFV = 41943040, OUT_RF = 50331648, OUT_RB = 52428800, OUT_TOTAL = 54525952;
constexpr float LN_EPS = 1e-5f;

namespace pg8 {
#define PG8_LAS __attribute__((address_space(3)))
typedef unsigned short bf16_t;
typedef short bf16x8 __attribute__((ext_vector_type(8)));
typedef float f32x4 __attribute__((ext_vector_type(4)));
typedef unsigned u32x4 __attribute__((ext_vector_type(4)));
constexpr int BM = 256, BK = 64, HALF = 128, HTB = HALF * BK * 2  , STAGE_BYTES = 8 * HTB, NXCD = 8, WGM = 8;

__host__ __device__ __forceinline__ int lds_byte(int r, int c) { const int st = (r >> 4) * 2 + (c >> 5), rr = r & 15, cc = c & 31, ob = rr * 64 + cc * 2; return st * 1024 + (ob ^ (((ob >> 9) & 1) << 5)); }
__host__ __device__ __forceinline__ void stage_rc(int b, int& R, int& C) { const int st = b / 1024, sb = b % 1024, swz = sb ^ (((sb >> 9) & 1) << 5); R = (st >> 1) * 16 + swz / 64; C = (st & 1) * 32 + (swz % 64) / 2; }
__host__ __device__ __forceinline__ int perm32(int rho) { const int n = rho >> 4, i = rho & 15; return 8 * (i >> 2) + 4 * n + (i & 3); }

struct Unit { int pm, pn; };
struct Gemm { const bf16_t* A; const bf16_t* Bt; int M, N, K; };

struct StaticOrder {
    int nM, nN, nwg, G, c;
    __host__ __device__ void init(int M, int N, int G_, int c_) { nM = M / BM; nN = N / BM; nwg = nM * nN; G = G_; c = c_; }
    __host__ __device__ bool next(int i, Unit& u) const {
        const long L = (long)i * G + c; if (L >= nwg) return false;
        int wgid = (int)L; { const int q = nwg / NXCD, r = nwg % NXCD, xcd = wgid % NXCD, off = wgid / NXCD; wgid = (xcd < r ? xcd * (q + 1) : r * (q + 1) + (xcd - r) * q) + off; }
        const int nig = WGM * nN, gid = wgid / nig, fm = gid * WGM, gsz = (nM - fm) < WGM ? (nM - fm) : WGM;
        u.pm = fm + ((wgid % nig) % gsz); u.pn = (wgid % nig) / gsz; return true;
    }
    __device__ __forceinline__ void a_ready(const Unit&) const {}
    __device__ __forceinline__ void done(const Unit&) const {}
};

typedef __attribute__((address_space(1))) unsigned gu32_;
typedef __attribute__((address_space(1))) unsigned long long gu64_;
__host__ __device__ __forceinline__ bool f_needed(int pn) { return (pn >= 6 && pn < 10) || (pn >= 12 && pn < 20); }
constexpr unsigned RB_NEED = 12u;
struct DepOrder : StaticOrder {
    gu32_* cnt; bool lead; mutable int pend;
    __device__ __forceinline__ void flush() const { if (pend >= 0 && lead) (void)__hip_atomic_fetch_add(cnt + 64 * pend, 1u, __ATOMIC_RELAXED, __HIP_MEMORY_SCOPE_AGENT); pend = -1; }
    __device__ __forceinline__ void done(const Unit& u) const { flush(); pend = f_needed(u.pn) ? u.pm : -1; }
};

__device__ __forceinline__ unsigned cvt_pk_bf16(float lo, float hi) { typedef _Float16 h2_ __attribute__((ext_vector_type(2))); typedef float f2_ __attribute__((ext_vector_type(2))); const f2_ v = {lo, hi}; return __builtin_bit_cast(unsigned, __builtin_convertvector(v, h2_)); }
typedef float f32x2 __attribute__((ext_vector_type(2)));
typedef unsigned u32x2 __attribute__((ext_vector_type(2)));
typedef _Float16 h16x2 __attribute__((ext_vector_type(2)));
typedef _Float16 h16x8 __attribute__((ext_vector_type(8)));
__device__ __forceinline__ float bf_lo(unsigned w) { return (float)__builtin_bit_cast(h16x2, w)[0]; }
__device__ __forceinline__ float bf_hi(unsigned w) { return (float)__builtin_bit_cast(h16x2, w)[1]; }
__device__ __forceinline__ float sigm(float x) { return __builtin_amdgcn_rcpf(1.0f + __expf(-x)); }

struct EpiF {
    static constexpr bool PERM = true, AFTER_DRAIN = false;
    bf16_t* F; float* out; int layer; unsigned char* GF;
    __device__ __forceinline__ void operator()(const f32x4 (&acc)[2][2][4][2], const Unit& u, int wr, int wc, int fr, int fq) const {
        const int row0 = u.pm * BM + wr * 64 + fr, col0 = u.pn * BM + wc * 32 + 8 * fq;
        float* ob = nullptr;
        if (u.pm < 16) { const int seg = u.pn >> 1;
            if (seg == 1) ob = out + OUT_NAK; else if (seg == 2) ob = out + OUT_NAV; else if (seg == 4) ob = out + OUT_DFK; else if (seg == 5) ob = out + OUT_DFV; }
        const __amdgpu_buffer_rsrc_t frs = __builtin_amdgcn_make_buffer_rsrc(F, 0, MT * NINP * 2, 0x00020000);
        const bool gt = u.pn >= 20; const unsigned gbase = gt ? gf_off((u.pn - 20) >> 3, u.pm, (u.pn - 20) & 7, wr * 4 + wc) + (unsigned)(fr + 16 * fq) * 16u : 0u;
        const bool wt = f_needed(u.pn);
        const int cseg = (u.pn & 1) * 256 + wc * 32 + 8 * fq;
#pragma unroll
        for (int ai = 0; ai < 2; ++ai)
#pragma unroll
            for (int m = 0; m < 4; ++m) { const int row = row0 + ai * HALF + m * 16; bf16_t* rowp = F + (size_t)row * NINP + col0;
#pragma unroll
                for (int bj = 0; bj < 2; ++bj) { const f32x4 v0 = acc[ai][bj][m][0], v1 = acc[ai][bj][m][1];
                    u32x4 w; w.x = cvt_pk_bf16(v0[0], v0[1]); w.y = cvt_pk_bf16(v0[2], v0[3]); w.z = cvt_pk_bf16(v1[0], v1[1]); w.w = cvt_pk_bf16(v1[2], v1[3]);
                    if (gt) *(u32x4*)(GF + gbase + (unsigned)(ai * 8 + m * 2 + bj) * 1024u) = w;
                    else if (wt) __builtin_amdgcn_raw_buffer_store_b128(w, frs, (unsigned)(((unsigned)row * NINP + col0 + bj * HALF) * 2u), 0,   16);
                    else *(u32x4*)(rowp + bj * HALF) = w;
                    if (ob) { float* dst = ob + ((size_t)((row >> 8) * 4 + layer) * 256 + (row & 255)) * 512 + cseg + bj * HALF; *(f32x4*)dst = v0; *(f32x4*)(dst + 4) = v1; } } }
    }
};
struct EpiMerge {
    static constexpr bool PERM = true, AFTER_DRAIN = false;
    const unsigned char* GF; bf16_t* merged;
    __device__ __forceinline__ static float egate(float x) { return __expf(-fminf(fmaxf(x, -30.f), 30.f)); }
    __device__ __forceinline__ void mid(f32x4 (&acc)[2][2][4][2], const Unit& u, int i, int wr, int wc, int fr, int fq) const {
        unsigned off0 = gf_off(i, u.pm, u.pn, wr * 4 + wc) + (unsigned)(fr + 16 * fq) * 16u;
        asm volatile("" : "+v"(off0));
        u32x4 ga[2][2], gb[2][2];
        { const unsigned char* gp = GF + off0;
#pragma unroll
          for (int bj = 0; bj < 2; ++bj) { ga[0][bj] = *(const u32x4*)(gp + bj * 1024); gb[0][bj] = *(const u32x4*)(gp + gf_off(1, 0, 0, 0) + bj * 1024); } }
#pragma unroll
        for (int k = 0; k < 8; ++k) { const int ai = k >> 2, m = k & 3, cb = k & 1, nb = cb ^ 1;
            if (k < 7) { const unsigned char* gp = GF + (off0 + (unsigned)((k + 1) * 2) * 1024u);
#pragma unroll
                for (int bj = 0; bj < 2; ++bj) { ga[nb][bj] = *(const u32x4*)(gp + bj * 1024); gb[nb][bj] = *(const u32x4*)(gp + gf_off(1, 0, 0, 0) + bj * 1024); } }
            asm volatile("" ::: "memory");
#pragma unroll
            for (int bj = 0; bj < 2; ++bj) { const u32x4 xa = ga[cb][bj], xb = gb[cb][bj];
                f32x4 r0, r1;
                r0[0] = (1.f + egate(bf_lo(xb.x))) * __builtin_amdgcn_rcpf(1.f + egate(bf_lo(xa.x))); r0[1] = (1.f + egate(bf_hi(xb.x))) * __builtin_amdgcn_rcpf(1.f + egate(bf_hi(xa.x)));
                r0[2] = (1.f + egate(bf_lo(xb.y))) * __builtin_amdgcn_rcpf(1.f + egate(bf_lo(xa.y))); r0[3] = (1.f + egate(bf_hi(xb.y))) * __builtin_amdgcn_rcpf(1.f + egate(bf_hi(xa.y)));
                r1[0] = (1.f + egate(bf_lo(xb.z))) * __builtin_amdgcn_rcpf(1.f + egate(bf_lo(xa.z))); r1[1] = (1.f + egate(bf_hi(xb.z))) * __builtin_amdgcn_rcpf(1.f + egate(bf_hi(xa.z)));
                r1[2] = (1.f + egate(bf_lo(xb.w))) * __builtin_amdgcn_rcpf(1.f + egate(bf_lo(xa.w))); r1[3] = (1.f + egate(bf_hi(xb.w))) * __builtin_amdgcn_rcpf(1.f + egate(bf_hi(xa.w)));
                acc[ai][bj][m][0] *= r0; acc[ai][bj][m][1] *= r1; }
            asm volatile("" ::: "memory"); }
    }
    __device__ __forceinline__ void operator()(const f32x4 (&acc)[2][2][4][2], const Unit& u, int wr, int wc, int fr, int fq) const {
        const int row0 = u.pm * BM + wr * 64 + fr, col0 = u.pn * BM + wc * 32 + 8 * fq;
#pragma unroll
        for (int ai = 0; ai < 2; ++ai) {
            u32x4 gin[4][2];
#pragma unroll
            for (int m = 0; m < 4; ++m)
#pragma unroll
                for (int bj = 0; bj < 2; ++bj) gin[m][bj] = *(const u32x4*)(GF + gf_off(2, u.pm, u.pn, wr * 4 + wc) + (unsigned)(fr + 16 * fq) * 16u + (unsigned)(ai * 8 + m * 2 + bj) * 1024u);
#pragma unroll
            for (int m = 0; m < 4; ++m) { const int row = row0 + ai * HALF + m * 16;
#pragma unroll
                for (int bj = 0; bj < 2; ++bj) { const int col = col0 + bj * HALF;
                    const u32x4 gw = gin[m][bj];
                    f32x4 g0, g1; g0[0] = __builtin_amdgcn_rcpf(1.f + egate(bf_lo(gw.x))); g0[1] = __builtin_amdgcn_rcpf(1.f + egate(bf_hi(gw.x))); g0[2] = __builtin_amdgcn_rcpf(1.f + egate(bf_lo(gw.y))); g0[3] = __builtin_amdgcn_rcpf(1.f + egate(bf_hi(gw.y)));
                    g1[0] = __builtin_amdgcn_rcpf(1.f + egate(bf_lo(gw.z))); g1[1] = __builtin_amdgcn_rcpf(1.f + egate(bf_hi(gw.z))); g1[2] = __builtin_amdgcn_rcpf(1.f + egate(bf_lo(gw.w))); g1[3] = __builtin_amdgcn_rcpf(1.f + egate(bf_hi(gw.w)));
                    const f32x4 v0 = acc[ai][bj][m][0] * g0, v1 = acc[ai][bj][m][1] * g1;
                    u32x4 w; w.x = cvt_pk_bf16(v0[0], v0[1]); w.y = cvt_pk_bf16(v0[2], v0[3]); w.z = cvt_pk_bf16(v1[0], v1[1]); w.w = cvt_pk_bf16(v1[2], v1[3]);
                    *(u32x4*)(merged + (size_t)row * D + col) = w; } } }
    }
};
struct EpiRes {
    static constexpr bool PERM = true, AFTER_DRAIN = false;
    const bf16_t* src; const float* st; const float* gam; const float* bet; const float* gate; bf16_t* out;
    __device__ __forceinline__ void operator()(const f32x4 (&acc)[2][2][4][2], const Unit& u, int wr, int wc, int fr, int fq) const {
        const int row0 = u.pm * BM + wr * 64 + fr, col0 = u.pn * BM + wc * 32 + 8 * fq;
        const int cidx = u.pm < 16 ? 0 : 1 + ((u.pm - 16) >> 2);
        const float* gp = gate + (size_t)cidx * 12288 + col0;
        f32x2 rs[2][4];
#pragma unroll
        for (int ai = 0; ai < 2; ++ai)
#pragma unroll
            for (int m = 0; m < 4; ++m) { rs[ai][m] = (f32x2){1.f, 0.f}; if (st) rs[ai][m] = *(const f32x2*)(st + 2 * (row0 + ai * HALF + m * 16)); }
#pragma unroll
        for (int bj = 0; bj < 2; ++bj) {
            const f32x4 g0 = *(const f32x4*)(gp + bj * HALF), g1 = *(const f32x4*)(gp + bj * HALF + 4);
            const f32x4 ga0 = *(const f32x4*)(gam + col0 + bj * HALF), ga1 = *(const f32x4*)(gam + col0 + bj * HALF + 4);
            const f32x4 be0 = *(const f32x4*)(bet + col0 + bj * HALF), be1 = *(const f32x4*)(bet + col0 + bj * HALF + 4);
            u32x4 xin[2][4];
            if (bj == 1) {
#pragma unroll
                for (int ai = 0; ai < 2; ++ai)
#pragma unroll
                    for (int m = 0; m < 4; ++m) xin[ai][m] = *(const u32x4*)(src + (size_t)(row0 + ai * HALF + m * 16) * D + col0 + bj * HALF); }
#pragma unroll
            for (int ai = 0; ai < 2; ++ai) {
                if (bj == 0) {
#pragma unroll
                    for (int m = 0; m < 4; ++m) xin[ai][m] = *(const u32x4*)(src + (size_t)(row0 + ai * HALF + m * 16) * D + col0 + bj * HALF); }
#pragma unroll
                for (int m = 0; m < 4; ++m) { const size_t off = (size_t)(row0 + ai * HALF + m * 16) * D + col0 + bj * HALF;
                    const u32x4 xw = xin[ai][m]; const float r = rs[ai][m][0], mr = rs[ai][m][1];
                    const f32x4 x0 = {bf_lo(xw.x), bf_hi(xw.x), bf_lo(xw.y), bf_hi(xw.y)}, x1 = {bf_lo(xw.z), bf_hi(xw.z), bf_lo(xw.w), bf_hi(xw.w)};
                    const f32x4 v0 = (x0 * r - mr) * ga0 + be0 + g0 * acc[ai][bj][m][0], v1 = (x1 * r - mr) * ga1 + be1 + g1 * acc[ai][bj][m][1];
                    u32x4 w; w.x = cvt_pk_bf16(v0[0], v0[1]); w.y = cvt_pk_bf16(v0[2], v0[3]); w.z = cvt_pk_bf16(v1[0], v1[1]); w.w = cvt_pk_bf16(v1[2], v1[3]);
                    *(u32x4*)(out + off) = w; } }
        }
    }
};
struct EpiSwiglu {
    static constexpr bool PERM = true, AFTER_DRAIN = false;
    bf16_t* act;
    __device__ __forceinline__ void operator()(const f32x4 (&acc)[2][2][4][2], const Unit& u, int wr, int wc, int fr, int fq) const {
        const int row0 = u.pm * BM + wr * 64 + fr, col0 = u.pn * HALF + wc * 32 + 8 * fq;
#pragma unroll
        for (int ai = 0; ai < 2; ++ai)
#pragma unroll
            for (int m = 0; m < 4; ++m) { const int row = row0 + ai * HALF + m * 16;
                f32x4 r0, r1;
#pragma unroll
                for (int e = 0; e < 4; ++e) { const float g0 = acc[ai][0][m][0][e], g1 = acc[ai][0][m][1][e];
                    r0[e] = g0 * sigm(g0) * acc[ai][1][m][0][e]; r1[e] = g1 * sigm(g1) * acc[ai][1][m][1][e]; }
                u32x4 w; w.x = cvt_pk_bf16(r0[0], r0[1]); w.y = cvt_pk_bf16(r0[2], r0[3]); w.z = cvt_pk_bf16(r1[0], r1[1]); w.w = cvt_pk_bf16(r1[2], r1[3]);
                *(u32x4*)(act + (size_t)row * FF + col0) = w; }
    }
};

template <class Epi, class Sched, bool ALIGN_EPI = false, bool SP2 = false, bool HOOK = false>
__device__ __forceinline__ void gemm_phase(PG8_LAS unsigned char* lds, const Gemm g, const Sched& S, const Epi& E, const int tid) {
    const int wid = __builtin_amdgcn_readfirstlane(tid >> 6), lane = tid & 63, wr = wid >> 2, wc = wid & 3, fr = lane & 15, fq = lane >> 4;
    const int K = g.K, nt = K / BK;
    unsigned voffA[2], voffB[2];
#pragma unroll
    for (int i = 0; i < 2; ++i) { int R, C; stage_rc(tid * 16 + i * 8192, R, C); const int Rb = Epi::PERM ? ((R & ~31) + perm32(R & 31)) : R;
        voffA[i] = (unsigned)(R * K + C) * 2u; voffB[i] = (unsigned)(Rb * K + C) * 2u; }
    const size_t kstep = (size_t)(BK * 2);
    const size_t hstep = (size_t)HALF * K * 2;
    const size_t tstep = 2 * hstep;
    const unsigned ldsw = (unsigned)wid * 1024u;
    const int aoff = lds_byte(wr * 64 + fr, fq * 8), boff = lds_byte(wc * 32 + fr, fq * 8);
#define PG8_SA(b, h) (((b) * 2 + (h)) * HTB)
#define PG8_SB(b, h) ((4 + (b) * 2 + (h)) * HTB)
#define PG8_STAGE(bufoff, gbase, voff) do { _Pragma("unroll") for (int _i = 0; _i < 2; ++_i) \
        __builtin_amdgcn_global_load_lds((const unsigned*)((const char*)(gbase) + (voff)[_i]), (PG8_LAS unsigned*)(lds + (bufoff) + ldsw + _i * 8192), 16, 0, 0); } while (0)
#define PG8_LDA(dst, b, h) do { _Pragma("unroll") for (int m = 0; m < 4; ++m) _Pragma("unroll") for (int k = 0; k < 2; ++k) dst[m][k] = *(const PG8_LAS bf16x8*)(lds + PG8_SA(b, h) + aoff + m * 2048 + k * 1024); } while (0)
#define PG8_LDB(dst, b, h) do { _Pragma("unroll") for (int n = 0; n < 2; ++n) _Pragma("unroll") for (int k = 0; k < 2; ++k) dst[n][k] = *(const PG8_LAS bf16x8*)(lds + PG8_SB(b, h) + boff + n * 2048 + k * 1024); } while (0)
#define PG8_MMA(ai, bj, At, Bt) do { __builtin_amdgcn_s_setprio(1); _Pragma("unroll") for (int m = 0; m < 4; ++m) _Pragma("unroll") for (int n = 0; n < 2; ++n) _Pragma("unroll") for (int k = 0; k < 2; ++k) \
        acc[ai][bj][m][n] = __builtin_amdgcn_mfma_f32_16x16x32_f16(__builtin_bit_cast(h16x8, Bt[n][k]), __builtin_bit_cast(h16x8, At[m][k]), acc[ai][bj][m][n], 0, 0, 0); __builtin_amdgcn_s_setprio(0); } while (0)
#define PG8_WAIT_V(n) asm volatile("s_waitcnt vmcnt(" #n ")" ::: "memory")
#define PG8_WAIT_L(n) asm volatile("s_waitcnt lgkmcnt(" #n ")" ::: "memory")
#define PG8_BAR __builtin_amdgcn_s_barrier()
#define PG8_SCHED __builtin_amdgcn_sched_barrier(0)
    Unit cur, nxt; int ui = 0;
    if (!S.next(0, cur)) return;
    f32x4 acc[2][2][4][2];
#pragma unroll
    for (int a = 0; a < 2; ++a)
#pragma unroll
        for (int b = 0; b < 2; ++b)
#pragma unroll
            for (int m = 0; m < 4; ++m)
#pragma unroll
                for (int n = 0; n < 2; ++n) acc[a][b][m][n] = (f32x4){0.f, 0.f, 0.f, 0.f};
    bf16x8 At[4][2], B0[2][2], B1[2][2];
    const char* cA = (const char*)g.A + (size_t)cur.pm * tstep; const char* cB = (const char*)g.Bt + (size_t)cur.pn * tstep;
    S.a_ready(cur);
    if constexpr (SP2) {
        PG8_STAGE(PG8_SB(0, 0), cB, voffB); PG8_STAGE(PG8_SB(0, 1), cB + hstep, voffB); PG8_STAGE(PG8_SA(0, 0), cA, voffA); PG8_STAGE(PG8_SA(0, 1), cA + hstep, voffA);
        PG8_STAGE(PG8_SB(1, 0), cB + kstep, voffB); PG8_STAGE(PG8_SA(1, 0), cA + kstep, voffA); PG8_STAGE(PG8_SB(1, 1), cB + hstep + kstep, voffB);
        if (wr == 1) PG8_BAR;
        PG8_WAIT_V(8); PG8_BAR;
        PG8_WAIT_V(6); PG8_BAR;
    } else {
        PG8_STAGE(PG8_SB(0, 0), cB, voffB); PG8_STAGE(PG8_SA(0, 0), cA, voffA); PG8_STAGE(PG8_SB(0, 1), cB + hstep, voffB); PG8_STAGE(PG8_SA(0, 1), cA + hstep, voffA);
        if (wr == 1) PG8_BAR;
        PG8_WAIT_V(4); PG8_BAR;
        PG8_STAGE(PG8_SB(1, 0), cB + kstep, voffB); PG8_STAGE(PG8_SA(1, 0), cA + kstep, voffA); PG8_STAGE(PG8_SB(1, 1), cB + hstep + kstep, voffB);
        PG8_WAIT_V(6); PG8_BAR;
    }
    for (;;) {
        const bool has_next = S.next(ui + 1, nxt);
        const char* nA = has_next ? (const char*)g.A + (size_t)nxt.pm * tstep : cA; const char* nB = has_next ? (const char*)g.Bt + (size_t)nxt.pn * tstep : cB;
        for (int t = 0; t < nt; t += 2) {
            if constexpr (HOOK) { if (t == 8 || t == 16) E.mid(acc, cur, (t >> 3) - 1, wr, wc, fr, fq); }
            const bool last = (t == nt - 2);
            const char* a1 = cA + (size_t)(t + 1) * kstep;
            const char* a2 = last ? nA : cA + (size_t)(t + 2) * kstep; const char* b2 = last ? nB : cB + (size_t)(t + 2) * kstep;
            const char* a3 = a2 + kstep; const char* b3 = b2 + kstep;
            if (last && has_next) S.a_ready(nxt);
            if constexpr (SP2) {
            PG8_LDB(B0, 0, 0); PG8_LDB(B1, 0, 1); PG8_SCHED; PG8_LDA(At, 0, 0); PG8_STAGE(PG8_SA(1, 1), a1 + hstep, voffA);
            PG8_WAIT_V(8); PG8_WAIT_L(0); PG8_BAR; PG8_MMA(0, 0, At, B0); PG8_MMA(0, 1, At, B1); PG8_BAR; PG8_SCHED;
            PG8_LDA(At, 0, 1); PG8_STAGE(PG8_SB(0, 0), b2, voffB); PG8_STAGE(PG8_SB(0, 1), b2 + hstep, voffB); PG8_STAGE(PG8_SA(0, 0), a2, voffA);
            PG8_WAIT_V(8); PG8_WAIT_L(0); PG8_BAR; PG8_MMA(1, 0, At, B0); PG8_MMA(1, 1, At, B1); PG8_BAR; PG8_SCHED;
            PG8_LDB(B0, 1, 0); PG8_LDB(B1, 1, 1); PG8_SCHED; PG8_LDA(At, 1, 0); PG8_STAGE(PG8_SA(0, 1), a2 + hstep, voffA);
            PG8_WAIT_V(8); PG8_WAIT_L(0); PG8_BAR; PG8_MMA(0, 0, At, B0); PG8_MMA(0, 1, At, B1); PG8_BAR; PG8_SCHED;
            PG8_LDA(At, 1, 1); PG8_STAGE(PG8_SB(1, 0), b3, voffB); PG8_STAGE(PG8_SB(1, 1), b3 + hstep, voffB); PG8_STAGE(PG8_SA(1, 0), a3, voffA);
            PG8_WAIT_V(8); PG8_WAIT_L(0); PG8_BAR; PG8_MMA(1, 0, At, B0); PG8_MMA(1, 1, At, B1); PG8_BAR; PG8_SCHED;
            } else {
            PG8_LDB(B0, 0, 0); PG8_SCHED; PG8_LDA(At, 0, 0); PG8_STAGE(PG8_SA(1, 1), a1 + hstep, voffA);
            PG8_WAIT_L(8); PG8_BAR; PG8_WAIT_L(0); PG8_MMA(0, 0, At, B0); PG8_BAR; PG8_SCHED;
            PG8_LDB(B1, 0, 1); PG8_STAGE(PG8_SB(0, 0), b2, voffB);
            PG8_BAR; PG8_WAIT_L(0); PG8_MMA(0, 1, At, B1); PG8_BAR;
            PG8_LDA(At, 0, 1); PG8_STAGE(PG8_SA(0, 0), a2, voffA);
            PG8_BAR; PG8_WAIT_L(0); PG8_MMA(1, 0, At, B0); PG8_BAR; PG8_SCHED;
            PG8_STAGE(PG8_SB(0, 1), b2 + hstep, voffB);
            PG8_WAIT_V(6); PG8_BAR; PG8_MMA(1, 1, At, B1); PG8_BAR;
            PG8_LDB(B0, 1, 0); PG8_SCHED; PG8_LDA(At, 1, 0); PG8_STAGE(PG8_SA(0, 1), a2 + hstep, voffA);
            PG8_WAIT_L(8); PG8_BAR; PG8_WAIT_L(0); PG8_MMA(0, 0, At, B0); PG8_BAR; PG8_SCHED;
            PG8_LDB(B1, 1, 1); PG8_STAGE(PG8_SB(1, 0), b3, voffB);
            PG8_BAR; PG8_WAIT_L(0); PG8_MMA(0, 1, At, B1); PG8_BAR;
            PG8_LDA(At, 1, 1); PG8_STAGE(PG8_SA(1, 0), a3, voffA);
            PG8_BAR; PG8_WAIT_L(0); PG8_MMA(1, 0, At, B0); PG8_BAR; PG8_SCHED;
            PG8_STAGE(PG8_SB(1, 1), b3 + hstep, voffB);
            PG8_WAIT_V(6); PG8_BAR; PG8_MMA(1, 1, At, B1); PG8_BAR;
            }
        }
        if constexpr (ALIGN_EPI) { if (wr == 0) PG8_BAR; }
        if constexpr (!Epi::AFTER_DRAIN) { E(acc, cur, wr, wc, fr, fq); S.done(cur); }
        if (!has_next) break;
#pragma unroll
        for (int a = 0; a < 2; ++a)
#pragma unroll
            for (int b = 0; b < 2; ++b)
#pragma unroll
                for (int m = 0; m < 4; ++m)
#pragma unroll
                    for (int n = 0; n < 2; ++n) acc[a][b][m][n] = (f32x4){0.f, 0.f, 0.f, 0.f};
        cur = nxt; cA = nA; cB = nB; ++ui;
        if constexpr (ALIGN_EPI) { if (wr == 1) PG8_BAR; }
    }
    PG8_WAIT_V(0);
    if constexpr (!ALIGN_EPI) { if (wr == 0) PG8_BAR; }
    PG8_BAR;
    if constexpr (Epi::AFTER_DRAIN) { E.fused(acc, cur, wr, wc, fr, fq, lds, wid, lane); S.done(cur); }
#undef PG8_SA
#undef PG8_SB
#undef PG8_STAGE
#undef PG8_LDA
#undef PG8_LDB
#undef PG8_MMA
#undef PG8_WAIT_V
#undef PG8_WAIT_L
#undef PG8_BAR
#undef PG8_SCHED
}
}

#define GAS __attribute__((address_space(1)))
#define LAS __attribute__((address_space(3)))
typedef unsigned short bf16;
typedef unsigned v4u __attribute__((ext_vector_type(4)));
typedef float f32x4 __attribute__((ext_vector_type(4)));
typedef short bf16x8 __attribute__((ext_vector_type(8)));
typedef GAS unsigned gu32;
typedef GAS unsigned long long gu64;
#define RLX_AGENT __ATOMIC_RELAXED, __HIP_MEMORY_SCOPE_AGENT
#define LDS_WAIT() asm volatile("s_waitcnt lgkmcnt(0)" ::: "memory")
#define VM_WAIT() asm volatile("s_waitcnt vmcnt(0)" ::: "memory")
__device__ __forceinline__ unsigned long long rt() { return __builtin_amdgcn_s_memrealtime(); }
__device__ __forceinline__ unsigned f2bf(float f) { unsigned u = __builtin_bit_cast(unsigned, f); return (u + 0x7fffu + ((u >> 16) & 1u)) >> 16; }
__device__ __forceinline__ unsigned pk2(float lo, float hi) { return f2bf(lo) | (f2bf(hi) << 16); }

#define XB_TMO      128
#define XB_XCNT(j)  (256  + 64 * (j))
#define XB_XSUB(j)  (1280 + 64 * (j))
#define XB_XGEN(j)  (2304 + 64 * (j))
#define XB_TOP      3328
#define XB_TOPGEN   3392
#define XCD_BAR_WORDS 3456
#define XB_SPIN_CAP (1u << 18)

__device__ __forceinline__ unsigned xb_ld(unsigned* p)              { return __hip_atomic_load(p, __ATOMIC_RELAXED, __HIP_MEMORY_SCOPE_AGENT); }
__device__ __forceinline__ unsigned xb_add(unsigned* p, unsigned v) { return __hip_atomic_fetch_add(p, v, __ATOMIC_RELAXED, __HIP_MEMORY_SCOPE_AGENT); }
__device__ __forceinline__ unsigned xb_xcc_id() { return (unsigned)__builtin_amdgcn_s_getreg((3 << 11) | 20) & 0xFu; }
#define XB_SPIN(cond, bar) do { unsigned _sp = 0; while (cond) { __builtin_amdgcn_s_sleep(1); \
    if ((++_sp & 255u) == 0u) { if (xb_ld(&(bar)[XB_TMO])) break; if (_sp > XB_SPIN_CAP) { atomicAdd(&(bar)[XB_TMO], 1u); break; } } } } while (0)

struct XcdBarrier {
    unsigned* bar; unsigned x;
    volatile LAS unsigned* st;
};

__device__ __forceinline__ XcdBarrier xcd_barrier_post(unsigned* bar, volatile LAS unsigned* st) {
    XcdBarrier b; b.bar = bar; b.x = xb_xcc_id(); b.st = st;
    if (threadIdx.x == 0) (void)xb_add(&bar[XB_XCNT(b.x)], 1u);
    return b;
}
__device__ __forceinline__ void xcd_barrier_complete(unsigned* bar, unsigned x, unsigned& nloc, unsigned& nx) {
    const unsigned G = gridDim.x * gridDim.y * gridDim.z;
    unsigned sum, cnt, mine, sp = 0u;
    for (;;) {
        sum = 0u; cnt = 0u; mine = 0u;
#pragma unroll
        for (unsigned j = 0; j < 16; ++j) { const unsigned c = xb_ld(&bar[XB_XCNT(j)]); sum += c; cnt += (c > 0u) ? 1u : 0u; mine = (j == x) ? c : mine; }
        if (sum == G) break;
        __builtin_amdgcn_s_sleep(1);
        if ((++sp & 255u) == 0u) { if (xb_ld(&bar[XB_TMO])) break; if (sp > XB_SPIN_CAP) { atomicAdd(&bar[XB_TMO], 1u); break; } }
    }
    nloc = mine > 0u ? mine : 1u; nx = cnt > 0u ? cnt : 1u;
}

__device__ __forceinline__ void xcd_barrier(const XcdBarrier& b) {
    asm volatile("s_waitcnt vmcnt(0)" ::: "memory");
    __syncthreads();
    if (threadIdx.x == 0) {
        unsigned* bar = b.bar;
        __builtin_amdgcn_s_waitcnt(0);
        unsigned nloc = b.st[0], nx = b.st[1];
        if (nloc == 0u) { xcd_barrier_complete(bar, b.x, nloc, nx); b.st[0] = nloc; b.st[1] = nx; }
        const unsigned old = xb_add(&bar[XB_XSUB(b.x)], 1u);
        const unsigned gen = old / nloc;
        if (old + 1u == (gen + 1u) * nloc) {
            __builtin_amdgcn_fence(__ATOMIC_RELEASE, "agent");
            asm volatile("s_waitcnt vmcnt(0)" ::: "memory");
            const unsigned og = xb_add(&bar[XB_TOP], 1u);
            const unsigned tg = og / nx;
            if (og + 1u == (tg + 1u) * nx) xb_add(&bar[XB_TOPGEN], 1u);
            else XB_SPIN(xb_ld(&bar[XB_TOPGEN]) == tg, bar);
            __builtin_amdgcn_fence(__ATOMIC_ACQUIRE, "agent");
            xb_add(&bar[XB_XGEN(b.x)], 1u);
            asm volatile("s_waitcnt vmcnt(0)" ::: "memory");
        } else {
            XB_SPIN(xb_ld(&bar[XB_XGEN(b.x)]) == gen, bar);
            __builtin_amdgcn_fence(__ATOMIC_ACQUIRE, "agent");
            asm volatile("s_waitcnt vmcnt(0)" ::: "memory");
        }
    }
    __syncthreads();
}

constexpr float DN_ALPHA = 1.681792830507429f;
constexpr size_t MiB = 1u << 20;
constexpr size_t WS_CTL = 0, CTL_ZERO_BYTES = 1 * MiB;
constexpr size_t WS_MOD = 1 * MiB;
constexpr size_t WS_LAM = 2 * MiB, WS_ROPE = 2 * MiB + 4096, WS_W2T = 2 * MiB + 65536, WS_A2T = WS_W2T + 524288, WS_G2T = WS_A2T + 524288;
constexpr size_t WS_CKNA = 4 * MiB, WS_CVNA = 8 * MiB, WS_CKDF = 12 * MiB, WS_CVDF = 16 * MiB;
constexpr size_t WS_WIN = 20 * MiB, WS_WBR = 196 * MiB, WS_WO = 220 * MiB, WS_WFI = 252 * MiB, WS_WFO = 428 * MiB;
constexpr size_t WS_H = 516 * MiB;
constexpr size_t WS_F = 548 * MiB;
constexpr size_t WS_O3 = 724 * MiB;
constexpr size_t WS_MBUF = 748 * MiB;
constexpr size_t WS_MERGED = 812 * MiB;
constexpr size_t WS_X = 844 * MiB;
constexpr size_t WS_ST1 = 876 * MiB, WS_ST2 = 877 * MiB;
constexpr size_t WS_GB = 878 * MiB;
constexpr size_t WS_GF = 920 * MiB;
constexpr size_t WS_SI = 908 * MiB;
constexpr size_t WS_Y = 1100 * MiB;
constexpr size_t WS_G = 1132 * MiB;
constexpr size_t WS_BON = 1148 * MiB;
constexpr size_t WS_QR = 1149 * MiB, WS_KR = 1153 * MiB;
constexpr size_t WS_END = 1245 * MiB;
constexpr int CW_BAR = 4096, CW_MIXQ = 16384, CW_RB = 32768, CW_PREQ = 49152;

constexpr int RING_BYTES = 131072, MISC_OFF = RING_BYTES + 320, LDS_BYTES = 147456;
constexpr int NWAVES = 8;

struct Args { const float* in[35]; float* out; unsigned char* ws; int l_lo, l_hi, ph_lo, ph_hi; };
#define CAS __attribute__((address_space(4)))
typedef const CAS Args& ArgsRef;

typedef unsigned v2u __attribute__((ext_vector_type(2)));
typedef short s16x4 __attribute__((ext_vector_type(4)));
typedef short v4i16_t __attribute__((ext_vector_type(4)));
using pg8::cvt_pk_bf16; using pg8::bf_lo; using pg8::bf_hi; using pg8::sigm;

__device__ __forceinline__ bf16 f2h(float v) { return __builtin_bit_cast(unsigned short, (_Float16)v); }
template <int CTRL> __device__ __forceinline__ float dpp(float x) { return __builtin_bit_cast(float, __builtin_amdgcn_mov_dpp(__builtin_bit_cast(int, x), CTRL, 0xf, 0xf, true)); }
template <int CTRL> __device__ __forceinline__ float dppf(float x) { return __builtin_bit_cast(float, __builtin_amdgcn_update_dpp(0x3f800000, __builtin_bit_cast(int, x), CTRL, 0xf, 0xf, false)); }
__device__ __forceinline__ float red8(float x) { x += dpp<0xB1>(x); x += dpp<0x4E>(x); x += dpp<0x141>(x); return x; }
__device__ __forceinline__ float xrow16_max(float x) { x = fmaxf(x, __shfl_xor(x, 16)); x = fmaxf(x, __shfl_xor(x, 32)); return x; }
__device__ __forceinline__ float xrow16_sum(float x) { x += __shfl_xor(x, 16); x += __shfl_xor(x, 32); return x; }
__device__ __forceinline__ float wave_sum(float v) {
    v += dpp<0xB1>(v); v += dpp<0x4E>(v); v += dpp<0x141>(v); v += dpp<0x128>(v);
    return xrow16_sum(v);
}
__device__ __forceinline__ s16x4 vtr(const LAS unsigned char* p) { return __builtin_bit_cast(s16x4, __builtin_amdgcn_ds_read_tr16_b64_v4i16((LAS v4i16_t*)p)); }
__device__ __forceinline__ f32x4 mfma16(bf16x8 a, bf16x8 b, f32x4 c) { return __builtin_amdgcn_mfma_f32_16x16x32_f16(__builtin_bit_cast(pg8::h16x8, a), __builtin_bit_cast(pg8::h16x8, b), c, 0, 0, 0); }

__device__ __forceinline__ void phase_ada(ArgsRef a, unsigned char* ws, LAS unsigned char* lds, int tid, int bid, int G) {
    LAS float* sc = (LAS float*)lds;
    LAS float* red = sc + 5 * 2048;
    const float* cvec = a.in[8]; const float* cctx = a.in[9];
    for (int i = tid; i < 5 * 2048; i += 512) { const int c = i >> 11, k = i & 2047; const float v = c == 0 ? cctx[k] : cvec[(c - 1) * 2048 + k]; sc[i] = v / (1.0f + expf(-v)); }
    __syncthreads();
    const int wave = tid >> 6, lane = tid & 63;
    float* MOD = (float*)(ws + WS_MOD);
    for (int unit = bid; unit < NL * 96; unit += G) {
        const int l = unit / 96, n0 = (unit % 96) * 128;
        const float* W = a.in[10] + (size_t)l * 2048 * 12288 + n0 + 2 * lane;
        float acc[5][2];
#pragma unroll
        for (int c = 0; c < 5; ++c) { acc[c][0] = 0.f; acc[c][1] = 0.f; }
        const int k0 = wave * 256;
        for (int kk = 0; kk < 256; kk += 8) {
            pg8::f32x2 w[8];
#pragma unroll
            for (int j = 0; j < 8; ++j) w[j] = *(const pg8::f32x2*)(W + (size_t)(k0 + kk + j) * 12288);
#pragma unroll
            for (int j = 0; j < 8; ++j)
#pragma unroll
                for (int c = 0; c < 5; ++c) { const float s = sc[c * 2048 + k0 + kk + j]; acc[c][0] += s * w[j].x; acc[c][1] += s * w[j].y; }
        }
#pragma unroll
        for (int c = 0; c < 5; ++c) { red[(wave * 5 + c) * 128 + 2 * lane] = acc[c][0]; red[(wave * 5 + c) * 128 + 2 * lane + 1] = acc[c][1]; }
        __syncthreads();
        for (int i = tid; i < 5 * 128; i += 512) { const int c = i >> 7, n = i & 127; float s = 0.f;
#pragma unroll
            for (int w = 0; w < 8; ++w) s += red[(w * 5 + c) * 128 + n];
            MOD[((size_t)l * 5 + c) * 12288 + n0 + n] = s + a.in[11][(size_t)l * 12288 + n0 + n]; }
        __syncthreads();
    }
}

__device__ __forceinline__ void transpose_item(const float* W, int K, int N, bf16* WT, int k0, int n0, int drow0, LAS float* scr, int lane, int ldk = 0) {
    if (ldk == 0) ldk = K;
    { f32x4 r[8];
#pragma unroll
      for (int i = 0; i < 8; ++i) r[i] = *(const f32x4*)(W + (size_t)(k0 + 8 * i + (lane >> 3)) * N + n0 + 4 * (lane & 7));
#pragma unroll
      for (int i = 0; i < 8; ++i) { LAS float* d = scr + (8 * i + (lane >> 3)) * 33 + 4 * (lane & 7); d[0] = r[i][0]; d[1] = r[i][1]; d[2] = r[i][2]; d[3] = r[i][3]; } }
    LDS_WAIT(); asm volatile("" ::: "memory");
    const int c = lane & 7;
#pragma unroll
    for (int j = 0; j < 4; ++j) { const int n = (lane >> 3) + 8 * j; const LAS float* s = scr + (8 * c) * 33 + n;
        v4u o; o.x = cvt_pk_bf16(s[0 * 33], s[1 * 33]); o.y = cvt_pk_bf16(s[2 * 33], s[3 * 33]); o.z = cvt_pk_bf16(s[4 * 33], s[5 * 33]); o.w = cvt_pk_bf16(s[6 * 33], s[7 * 33]);
        *(v4u*)(WT + (size_t)(drow0 + n) * ldk + k0 + 8 * c) = o; }
    LDS_WAIT(); asm volatile("" ::: "memory");
}
constexpr int IT_WIN = 32 * 348, IT_WBR = 3 * 8 * 64, IT_WO = 32 * 64, IT_WFI = 32 * 352, IT_WFO = 88 * 64, IT_LAYER = IT_WIN + IT_WBR + IT_WO + IT_WFI + IT_WFO;
__device__ __forceinline__ void phase_cvt(ArgsRef a, unsigned char* ws, LAS unsigned char* lds, int tid, int bid, int G) {
    const int wave = tid >> 6, lane = tid & 63;
    LAS float* scr = (LAS float*)(lds + wave * 16384);
    const int gw = bid * NWAVES + wave, NGW = G * NWAVES;
    constexpr int IT_ALL = NL * IT_LAYER, IT_EVEN = 56 * 2048;
    const bool skew = (G == 256);
    for (int it = gw, st2 = 0; ; ) {
        if (!skew) { if (it >= IT_ALL) break; }
        else if (!st2) { if (it >= IT_EVEN) { st2 = 1; if (bid < 128) break; it = IT_EVEN + (gw - 1024); continue; } }
        else if (it >= IT_ALL) break;
        const int it_next = it + ((skew && st2) ? 1024 : NGW);
        const int l = it / IT_LAYER; int r = it - l * IT_LAYER;
        if (r < IT_WIN) { const int kb = r / 348, nb = r - kb * 348, n0 = 32 * nb;
            transpose_item(a.in[12] + (size_t)l * D * NIN, D, NIN, (bf16*)(ws + WS_WIN) + (size_t)l * NINP * D, 64 * kb, n0, n0 + (n0 >= 4992 ? 128 : 0), scr, lane); it = it_next; continue; }
        r -= IT_WIN;
        if (r < IT_WBR) { const int i = r >> 9, rr = r & 511, kb = rr >> 6, nb = rr & 63;
            transpose_item(a.in[27] + (size_t)(l * 3 + i) * 512 * D, 512, D, (bf16*)(ws + WS_WBR) + (size_t)l * D * 1536 + i * 512, 64 * kb, 32 * nb, 32 * nb, scr, lane, 1536); it = it_next; continue; }
        r -= IT_WBR;
        if (r < IT_WO) { const int kb = r >> 6, nb = r & 63;
            transpose_item(a.in[28] + (size_t)l * D * D, D, D, (bf16*)(ws + WS_WO) + (size_t)l * D * D, 64 * kb, 32 * nb, 32 * nb, scr, lane); it = it_next; continue; }
        r -= IT_WO;
        if (r < IT_WFI) { const int kb = r / 352, nb = r - kb * 352, n0 = 32 * nb;
            const int dr = n0 < FF ? (n0 >> 7) * 256 + (n0 & 127) : ((n0 - FF) >> 7) * 256 + 128 + ((n0 - FF) & 127);
            transpose_item(a.in[31] + (size_t)l * D * NFI, D, NFI, (bf16*)(ws + WS_WFI) + (size_t)l * NFI * D, 64 * kb, n0, dr, scr, lane); it = it_next; continue; }
        r -= IT_WFI;
        { const int kb = r >> 6, nb = r & 63;
            transpose_item(a.in[32] + (size_t)l * FF * D, FF, D, (bf16*)(ws + WS_WFO) + (size_t)l * D * FF, 64 * kb, 32 * nb, 32 * nb, scr, lane); }
        it = it_next;
    }
    const int gt = bid * 512 + tid, NGT = G * 512;
    for (int i = gt; i < 4 * 262144; i += NGT) { const int t = i >> 18, e = (i & 262143) * 8;
        const float* src = a.in[2 + t] + e; const f32x4 x0 = *(const f32x4*)src, x1 = *(const f32x4*)(src + 4);
        v4u o; o.x = cvt_pk_bf16(x0[0], x0[1]); o.y = cvt_pk_bf16(x0[2], x0[3]); o.z = cvt_pk_bf16(x1[0], x1[1]); o.w = cvt_pk_bf16(x1[2], x1[3]);
        *(v4u*)((bf16*)(ws + WS_CKNA + (size_t)t * 4 * MiB) + e) = o; }
    for (int i = gt; i < 3 * 262144; i += NGT) { const int t = i >> 18, e = i & 262143;
        if (t < 2) { const int j = e & 63, c = (e >> 6) & 511, ld = e >> 15;
            const float v = a.in[t == 0 ? 18 : 20][((size_t)ld * 64 + j) * 512 + c];
            ((bf16*)(ws + (t == 0 ? WS_W2T : WS_A2T)))[e] = f2h(v); }
        else { const int j = e & 127, c = (e >> 7) & 511, l = e >> 16;
            ((bf16*)(ws + WS_G2T))[e] = f2h(a.in[21][((size_t)l * 128 + j) * 512 + c]); } }
    for (int i = gt; i < 64 * 16; i += NGT) { const int pos = i >> 4, f = i & 15; const float inv = powf(10000.0f, -(float)f / 16.0f); const float ang = (float)pos * inv;
        float* rp = (float*)(ws + WS_ROPE) + 2 * i; rp[0] = cosf(ang); rp[1] = sinf(ang); }
    for (int i = gt; i < 9 * D; i += NGT) { const int k = i / D, c = i - k * D; float gv = 1.f, bv = 0.f;
        if (k > 0) { const int l = (k - 1) >> 1; if ((k - 1) & 1) { gv = a.in[33][l * D + c]; bv = a.in[34][l * D + c]; } else { gv = a.in[29][l * D + c]; bv = a.in[30][l * D + c]; } }
        float* gb = (float*)(ws + WS_GB) + (size_t)k * 2 * D; gb[c] = DN_ALPHA * gv; gb[D + c] = DN_ALPHA * bv; }
    if (gw < NL) { const float* lp = a.in[14] + gw * 256; const float s1 = wave_sum(lp[lane] * lp[64 + lane]), s2 = wave_sum(lp[128 + lane] * lp[192 + lane]);
        const float li = gw == 0 ? 0.2f : gw == 1 ? 0.355509067590969f : gw == 2 ? 0.470713018343584f : 0.556058204155641f;
        if (lane == 0) ((float*)(ws + WS_LAM))[gw] = expf(s1) - expf(s2) + li; }
}
__device__ __forceinline__ float lam_init_of(int l) { return l == 0 ? 0.2f : l == 1 ? 0.355509067590969f : l == 2 ? 0.470713018343584f : 0.556058204155641f; }

template <int MODE> __device__ __forceinline__ void phase_ln(ArgsRef a, unsigned char* ws, int l, int gw, int NGW, int lane) {
    const float* MODp = (const float*)(ws + WS_MOD);
    bf16* X = (bf16*)(ws + WS_X); bf16* H = (bf16*)(ws + WS_H);
    const float* lg = MODE == 1 ? a.in[29] + l * D : a.in[33] + l * D; const float* lb = MODE == 1 ? a.in[30] + l * D : a.in[34] + l * D;
    const int ml = MODE == 2 ? l + 1 : l, mi = MODE == 1 ? 3 : 0;
    for (int row = gw; row < MT; row += NGW) {
        f32x4 v[8]; float s = 0.f;
        if (MODE == 0) { const float* src = (row < NCTX ? a.in[0] + (size_t)row * D : a.in[1] + (size_t)(row - NCTX) * D) + 8 * lane;
#pragma unroll
            for (int j = 0; j < 4; ++j) { v[2 * j] = *(const f32x4*)(src + 512 * j); v[2 * j + 1] = *(const f32x4*)(src + 512 * j + 4); } }
        else { const bf16* src = (const bf16*)(ws + WS_MBUF) + (size_t)row * D + 8 * lane;
#pragma unroll
            for (int j = 0; j < 4; ++j) { const v4u w = *(const v4u*)(src + 512 * j);
                v[2 * j] = (f32x4){bf_lo(w.x), bf_hi(w.x), bf_lo(w.y), bf_hi(w.y)}; v[2 * j + 1] = (f32x4){bf_lo(w.z), bf_hi(w.z), bf_lo(w.w), bf_hi(w.w)}; } }
#pragma unroll
        for (int j = 0; j < 8; ++j) s += (v[j][0] + v[j][1]) + (v[j][2] + v[j][3]);
        if (MODE != 0) {
            const float mean = wave_sum(s) * (1.f / D); float s2 = 0.f;
#pragma unroll
            for (int j = 0; j < 8; ++j) { v[j] = v[j] - mean; s2 += (v[j][0] * v[j][0] + v[j][1] * v[j][1]) + (v[j][2] * v[j][2] + v[j][3] * v[j][3]); }
            const float rstd = __builtin_amdgcn_rsqf(wave_sum(s2) * (1.f / D) + LN_EPS);
            if (MODE != 3 && lane == 0) *(pg8::f32x2*)((float*)(ws + (MODE == 1 ? WS_ST1 : WS_ST2)) + 2 * row) = (pg8::f32x2){rstd, mean * rstd};
            s = 0.f;
#pragma unroll
            for (int j = 0; j < 8; ++j) { const int co = 8 * lane + 512 * (j >> 1) + 4 * (j & 1); const f32x4 gg = *(const f32x4*)(lg + co), bb = *(const f32x4*)(lb + co);
                v[j] = v[j] * rstd * gg + bb; s += (v[j][0] + v[j][1]) + (v[j][2] + v[j][3]); }
        }
        if (MODE == 3) { float* xo = a.out + (size_t)row * D + 8 * lane;
#pragma unroll
            for (int j = 0; j < 4; ++j) { *(f32x4*)(xo + 512 * j) = v[2 * j]; *(f32x4*)(xo + 512 * j + 4) = v[2 * j + 1]; } }
        else if (MODE == 0) { bf16* xo = X + (size_t)row * D + 8 * lane;
#pragma unroll
            for (int j = 0; j < 4; ++j) { v4u w; w.x = cvt_pk_bf16(v[2 * j][0], v[2 * j][1]); w.y = cvt_pk_bf16(v[2 * j][2], v[2 * j][3]); w.z = cvt_pk_bf16(v[2 * j + 1][0], v[2 * j + 1][1]); w.w = cvt_pk_bf16(v[2 * j + 1][2], v[2 * j + 1][3]);
                *(v4u*)(xo + 512 * j) = w; } }
        if (MODE != 3) {
            const float mean = wave_sum(s) * (1.f / D); float s2 = 0.f;
#pragma unroll
            for (int j = 0; j < 8; ++j) { v[j] = v[j] - mean; s2 += (v[j][0] * v[j][0] + v[j][1] * v[j][1]) + (v[j][2] * v[j][2] + v[j][3] * v[j][3]); }
            const float rstd = __builtin_amdgcn_rsqf(wave_sum(s2) * (1.f / D) + LN_EPS);
            const int cidx = row < NCTX ? 0 : 1 + ((row - NCTX) >> 10);
            const float* shp = MODp + ((size_t)ml * 5 + cidx) * 12288 + mi * D; const float* scp = shp + D;
            bf16* ho = H + (size_t)row * D + 8 * lane;
#pragma unroll
            for (int j = 0; j < 4; ++j) { const int co = 8 * lane + 512 * j;
                const f32x4 h0 = v[2 * j] * rstd * (*(const f32x4*)(scp + co) + 1.0f) + *(const f32x4*)(shp + co), h1 = v[2 * j + 1] * rstd * (*(const f32x4*)(scp + co + 4) + 1.0f) + *(const f32x4*)(shp + co + 4);
                v4u w; w.x = cvt_pk_bf16(h0[0], h0[1]); w.y = cvt_pk_bf16(h0[2], h0[3]); w.z = cvt_pk_bf16(h1[0], h1[1]); w.w = cvt_pk_bf16(h1[2], h1[3]);
                *(v4u*)(ho + 512 * j) = w; }
        }
    }
}

__device__ __forceinline__ void shift8(const bf16* F, unsigned fo, bool hp, bool hn, const float* mix, unsigned mo, float (&o)[8]) {
    const v4u c = *(const v4u*)(F + fo); v4u p = {0u, 0u, 0u, 0u}, n = {0u, 0u, 0u, 0u};
    if (hp) p = *(const v4u*)(F + (fo - NINP)); if (hn) n = *(const v4u*)(F + (fo + NINP));
    const f32x4 m0a = *(const f32x4*)(mix + mo), m0b = *(const f32x4*)(mix + (mo + 4)), m1a = *(const f32x4*)(mix + (mo + 1920)), m1b = *(const f32x4*)(mix + (mo + 1924));
#pragma unroll
    for (int w = 0; w < 4; ++w) { const unsigned cw = c[w], pw = p[w], nw = n[w];
        const float f0 = bf_lo(cw), f1 = bf_hi(cw); const float m00 = w < 2 ? m0a[2 * w] : m0b[2 * w - 4], m01 = w < 2 ? m0a[2 * w + 1] : m0b[2 * w - 3];
        const float m10 = w < 2 ? m1a[2 * w] : m1b[2 * w - 4], m11 = w < 2 ? m1a[2 * w + 1] : m1b[2 * w - 3];
        o[2 * w] = f0 + m00 * (bf_lo(pw) - f0) + m10 * (bf_lo(nw) - f0); o[2 * w + 1] = f1 + m01 * (bf_hi(pw) - f1) + m11 * (bf_hi(nw) - f1); }
}
__device__ __forceinline__ f32x4 shift4(const bf16* F, unsigned fo, bool hp, bool hn, const float* mix, unsigned mo) {
    const v2u c = *(const v2u*)(F + fo); v2u p = {0u, 0u}, n = {0u, 0u};
    if (hp) p = *(const v2u*)(F + (fo - NINP)); if (hn) n = *(const v2u*)(F + (fo + NINP));
    const f32x4 m0 = *(const f32x4*)(mix + mo), m1 = *(const f32x4*)(mix + (mo + 1920));
    f32x4 f, pv, nv; f[0] = bf_lo(c.x); f[1] = bf_hi(c.x); f[2] = bf_lo(c.y); f[3] = bf_hi(c.y);
    pv[0] = bf_lo(p.x); pv[1] = bf_hi(p.x); pv[2] = bf_lo(p.y); pv[3] = bf_hi(p.y); nv[0] = bf_lo(n.x); nv[1] = bf_hi(n.x); nv[2] = bf_lo(n.y); nv[3] = bf_hi(n.y);
    return f + m0 * (pv - f) + m1 * (nv - f);
}
__device__ __forceinline__ float ftanh(float x) { return 1.0f - 2.0f * __builtin_amdgcn_rcpf(1.0f + __expf(2.0f * x)); }
__device__ __forceinline__ bf16x8 pack8(const float (&o)[8]) { v4u w; w.x = cvt_pk_bf16(o[0], o[1]); w.y = cvt_pk_bf16(o[2], o[3]); w.z = cvt_pk_bf16(o[4], o[5]); w.w = cvt_pk_bf16(o[6], o[7]); return __builtin_bit_cast(bf16x8, w); }
__device__ __forceinline__ float logsigmoid(float z) { const float e = __expf(-fabsf(z)); return fminf(z, 0.f) - __logf(1.0f + e); }

__device__ __forceinline__ void phase_pre(ArgsRef a, unsigned char* ws, int l, int gw, int NGW, int lane) {
    const bf16* F = (const bf16*)(ws + WS_F);
    const float* mix = a.in[16] + (size_t)l * 2 * 1920;
    const float* w0 = a.in[17] + l * 1024; const float* a0 = a.in[19] + l * 1024;
    const float* kkw = a.in[22] + l * 512; const float* kaw = a.in[23] + l * 512; const float* rkw = a.in[24] + l * 512;
    const bf16* W2T = (const bf16*)(ws + WS_W2T) + (size_t)l * 2 * 512 * 64; const bf16* A2T = (const bf16*)(ws + WS_A2T) + (size_t)l * 2 * 512 * 64;
    const bf16* G2T = (const bf16*)(ws + WS_G2T) + (size_t)l * 512 * 128;
    float* SI = (float*)(ws + WS_SI); float* Gb = (float*)(ws + WS_G); float* BON = (float*)(ws + WS_BON);
    for (int u = 4096 + gw; u < 4096 + 8192; u += NGW) {
        int q = lane & 15, g = lane >> 4; asm volatile("" : "+v"(q), "+v"(g));
        if (u < 4096) {
            const int tile = u >> 3, hh = u & 7, row = tile * 16 + q;
            const int T = row < NCTX ? 256 : 1024, pos = row & (T - 1); const bool hp = pos > 0, hn = pos < T - 1;
            const unsigned fo = (unsigned)row * NINP + C_RW;
            float t8[8]; f32x4 af[4], ab[4];
            const unsigned ao = (unsigned)(hh * 64 + q) * 64 + 8 * g, go = (unsigned)(hh * 64 + q) * 128 + 8 * g;
            const unsigned c40 = hh * 64 + 4 * g;
            const unsigned so = ((unsigned)hh * MT + row) * 384 + 4 * g;
#pragma unroll
            for (int d = 0; d < 2; ++d) { f32x4 acc[4];
#pragma unroll
                for (int rb = 0; rb < 4; ++rb) acc[rb] = (f32x4){0.f, 0.f, 0.f, 0.f};
#pragma unroll
                for (int ks = 0; ks < 2; ++ks) { const unsigned cb = 32 * ks + 8 * g; shift8(F, fo + 1536 + 64 * d + cb, hp, hn, mix, 1536 + 64 * d + cb, t8);
#pragma unroll
                    for (int e = 0; e < 8; ++e) t8[e] = ftanh(t8[e]);
                    const bf16x8 bop = pack8(t8);
#pragma unroll
                    for (int rb = 0; rb < 4; ++rb) acc[rb] = mfma16(*(const bf16x8*)(W2T + (ao + 32768 * d + 1024 * rb + 32 * ks)), bop, acc[rb]); }
#pragma unroll
                for (int rb = 0; rb < 4; ++rb) { const f32x4 wz = *(const f32x4*)(w0 + (512 * d + c40 + 16 * rb)); f32x4 dec;
#pragma unroll
                    for (int e = 0; e < 4; ++e) dec[e] = __expf(-__expf(logsigmoid(wz[e] + acc[rb][e]) - 0.5f));
                    *(f32x4*)(SI + (so + 8u * MT * 384u * d + 16 * rb + 64)) = dec; }
                asm volatile("" ::: "memory"); }
#pragma unroll
            for (int d = 0; d < 2; ++d) { f32x4 acc[4];
#pragma unroll
                for (int rb = 0; rb < 4; ++rb) acc[rb] = (f32x4){0.f, 0.f, 0.f, 0.f};
#pragma unroll
                for (int ks = 0; ks < 2; ++ks) { const unsigned cb = 32 * ks + 8 * g; shift8(F, fo + 1664 + 64 * d + cb, hp, hn, mix, 1664 + 64 * d + cb, t8);
                    const bf16x8 bop = pack8(t8);
#pragma unroll
                    for (int rb = 0; rb < 4; ++rb) acc[rb] = mfma16(*(const bf16x8*)(A2T + (ao + 32768 * d + 1024 * rb + 32 * ks)), bop, acc[rb]); }
#pragma unroll
                for (int rb = 0; rb < 4; ++rb) { const f32x4 az = *(const f32x4*)(a0 + (512 * d + c40 + 16 * rb));
#pragma unroll
                    for (int e = 0; e < 4; ++e) { const float v = sigm(az[e] + acc[rb][e]); if (d == 0) af[rb][e] = v; else ab[rb][e] = v; } }
                asm volatile("" ::: "memory"); }
            { f32x4 acc[4];
#pragma unroll
                for (int rb = 0; rb < 4; ++rb) acc[rb] = (f32x4){0.f, 0.f, 0.f, 0.f};
#pragma unroll
                for (int ks = 0; ks < 4; ++ks) { const unsigned cb = 32 * ks + 8 * g; shift8(F, fo + 1792 + cb, hp, hn, mix, 1792 + cb, t8);
#pragma unroll
                    for (int e = 0; e < 8; ++e) t8[e] = sigm(t8[e]);
                    const bf16x8 bop = pack8(t8);
#pragma unroll
                    for (int rb = 0; rb < 4; ++rb) acc[rb] = mfma16(*(const bf16x8*)(G2T + (go + 2048 * rb + 32 * ks)), bop, acc[rb]); }
#pragma unroll
                for (int rb = 0; rb < 4; ++rb) *(f32x4*)(Gb + ((unsigned)row * 512 + c40 + 16 * rb)) = acc[rb];
                asm volatile("" ::: "memory"); }
            float ss = 0.f;
#pragma unroll
            for (int rb = 0; rb < 4; ++rb) { const unsigned c4 = c40 + 16 * rb;
                const f32x4 kv = shift4(F, fo + 512 + c4, hp, hn, mix, 512 + c4) * *(const f32x4*)(kkw + c4); ss += (kv[0] * kv[0] + kv[1] * kv[1]) + (kv[2] * kv[2] + kv[3] * kv[3]); }
            ss = xrow16_sum(ss);
            const float kinv = __builtin_amdgcn_rcpf(fmaxf(__builtin_amdgcn_sqrtf(ss), 1e-12f));
            float bonus = 0.f;
            asm volatile("" ::: "memory");
#pragma unroll
            for (int rb = 0; rb < 4; ++rb) { const unsigned c4 = c40 + 16 * rb;
                const f32x4 rr = shift4(F, fo + c4, hp, hn, mix, c4), kh = shift4(F, fo + 512 + c4, hp, hn, mix, 512 + c4), vv = shift4(F, fo + 1024 + c4, hp, hn, mix, 1024 + c4);
                const f32x4 kkv = kh * *(const f32x4*)(kkw + c4);
                const f32x4 kav = *(const f32x4*)(kaw + c4), rkv = *(const f32x4*)(rkw + c4);
                f32x4 kdf, kdb, bf, bb, nkk;
#pragma unroll
                for (int e = 0; e < 4; ++e) {
                    kdf[e] = kh[e] * (1.0f + (af[rb][e] - 1.0f) * kav[e]); kdb[e] = kh[e] * (1.0f + (ab[rb][e] - 1.0f) * kav[e]);
                    const float kn = kkv[e] * kinv; nkk[e] = -kn; bf[e] = kn * af[rb][e]; bb[e] = kn * ab[rb][e];
                    bonus += rr[e] * rkv[e] * (kdf[e] + kdb[e]); }
                const unsigned s0 = so + 16 * rb, s1 = s0 + 8u * MT * 384u;
                *(f32x4*)(SI + s0) = rr; *(f32x4*)(SI + (s0 + 128)) = kdf; *(f32x4*)(SI + (s0 + 192)) = vv; *(f32x4*)(SI + (s0 + 256)) = nkk; *(f32x4*)(SI + (s0 + 320)) = bf;
                *(f32x4*)(SI + s1) = rr; *(f32x4*)(SI + (s1 + 128)) = kdb; *(f32x4*)(SI + (s1 + 192)) = vv; *(f32x4*)(SI + (s1 + 256)) = nkk; *(f32x4*)(SI + (s1 + 320)) = bb;
                asm volatile("" ::: "memory"); }
            bonus = xrow16_sum(bonus);
            if (g == 0) BON[(size_t)row * 8 + hh] = bonus;
        } else {
            const int v = u - 4096, lr = v >> 1, isk = v & 1;
            const bf16* src = F + (size_t)(NCTX + lr) * NINP + (isk ? C_DFK : C_DFQ) + 8 * lane;
            const v4u x = *(const v4u*)src; v4u xp; xp.x = __shfl_xor(x.x, 2); xp.y = __shfl_xor(x.y, 2); xp.z = __shfl_xor(x.z, 2); xp.w = __shfl_xor(x.w, 2);
            const int seg = lane & 7, tpos = lr & 1023, pos = seg < 4 ? (tpos >> 6) : (tpos & 63); const bool second = (seg & 2) != 0;
            const float* rp = (const float*)(ws + WS_ROPE) + ((size_t)pos * 16 + 8 * (seg & 1)) * 2;
            float o[8];
#pragma unroll
            for (int w = 0; w < 4; ++w) { const unsigned xw = x[w], pw = xp[w];
                const float c0 = rp[4 * w], s0 = rp[4 * w + 1], c1 = rp[4 * w + 2], s1 = rp[4 * w + 3];
                o[2 * w] = second ? bf_lo(xw) * c0 + bf_lo(pw) * s0 : bf_lo(xw) * c0 - bf_lo(pw) * s0;
                o[2 * w + 1] = second ? bf_hi(xw) * c1 + bf_hi(pw) * s1 : bf_hi(xw) * c1 - bf_hi(pw) * s1; }
            v4u ow; ow.x = cvt_pk_bf16(o[0], o[1]); ow.y = cvt_pk_bf16(o[2], o[3]); ow.z = cvt_pk_bf16(o[4], o[5]); ow.w = cvt_pk_bf16(o[6], o[7]);
            *(v4u*)((bf16*)(ws + (isk ? WS_KR : WS_QR)) + (size_t)lr * 512 + 8 * lane) = ow;
        }
    }
}

__device__ __forceinline__ void phase_rope(unsigned char* ws, int gw, int NGW, int lane) {
    const bf16* F = (const bf16*)(ws + WS_F); const float* ropet = (const float*)(ws + WS_ROPE);
    const int seg = lane & 7; const bool second = (seg & 2) != 0;
    for (int u0 = gw; u0 < 8192; u0 += 4 * NGW) {
        v4u x[4]; f32x4 t[4][4];
#pragma unroll
        for (int i = 0; i < 4; ++i) { const int v = u0 + i * NGW; if (v < 8192) { const int lr = v >> 1, isk = v & 1, tpos = lr & 1023, pos = seg < 4 ? (tpos >> 6) : (tpos & 63);
                x[i] = *(const v4u*)(F + (size_t)(NCTX + lr) * NINP + (isk ? C_DFK : C_DFQ) + 8 * lane);
                const float* rp = ropet + ((size_t)pos * 16 + 8 * (seg & 1)) * 2;
#pragma unroll
                for (int w = 0; w < 4; ++w) t[i][w] = *(const f32x4*)(rp + 4 * w); } }
#pragma unroll
        for (int i = 0; i < 4; ++i) { const int v = u0 + i * NGW; if (v < 8192) { const int lr = v >> 1, isk = v & 1;
                v4u xp; xp.x = __shfl_xor(x[i].x, 2); xp.y = __shfl_xor(x[i].y, 2); xp.z = __shfl_xor(x[i].z, 2); xp.w = __shfl_xor(x[i].w, 2);
                v4u ow;
#pragma unroll
                for (int w = 0; w < 4; ++w) { const unsigned xw = x[i][w], pw = xp[w]; const f32x4 cs = t[i][w];
                    const float o0 = second ? bf_lo(xw) * cs[0] + bf_lo(pw) * cs[1] : bf_lo(xw) * cs[0] - bf_lo(pw) * cs[1];
                    const float o1 = second ? bf_hi(xw) * cs[2] + bf_hi(pw) * cs[3] : bf_hi(xw) * cs[2] - bf_hi(pw) * cs[3];
                    ow[w] = cvt_pk_bf16(o0, o1); }
                *(v4u*)((bf16*)(ws + (isk ? WS_KR : WS_QR)) + (size_t)lr * 512 + 8 * lane) = ow; } }
    }
}

constexpr size_t WS_OPS = 1157 * MiB; constexpr int OPS_BLOCK = 21 * 512, N_CHUNKS = 8192;
#define IMO(i) ((((i) >> 1) * 1024) + (((i) & 1) * 8))
typedef _Float16 h16x4 __attribute__((ext_vector_type(4)));
__device__ __forceinline__ f32x4 mfma16k(v2u a, v2u b, f32x4 c) { return __builtin_amdgcn_mfma_f32_16x16x16f16(__builtin_bit_cast(h16x4, a), __builtin_bit_cast(h16x4, b), c, 0, 0, 0); }
__device__ __forceinline__ v2u pk4(f32x4 v) { v2u r; r.x = cvt_pk_bf16(v[0], v[1]); r.y = cvt_pk_bf16(v[2], v[3]); return r; }
__device__ __forceinline__ unsigned short h1(float v) { return __builtin_bit_cast(unsigned short, (_Float16)v); }
struct ChunkId { int dh, T, tokbase, c; };
__device__ __forceinline__ ChunkId chunk_decode(int cu) { ChunkId k; k.dh = cu >> 9; const int cid = cu & 511;
    if (cid < 256) { k.T = 256; k.tokbase = (cid >> 4) * 256; k.c = cid & 15; } else { k.T = 1024; k.tokbase = NCTX + ((cid - 256) >> 6) * 1024; k.c = (cid - 256) & 63; } return k; }
constexpr size_t WS_V = WS_SI;
constexpr int FT_PITCH = 3856, MX_OFF = 18 * FT_PITCH, BO_OFF = MX_OFF + 2 * 1920 * 4, PRE_LDS = BO_OFF + 12 * 1024;
static_assert(MX_OFF % 16 == 0 && PRE_LDS <= RING_BYTES, "pre-pass LDS map");
__device__ __forceinline__ void shift8_lds(const LAS unsigned char* ft  , const LAS float* mx  , float (&o)[8]) {
    const v4u c = *(const LAS v4u*)ft, p = *(const LAS v4u*)(ft - FT_PITCH), n = *(const LAS v4u*)(ft + FT_PITCH);
    const f32x4 m0a = *(const LAS f32x4*)mx, m0b = *(const LAS f32x4*)(mx + 4), m1a = *(const LAS f32x4*)(mx + 1920), m1b = *(const LAS f32x4*)(mx + 1924);
#pragma unroll
    for (int w = 0; w < 4; ++w) { const unsigned cw = c[w], pw = p[w], nw = n[w];
        const float f0 = bf_lo(cw), f1 = bf_hi(cw); const float m00 = w < 2 ? m0a[2 * w] : m0b[2 * w - 4], m01 = w < 2 ? m0a[2 * w + 1] : m0b[2 * w - 3];
        const float m10 = w < 2 ? m1a[2 * w] : m1b[2 * w - 4], m11 = w < 2 ? m1a[2 * w + 1] : m1b[2 * w - 3];
        o[2 * w] = f0 + m00 * (bf_lo(pw) - f0) + m10 * (bf_lo(nw) - f0); o[2 * w + 1] = f1 + m01 * (bf_hi(pw) - f1) + m11 * (bf_hi(nw) - f1); }
}
__device__ __forceinline__ f32x4 shift4_lds(const LAS unsigned char* ft, const LAS float* mx) {
    const v2u c = *(const LAS v2u*)ft, p = *(const LAS v2u*)(ft - FT_PITCH), n = *(const LAS v2u*)(ft + FT_PITCH);
    const f32x4 m0 = *(const LAS f32x4*)mx, m1 = *(const LAS f32x4*)(mx + 1920);
    f32x4 f, pv, nv; f[0] = bf_lo(c.x); f[1] = bf_hi(c.x); f[2] = bf_lo(c.y); f[3] = bf_hi(c.y);
    pv[0] = bf_lo(p.x); pv[1] = bf_hi(p.x); pv[2] = bf_lo(p.y); pv[3] = bf_hi(p.y); nv[0] = bf_lo(n.x); nv[1] = bf_hi(n.x); nv[2] = bf_lo(n.y); nv[3] = bf_hi(n.y);
    return f + m0 * (pv - f) + m1 * (nv - f);
}
__device__ __forceinline__ void pre_tile(ArgsRef a, unsigned char* ws, int l, int tile, LAS unsigned char* lds, int tid) {
    const bf16* F = (const bf16*)(ws + WS_F);
    const float* mix = a.in[16] + (size_t)l * 2 * 1920;
    const float* w0 = a.in[17] + l * 1024; const float* a0 = a.in[19] + l * 1024;
    const float* kkw = a.in[22] + l * 512; const float* kaw = a.in[23] + l * 512; const float* rkw = a.in[24] + l * 512;
    const bf16* W2T = (const bf16*)(ws + WS_W2T) + (size_t)l * 2 * 512 * 64; const bf16* A2T = (const bf16*)(ws + WS_A2T) + (size_t)l * 2 * 512 * 64;
    const bf16* G2T = (const bf16*)(ws + WS_G2T) + (size_t)l * 512 * 128;
    float* SI = (float*)(ws + WS_SI); float* Gb = (float*)(ws + WS_G); float* BON = (float*)(ws + WS_BON);
    const int hh = __builtin_amdgcn_readfirstlane(tid >> 6), lane = tid & 63;
    int q = lane & 15, g = lane >> 4; asm volatile("" : "+v"(q), "+v"(g));
    const int tok0 = tile * 16, T = tok0 < NCTX ? 256 : 1024, pos0 = tok0 & (T - 1);
    for (int i = tid; i < 18 * 240; i += 512) { const int r = i / 240, c = i - r * 240, pos = pos0 + r - 1;
        v4u v = {0u, 0u, 0u, 0u}; if (pos >= 0 && pos < T) v = *(const v4u*)(F + (size_t)(tok0 + r - 1) * NINP + C_RW + c * 8);
        *(LAS v4u*)(lds + r * FT_PITCH + c * 16) = v; }
    for (int i = tid; i < 960; i += 512) *(LAS f32x4*)(lds + MX_OFF + 16 * i) = *(const f32x4*)(mix + 4 * i);
    __syncthreads();
    const LAS unsigned char* ftq = lds + (q + 1) * FT_PITCH; const LAS float* mx = (const LAS float*)(lds + MX_OFF);
    float t8[8];
    for (int op = hh; op < 12; op += 8) {
        const int chb = op < 2 ? 1536 : (op < 4 ? 1600 : (op < 6 ? 1664 : (op < 8 ? 1728 : 1792))), ks = op < 8 ? (op & 1) : (op - 8), ch = chb + 32 * ks + 8 * g;
        shift8_lds(ftq + ch * 2, mx + ch, t8);
        if (op < 4) {
#pragma unroll
            for (int e = 0; e < 8; ++e) t8[e] = ftanh(t8[e]); }
        else if (op >= 8) {
#pragma unroll
            for (int e = 0; e < 8; ++e) t8[e] = sigm(t8[e]); }
        *(LAS bf16x8*)(lds + BO_OFF + op * 1024 + lane * 16) = pack8(t8);
    }
    __syncthreads();
    const LAS unsigned char* bo = lds + BO_OFF + lane * 16;
    const int row = tok0 + q;
    const unsigned ao = (unsigned)(hh * 64 + q) * 64 + 8 * g, go = (unsigned)(hh * 64 + q) * 128 + 8 * g;
    const unsigned c40 = hh * 64 + 4 * g;
    { f32x4 acc[4];
#pragma unroll
        for (int rb = 0; rb < 4; ++rb) acc[rb] = (f32x4){0.f, 0.f, 0.f, 0.f};
#pragma unroll
        for (int ks = 0; ks < 4; ++ks) { const bf16x8 bop = *(const LAS bf16x8*)(bo + (8 + ks) * 1024);
#pragma unroll
            for (int rb = 0; rb < 4; ++rb) acc[rb] = mfma16(*(const bf16x8*)(G2T + (go + 2048 * rb + 32 * ks)), bop, acc[rb]); }
#pragma unroll
        for (int rb = 0; rb < 4; ++rb) *(v2u*)((bf16*)Gb + ((unsigned)row * 512 + c40 + 16 * rb)) = pk4(acc[rb]);
        asm volatile("" ::: "memory"); }
    float ss = 0.f;
#pragma unroll
    for (int rb = 0; rb < 4; ++rb) { const unsigned c4 = c40 + 16 * rb;
        const f32x4 kv = shift4_lds(ftq + (512 + c4) * 2, mx + 512 + c4) * *(const f32x4*)(kkw + c4); ss += (kv[0] * kv[0] + kv[1] * kv[1]) + (kv[2] * kv[2] + kv[3] * kv[3]); }
    ss = xrow16_sum(ss);
    const float kinv = __builtin_amdgcn_rcpf(fmaxf(__builtin_amdgcn_sqrtf(ss), 1e-12f));
    float bonus = 0.f;
    const int tq = tile < 256 ? (tile & 15) : ((tile - 256) & 63), nct = tile < 256 ? 16 : 64, sb = tile < 256 ? (tile >> 4) : ((tile - 256) >> 6);
    const int cid_f = (tile < 256 ? sb * 16 : 256 + sb * 64) + tq, cid_b = (tile < 256 ? sb * 16 : 256 + sb * 64) + (nct - 1 - tq);
    const f32x4 z4 = {0.f, 0.f, 0.f, 0.f};
    v2u idop; { f32x4 idv;
#pragma unroll
        for (int e = 0; e < 4; ++e) idv[e] = (4 * g + e == q) ? 1.f : 0.f; idop = pk4(idv); }
#pragma unroll
    for (int d = 0; d < 2; ++d) {
        f32x4 cBe = z4, cBt = z4, cKa = z4, cRb = z4, cRk = z4;
        f32x4 decd[4], asd[4];
        { f32x4 acc[4];
#pragma unroll
          for (int rb = 0; rb < 4; ++rb) acc[rb] = z4;
#pragma unroll
          for (int ks = 0; ks < 2; ++ks) { const bf16x8 bop = *(const LAS bf16x8*)(bo + (2 * d + ks) * 1024);
#pragma unroll
              for (int rb = 0; rb < 4; ++rb) acc[rb] = mfma16(*(const bf16x8*)(W2T + (ao + 32768 * d + 1024 * rb + 32 * ks)), bop, acc[rb]); }
#pragma unroll
          for (int rb = 0; rb < 4; ++rb) { const f32x4 wz = *(const f32x4*)(w0 + (512 * d + c40 + 16 * rb));
#pragma unroll
              for (int e = 0; e < 4; ++e) decd[rb][e] = __expf(-__expf(logsigmoid(wz[e] + acc[rb][e]) - 0.5f)); }
          asm volatile("" ::: "memory");
#pragma unroll
          for (int rb = 0; rb < 4; ++rb) acc[rb] = z4;
#pragma unroll
          for (int ks = 0; ks < 2; ++ks) { const bf16x8 bop = *(const LAS bf16x8*)(bo + (4 + 2 * d + ks) * 1024);
#pragma unroll
              for (int rb = 0; rb < 4; ++rb) acc[rb] = mfma16(*(const bf16x8*)(A2T + (ao + 32768 * d + 1024 * rb + 32 * ks)), bop, acc[rb]); }
#pragma unroll
          for (int rb = 0; rb < 4; ++rb) { const f32x4 az = *(const f32x4*)(a0 + (512 * d + c40 + 16 * rb));
#pragma unroll
              for (int e = 0; e < 4; ++e) asd[rb][e] = sigm(az[e] + acc[rb][e]); }
          asm volatile("" ::: "memory"); }
        unsigned oo = (unsigned)((d * 8 + hh) * 512 + (d == 0 ? cid_f : cid_b)) * OPS_BLOCK + lane * 16;
        unsigned char* ops = ws + WS_OPS + oo;
#pragma unroll
        for (int rb = 0; rb < 4; ++rb) { const unsigned c4 = c40 + 16 * rb;
            const f32x4 rr = shift4_lds(ftq + c4 * 2, mx + c4), kh = shift4_lds(ftq + (512 + c4) * 2, mx + 512 + c4);
            const f32x4 kkv = kh * *(const f32x4*)(kkw + c4), kav = *(const f32x4*)(kaw + c4);
            const f32x4 as = asd[rb], wv = decd[rb];
            f32x4 kd, bv, nkk;
#pragma unroll
            for (int e = 0; e < 4; ++e) { kd[e] = kh[e] * (1.0f + (as[e] - 1.0f) * kav[e]); const float kn = kkv[e] * kinv; nkk[e] = -kn; bv[e] = kn * as[e]; }
            { const f32x4 rkv = *(const f32x4*)(rkw + c4);
#pragma unroll
              for (int e = 0; e < 4; ++e) bonus += rr[e] * rkv[e] * kd[e]; }
            if (d == 0) *(v2u*)((bf16*)(ws + WS_V) + ((unsigned)row * 512 + c4)) = pk4(shift4_lds(ftq + (1024 + c4) * 2, mx + 1024 + c4));
            f32x4 gi, gx, gc;
#pragma unroll
            for (int e = 0; e < 4; ++e) { float x = wv[e];
                if (d == 0) { x *= dppf<0x111>(x); x *= dppf<0x112>(x); x *= dppf<0x114>(x); x *= dppf<0x118>(x); gx[e] = dppf<0x111>(x); }
                else        { x *= dppf<0x101>(x); x *= dppf<0x102>(x); x *= dppf<0x104>(x); x *= dppf<0x108>(x); gx[e] = dppf<0x101>(x); }
                gi[e] = x; gc[e] = __shfl(x, (lane & 48) | (d == 0 ? 15 : 0)); }
            f32x4 ginv;
#pragma unroll
            for (int e = 0; e < 4; ++e) ginv[e] = __builtin_amdgcn_rcpf(gi[e]);
            const v2u aop = pk4(gx * nkk), rop = pk4(gi * rr), bop = pk4(bv * ginv), kop = pk4(kd * ginv), btop = pk4(bv * ginv * gc), ktop = pk4(kd * ginv * gc);
            { const v2u bt_ = pk4(mfma16k(btop, idop, z4)), kt_ = pk4(mfma16k(ktop, idop, z4));
              *(v4u*)(ops + rb * 1024) = (v4u){aop.x, aop.y, rop.x, rop.y}; *(v4u*)(ops + (4 + rb) * 1024) = (v4u){bt_.x, bt_.y, kt_.x, kt_.y}; }
            if (q == (d == 0 ? 15 : 0)) *(f32x4*)(ops - lane * 16 + 20 * 512 + (16 * rb + 4 * g) * 4) = gi;
            cBe = mfma16k(bop, aop, cBe); cBt = mfma16k(aop, bop, cBt); cKa = mfma16k(kop, aop, cKa); cRb = mfma16k(bop, rop, cRb); cRk = mfma16k(kop, rop, cRk);
            asm volatile("" ::: "memory"); }
        f32x4 Beta = cBe, BetaT = cBt, Kap = cKa, Rb = cRb, Rk = cRk, Id;
#pragma unroll
        for (int e = 0; e < 4; ++e) { const int rw = 4 * g + e;
            const bool jt = d == 0 ? rw < q : rw > q, tj = d == 0 ? q < rw : q > rw, je = d == 0 ? rw <= q : rw >= q;
            if (!jt) { Beta[e] = 0.f; Kap[e] = 0.f; } if (!tj) BetaT[e] = 0.f; if (!je) { Rb[e] = 0.f; Rk[e] = 0.f; }
            Id[e] = rw == q ? 1.f : 0.f; }
        const v2u kap_ = pk4(Kap), rb_ = pk4(Rb), rk_ = pk4(Rk);
        const f32x4 B2 = mfma16k(pk4(BetaT), pk4(Beta), z4), B2T = mfma16k(pk4(Beta), pk4(BetaT), z4);
        const f32x4 B4 = mfma16k(pk4(B2T), pk4(B2), z4), B4T = mfma16k(pk4(B2), pk4(B2T), z4);
        const f32x4 B8 = mfma16k(pk4(B4T), pk4(B4), z4);
        const f32x4 T1 = mfma16k(pk4(Id + BetaT), pk4(Id + B2), z4), T1T = mfma16k(pk4(Id + B2), pk4(Id + BetaT), z4);
        const f32x4 T2 = mfma16k(pk4(Id + B4T), pk4(Id + B8), z4);
        { const v2u tt_ = pk4(mfma16k(pk4(T1T), pk4(T2), z4)); *(v4u*)(ops + 8 * 1024) = (v4u){kap_.x, kap_.y, tt_.x, tt_.y}; *(v4u*)(ops + 9 * 1024) = (v4u){rb_.x, rb_.y, rk_.x, rk_.y}; }
        asm volatile("" ::: "memory"); }
    bonus = xrow16_sum(bonus);
    if (g == 0) BON[(size_t)row * 8 + hh] = bonus;
    __syncthreads();
}

__device__ __forceinline__ void phase_post(ArgsRef a, unsigned char* ws, int l, int gw, int NGW, int lane) {
    const bf16* Y = (const bf16*)(ws + WS_Y); const bf16* Gb = (const bf16*)(ws + WS_G); const bf16* Vb = (const bf16*)(ws + WS_V); const float* BON = (const float*)(ws + WS_BON);
    bf16* O3 = (bf16*)(ws + WS_O3) + 1024;
    const float* lng = a.in[25] + l * 512; const float* lnb = a.in[26] + l * 512;
    const int c = 8 * lane, hh = lane >> 3;
    for (int row0 = gw; row0 < MT; row0 += 4 * NGW) {
        v4u yfw[4], ybw[4], vw[4], gw4[4]; float bon[4];
#pragma unroll
        for (int i = 0; i < 4; ++i) { const int row = row0 + i * NGW; if (row < MT) {
            yfw[i] = *(const v4u*)(Y + (size_t)row * 512 + c); ybw[i] = *(const v4u*)(Y + (size_t)(MT + row) * 512 + c);
            vw[i] = *(const v4u*)(Vb + (size_t)row * 512 + c); gw4[i] = *(const v4u*)(Gb + (size_t)row * 512 + c); bon[i] = BON[(size_t)row * 8 + hh]; } }
#pragma unroll
        for (int i = 0; i < 4; ++i) { const int row = row0 + i * NGW; if (row < MT) {
            f32x4 y0 = {bf_lo(yfw[i].x) + bf_lo(ybw[i].x), bf_hi(yfw[i].x) + bf_hi(ybw[i].x), bf_lo(yfw[i].y) + bf_lo(ybw[i].y), bf_hi(yfw[i].y) + bf_hi(ybw[i].y)};
            f32x4 y1 = {bf_lo(yfw[i].z) + bf_lo(ybw[i].z), bf_hi(yfw[i].z) + bf_hi(ybw[i].z), bf_lo(yfw[i].w) + bf_lo(ybw[i].w), bf_hi(yfw[i].w) + bf_hi(ybw[i].w)};
            float s = (y0[0] + y0[1]) + (y0[2] + y0[3]) + (y1[0] + y1[1]) + (y1[2] + y1[3]); s = red8(s);
            const float mu = s * (1.f / 64.f); y0 = y0 - mu; y1 = y1 - mu;
            float s2 = (y0[0] * y0[0] + y0[1] * y0[1]) + (y0[2] * y0[2] + y0[3] * y0[3]) + (y1[0] * y1[0] + y1[1] * y1[1]) + (y1[2] * y1[2] + y1[3] * y1[3]); s2 = red8(s2);
            const float rstd = __builtin_amdgcn_rsqf(s2 * (1.f / 64.f) + 64e-5f);
            const f32x4 v0 = {bf_lo(vw[i].x), bf_hi(vw[i].x), bf_lo(vw[i].y), bf_hi(vw[i].y)}, v1 = {bf_lo(vw[i].z), bf_hi(vw[i].z), bf_lo(vw[i].w), bf_hi(vw[i].w)};
            const f32x4 g0 = {bf_lo(gw4[i].x), bf_hi(gw4[i].x), bf_lo(gw4[i].y), bf_hi(gw4[i].y)}, g1 = {bf_lo(gw4[i].z), bf_hi(gw4[i].z), bf_lo(gw4[i].w), bf_hi(gw4[i].w)};
            const f32x4 o0 = (y0 * rstd * *(const f32x4*)(lng + c) + *(const f32x4*)(lnb + c) + v0 * bon[i]) * g0;
            const f32x4 o1 = (y1 * rstd * *(const f32x4*)(lng + c + 4) + *(const f32x4*)(lnb + c + 4) + v1 * bon[i]) * g1;
            v4u w; w.x = cvt_pk_bf16(o0[0], o0[1]); w.y = cvt_pk_bf16(o0[2], o0[3]); w.z = cvt_pk_bf16(o1[0], o1[1]); w.w = cvt_pk_bf16(o1[2], o1[3]);
            *(v4u*)(O3 + (size_t)row * 1536 + c) = w; } }
    }
}

__device__ __forceinline__ void scan_unit(ArgsRef a, unsigned char* ws, int l, bool lat, int b, int head, int dir, int half, LAS unsigned char* lds, int tid) {
    const int T = lat ? 1024 : 256, tokbase = lat ? NCTX + b * 1024 : b * 256, nch = T / 32;
    const bool active = !lat || tid < 256;
    const int row = (lat ? 32 * half : 0) + ((lat ? (tid & 255) : tid) >> 3), kseg = tid & 7;
    const float* si = (const float*)(ws + WS_SI) + ((size_t)(dir * 8 + head) * MT + tokbase) * 384;
    float* Yo = (float*)(ws + WS_Y) + ((size_t)dir * MT + tokbase) * 512 + head * 64;
    pg8::f32x2 S2[4];
    if (lat) { const float* sp = a.in[dir == 0 ? 6 : 7] + ((size_t)(b * 4 + l) * 8 + head) * 4096 + row * 64 + 8 * kseg;
        const f32x4 s0 = *(const f32x4*)sp, s1 = *(const f32x4*)(sp + 4); S2[0] = (pg8::f32x2){s0[0], s0[1]}; S2[1] = (pg8::f32x2){s0[2], s0[3]}; S2[2] = (pg8::f32x2){s1[0], s1[1]}; S2[3] = (pg8::f32x2){s1[2], s1[3]}; }
    else {
#pragma unroll
        for (int i = 0; i < 4; ++i) S2[i] = (pg8::f32x2){0.f, 0.f}; }
    LAS float* buf0 = (LAS float*)lds; LAS float* ybuf0 = (LAS float*)(lds + 98304);
    f32x4 pre[6];
    { const int tok0 = dir == 0 ? 0 : T - 32; const f32x4* s4 = (const f32x4*)(si + (size_t)tok0 * 384);
#pragma unroll
      for (int j = 0; j < 6; ++j) pre[j] = s4[tid + 512 * j]; }
    for (int c = 0; c < nch; ++c) {
        LAS float* buf = buf0 + (c & 1) * 12288; LAS float* yb = ybuf0 + (c & 1) * 2048;
#pragma unroll
        for (int j = 0; j < 6; ++j) *(LAS f32x4*)(buf + 4 * (tid + 512 * j)) = pre[j];
        __syncthreads();
        if (c > 0) { const int tp = dir == 0 ? 32 * (c - 1) : T - 32 * c; LAS float* ybp = ybuf0 + ((c - 1) & 1) * 2048;
            if (!lat) *(f32x4*)(Yo + (size_t)(tp + (tid >> 4)) * 512 + 4 * (tid & 15)) = *(LAS f32x4*)(ybp + 4 * tid);
            else if (tid < 256) *(f32x4*)(Yo + (size_t)(tp + (tid >> 3)) * 512 + 32 * half + 4 * (tid & 7)) = *(LAS f32x4*)(ybp + (tid >> 3) * 64 + 32 * half + 4 * (tid & 7)); }
        if (c + 1 < nch) { const int tok0 = dir == 0 ? 32 * (c + 1) : T - 32 * (c + 2); const f32x4* s4 = (const f32x4*)(si + (size_t)tok0 * 384);
#pragma unroll
            for (int j = 0; j < 6; ++j) pre[j] = s4[tid + 512 * j]; }
        if (active)
#pragma unroll 2
        for (int s = 0; s < 32; ++s) {
            const int ti = dir == 0 ? s : 31 - s; const LAS float* rec = buf + ti * 384 + 8 * kseg;
            typedef pg8::f32x2 f2;
            const f32x4 a0 = *(const LAS f32x4*)(rec + 256), a1 = *(const LAS f32x4*)(rec + 260);
            const f32x4 w0 = *(const LAS f32x4*)(rec + 64), w1 = *(const LAS f32x4*)(rec + 68), b0 = *(const LAS f32x4*)(rec + 320), b1 = *(const LAS f32x4*)(rec + 324);
            const f32x4 k0 = *(const LAS f32x4*)(rec + 128), k1 = *(const LAS f32x4*)(rec + 132), r0 = *(const LAS f32x4*)(rec), r1 = *(const LAS f32x4*)(rec + 4);
            const float vv = buf[ti * 384 + 192 + row];
            f2 t = S2[0] * (f2){a0[0], a0[1]}; t = S2[1] * (f2){a0[2], a0[3]} + t; t = S2[2] * (f2){a1[0], a1[1]} + t; t = S2[3] * (f2){a1[2], a1[3]} + t;
            const float sa = red8(t.x + t.y);
            const f2 sa2 = {sa, sa}, vv2 = {vv, vv};
            S2[0] = S2[0] * (f2){w0[0], w0[1]} + sa2 * (f2){b0[0], b0[1]} + vv2 * (f2){k0[0], k0[1]};
            S2[1] = S2[1] * (f2){w0[2], w0[3]} + sa2 * (f2){b0[2], b0[3]} + vv2 * (f2){k0[2], k0[3]};
            S2[2] = S2[2] * (f2){w1[0], w1[1]} + sa2 * (f2){b1[0], b1[1]} + vv2 * (f2){k1[0], k1[1]};
            S2[3] = S2[3] * (f2){w1[2], w1[3]} + sa2 * (f2){b1[2], b1[3]} + vv2 * (f2){k1[2], k1[3]};
            f2 u = S2[0] * (f2){r0[0], r0[1]}; u = S2[1] * (f2){r0[2], r0[3]} + u; u = S2[2] * (f2){r1[0], r1[1]} + u; u = S2[3] * (f2){r1[2], r1[3]} + u;
            const float y = red8(u.x + u.y);
            if (kseg == 0) yb[ti * 64 + row] = y;
        }
    }
    __syncthreads();
    { const int tp = dir == 0 ? 32 * (nch - 1) : 0; LAS float* ybp = ybuf0 + ((nch - 1) & 1) * 2048;
      if (!lat) *(f32x4*)(Yo + (size_t)(tp + (tid >> 4)) * 512 + 4 * (tid & 15)) = *(LAS f32x4*)(ybp + 4 * tid);
      else if (tid < 256) *(f32x4*)(Yo + (size_t)(tp + (tid >> 3)) * 512 + 32 * half + 4 * (tid & 7)) = *(LAS f32x4*)(ybp + (tid >> 3) * 64 + 32 * half + 4 * (tid & 7)); }
    if (!lat) { float* op = a.out + (dir == 0 ? OUT_RF : OUT_RB) + ((size_t)(b * 4 + l) * 8 + head) * 4096 + row * 64 + 8 * kseg;
        *(f32x4*)op = (f32x4){S2[0].x, S2[0].y, S2[1].x, S2[1].y}; *(f32x4*)(op + 4) = (f32x4){S2[2].x, S2[2].y, S2[3].x, S2[3].y}; }
    __syncthreads();
}

__device__ __forceinline__ void scan_pair_ctx(ArgsRef a, unsigned char* ws, int l, int b, int head, LAS unsigned char* lds, int tid) {
    typedef pg8::f32x2 f2;
    const int d = tid >> 8, gt = tid & 255, lr = gt >> 3, kseg = gt & 7, tokbase = b * 256;
    const float* si = (const float*)(ws + WS_SI) + ((size_t)(d * 8 + head) * MT + tokbase) * 384;
    float* Yo = (float*)(ws + WS_Y) + ((size_t)d * MT + tokbase) * 512 + head * 64;
    LAS float* buf0 = (LAS float*)(lds + d * 57344); LAS float* ybuf0 = (LAS float*)(lds + d * 57344 + 49152);
    f2 SA[4], SB[4];
#pragma unroll
    for (int i = 0; i < 4; ++i) { SA[i] = (f2){0.f, 0.f}; SB[i] = (f2){0.f, 0.f}; }
    f32x4 pre[6];
    { const int tok0 = d == 0 ? 0 : 256 - 16; const f32x4* s4 = (const f32x4*)(si + (size_t)tok0 * 384);
#pragma unroll
      for (int j = 0; j < 6; ++j) pre[j] = s4[gt + 256 * j]; }
    for (int c = 0; c < 16; ++c) {
        LAS float* buf = buf0 + (c & 1) * 6144; LAS float* yb = ybuf0 + (c & 1) * 1024;
#pragma unroll
        for (int j = 0; j < 6; ++j) *(LAS f32x4*)(buf + 4 * (gt + 256 * j)) = pre[j];
        __syncthreads();
        if (c > 0) { const int tp = d == 0 ? 16 * (c - 1) : 256 - 16 * c; LAS float* ybp = ybuf0 + ((c - 1) & 1) * 1024;
            *(f32x4*)(Yo + (size_t)(tp + (gt >> 4)) * 512 + 4 * (gt & 15)) = *(LAS f32x4*)(ybp + 4 * gt); }
        if (c + 1 < 16) { const int tok0 = d == 0 ? 16 * (c + 1) : 256 - 16 * (c + 2); const f32x4* s4 = (const f32x4*)(si + (size_t)tok0 * 384);
#pragma unroll
            for (int j = 0; j < 6; ++j) pre[j] = s4[gt + 256 * j]; }
#pragma unroll 2
        for (int s = 0; s < 16; ++s) {
            const int ti = d == 0 ? s : 15 - s; const LAS float* rec = buf + ti * 384 + 8 * kseg;
            const f32x4 a0 = *(const LAS f32x4*)(rec + 256), a1 = *(const LAS f32x4*)(rec + 260);
            const f32x4 w0 = *(const LAS f32x4*)(rec + 64), w1 = *(const LAS f32x4*)(rec + 68), b0 = *(const LAS f32x4*)(rec + 320), b1 = *(const LAS f32x4*)(rec + 324);
            const f32x4 k0 = *(const LAS f32x4*)(rec + 128), k1 = *(const LAS f32x4*)(rec + 132), r0 = *(const LAS f32x4*)(rec), r1 = *(const LAS f32x4*)(rec + 4);
            const f2 v2 = *(const LAS f2*)(buf + ti * 384 + 192 + 2 * lr);
            const f2 a01 = {a0[0], a0[1]}, a23 = {a0[2], a0[3]}, a45 = {a1[0], a1[1]}, a67 = {a1[2], a1[3]};
            f2 tA = SA[0] * a01; tA = SA[1] * a23 + tA; tA = SA[2] * a45 + tA; tA = SA[3] * a67 + tA;
            f2 tB = SB[0] * a01; tB = SB[1] * a23 + tB; tB = SB[2] * a45 + tB; tB = SB[3] * a67 + tB;
            const float saA = red8(tA.x + tA.y), saB = red8(tB.x + tB.y);
            const f2 sA2 = {saA, saA}, sB2 = {saB, saB}, vA2 = {v2.x, v2.x}, vB2 = {v2.y, v2.y};
            const f2 w01 = {w0[0], w0[1]}, w23 = {w0[2], w0[3]}, w45 = {w1[0], w1[1]}, w67 = {w1[2], w1[3]};
            const f2 b01 = {b0[0], b0[1]}, b23 = {b0[2], b0[3]}, b45 = {b1[0], b1[1]}, b67 = {b1[2], b1[3]};
            const f2 k01 = {k0[0], k0[1]}, k23 = {k0[2], k0[3]}, k45 = {k1[0], k1[1]}, k67 = {k1[2], k1[3]};
            SA[0] = SA[0] * w01 + sA2 * b01 + vA2 * k01; SA[1] = SA[1] * w23 + sA2 * b23 + vA2 * k23; SA[2] = SA[2] * w45 + sA2 * b45 + vA2 * k45; SA[3] = SA[3] * w67 + sA2 * b67 + vA2 * k67;
            SB[0] = SB[0] * w01 + sB2 * b01 + vB2 * k01; SB[1] = SB[1] * w23 + sB2 * b23 + vB2 * k23; SB[2] = SB[2] * w45 + sB2 * b45 + vB2 * k45; SB[3] = SB[3] * w67 + sB2 * b67 + vB2 * k67;
            const f2 r01 = {r0[0], r0[1]}, r23 = {r0[2], r0[3]}, r45 = {r1[0], r1[1]}, r67 = {r1[2], r1[3]};
            f2 uA = SA[0] * r01; uA = SA[1] * r23 + uA; uA = SA[2] * r45 + uA; uA = SA[3] * r67 + uA;
            f2 uB = SB[0] * r01; uB = SB[1] * r23 + uB; uB = SB[2] * r45 + uB; uB = SB[3] * r67 + uB;
            const float yA = red8(uA.x + uA.y), yB = red8(uB.x + uB.y);
            if (kseg == 0) *(LAS f2*)(yb + ti * 64 + 2 * lr) = (f2){yA, yB};
        }
    }
    __syncthreads();
    { const int tp = d == 0 ? 16 * 15 : 0; LAS float* ybp = ybuf0 + (15 & 1) * 1024;
      *(f32x4*)(Yo + (size_t)(tp + (gt >> 4)) * 512 + 4 * (gt & 15)) = *(LAS f32x4*)(ybp + 4 * gt); }
    { float* op = a.out + (d == 0 ? OUT_RF : OUT_RB) + ((size_t)(b * 4 + l) * 8 + head) * 4096 + (2 * lr) * 64 + 8 * kseg;
      *(f32x4*)op = (f32x4){SA[0].x, SA[0].y, SA[1].x, SA[1].y}; *(f32x4*)(op + 4) = (f32x4){SA[2].x, SA[2].y, SA[3].x, SA[3].y};
      *(f32x4*)(op + 64) = (f32x4){SB[0].x, SB[0].y, SB[1].x, SB[1].y}; *(f32x4*)(op + 68) = (f32x4){SB[2].x, SB[2].y, SB[3].x, SB[3].y}; }
    __syncthreads();
}

__device__ __forceinline__ void scan_wave(ArgsRef a, unsigned char* ws, int l, bool lat, int b, int head, int dir, int rg, int lane) {
    const int T = lat ? 1024 : 256, tokbase = lat ? NCTX + b * 1024 : b * 256, nch = T / 16, dh = dir * 8 + head;
    const int cu0 = dh * 512 + (lat ? 256 + b * 64 : b * 16);
    const int q = lane & 15, g4 = lane >> 4, row = 16 * rg + q;
    const float* siv = (const float*)(ws + WS_V) + head * 64 + row;
    float* Yo = (float*)(ws + WS_Y) + (size_t)dir * MT * 512 + head * 64 + row;
    f32x4 ST[4];
    if (lat) { const float* sp = a.in[dir == 0 ? 6 : 7] + ((size_t)(b * 4 + l) * 8 + head) * 4096 + row * 64 + 4 * g4;
#pragma unroll
        for (int kt = 0; kt < 4; ++kt) ST[kt] = *(const f32x4*)(sp + 16 * kt); }
    else {
#pragma unroll
        for (int kt = 0; kt < 4; ++kt) ST[kt] = (f32x4){0.f, 0.f, 0.f, 0.f}; }
    struct COps { v2u im[20]; f32x4 gC[4]; f32x4 vv; };
#define CH_LOAD(O, C) do { const unsigned char* ops_ = ws + WS_OPS + (size_t)(cu0 + (C)) * OPS_BLOCK; \
        _Pragma("unroll") for (int i = 0; i < 10; ++i) { const v4u pr_ = *(const v4u*)(ops_ + i * 1024 + lane * 16); O.im[2 * i] = (v2u){pr_.x, pr_.y}; O.im[2 * i + 1] = (v2u){pr_.z, pr_.w}; } \
        _Pragma("unroll") for (int kt = 0; kt < 4; ++kt) O.gC[kt] = *(const f32x4*)(ops_ + 20 * 512 + (16 * kt + 4 * g4) * 4); \
        _Pragma("unroll") for (int e = 0; e < 4; ++e) { O.vv[e] = siv[(size_t)(tokbase + 16 * (dir == 0 ? (C) : nch - 1 - (C)) + 4 * g4 + e) * 512]; } } while (0)
#define CH_STEP(O, C) do { const v2u vB = pk4(O.vv); v2u sB[4]; \
        _Pragma("unroll") for (int kt = 0; kt < 4; ++kt) sB[kt] = pk4(ST[kt]); \
        f32x4 X = {0.f, 0.f, 0.f, 0.f}, Yt = {0.f, 0.f, 0.f, 0.f}; \
        _Pragma("unroll") for (int kt = 0; kt < 4; ++kt) { X = mfma16k(O.im[kt], sB[kt], X); Yt = mfma16k(O.im[4 + kt], sB[kt], Yt); } \
        X = mfma16k(O.im[16], vB, X); \
        const f32x4 P = mfma16k(O.im[17], pk4(X), (f32x4){0.f, 0.f, 0.f, 0.f}); const v2u pB = pk4(P); \
        Yt = mfma16k(O.im[18], pB, Yt); Yt = mfma16k(O.im[19], vB, Yt); \
        _Pragma("unroll") for (int e = 0; e < 4; ++e) { Yo[(size_t)(tokbase + 16 * (dir == 0 ? (C) : nch - 1 - (C)) + 4 * g4 + e) * 512] = Yt[e]; } \
        _Pragma("unroll") for (int kt = 0; kt < 4; ++kt) { f32x4 n = ST[kt] * O.gC[kt]; n = mfma16k(O.im[8 + kt], pB, n); n = mfma16k(O.im[12 + kt], vB, n); ST[kt] = n; } } while (0)
    { COps A, B; CH_LOAD(A, 0);
      for (int c = 0; c < nch; c += 2) {
          CH_LOAD(B, c + 1);
          CH_STEP(A, c);
          if (c + 2 < nch) CH_LOAD(A, c + 2);
          CH_STEP(B, c + 1);
      } }
#undef CH_LOAD
#undef CH_STEP
    if (!lat) { float* op = a.out + (dir == 0 ? OUT_RF : OUT_RB) + ((size_t)(b * 4 + l) * 8 + head) * 4096 + row * 64 + 4 * g4;
#pragma unroll
        for (int kt = 0; kt < 4; ++kt) *(f32x4*)(op + 16 * kt) = ST[kt]; }
}

__device__ __forceinline__ void scan_wg(ArgsRef a, unsigned char* ws, int l, bool lat, int b, int head, LAS unsigned char* lds, int tid) {
    const int lane = tid & 63, wv = __builtin_amdgcn_readfirstlane(tid >> 6), dir = wv >> 2, rg = wv & 3, sl = tid & 255;
    const int T = lat ? 1024 : 256, tokbase = lat ? NCTX + b * 1024 : b * 256, nch = T / 16, dh = dir * 8 + head;
    const int cu0 = dh * 512 + (lat ? 256 + b * 64 : b * 16);
    const int q = lane & 15, g4 = lane >> 4, row = 16 * rg + q;
    const bf16* siv = (const bf16*)(ws + WS_V) + head * 64 + row;
    bf16* Yo = (bf16*)(ws + WS_Y) + (size_t)dir * MT * 512 + head * 64 + row;
    LAS unsigned char* slot0 = lds + dir * (2 * OPS_BLOCK);
    f32x4 ST[4];
    if (lat) { const float* sp = a.in[dir == 0 ? 6 : 7] + ((size_t)(b * 4 + l) * 8 + head) * 4096 + row * 64 + 4 * g4;
#pragma unroll
        for (int kt = 0; kt < 4; ++kt) ST[kt] = *(const f32x4*)(sp + 16 * kt); }
    else {
#pragma unroll
        for (int kt = 0; kt < 4; ++kt) ST[kt] = (f32x4){0.f, 0.f, 0.f, 0.f}; }
    struct GRegs { v4u x0, x1, x2; v2u vv; };
#define SW_GLOAD(R, C) do { const unsigned char* ob_ = ws + WS_OPS + (size_t)(cu0 + (C)) * OPS_BLOCK + sl * 16; \
        R.x0 = *(const v4u*)ob_; R.x1 = *(const v4u*)(ob_ + 4096); if (sl < 160) R.x2 = *(const v4u*)(ob_ + 8192); \
        { const bf16* vp_ = siv + (size_t)(tokbase + 16 * (dir == 0 ? (C) : nch - 1 - (C)) + 4 * g4) * 512; \
          R.vv.x = (unsigned)vp_[0] | ((unsigned)vp_[512] << 16); R.vv.y = (unsigned)vp_[1024] | ((unsigned)vp_[1536] << 16); } } while (0)
#define SW_PARK(R, C) do { LAS unsigned char* sp_ = slot0 + ((C) & 1) * OPS_BLOCK + sl * 16; \
        *(LAS v4u*)sp_ = R.x0; *(LAS v4u*)(sp_ + 4096) = R.x1; if (sl < 160) *(LAS v4u*)(sp_ + 8192) = R.x2; } while (0)
#define SW_STEP(VV, C) do { const LAS unsigned char* sb_ = slot0 + ((C) & 1) * OPS_BLOCK; v2u im[20]; \
        _Pragma("unroll") for (int i = 0; i < 10; ++i) { const v4u pr_ = *(const LAS v4u*)(sb_ + i * 1024 + lane * 16); im[2 * i] = (v2u){pr_.x, pr_.y}; im[2 * i + 1] = (v2u){pr_.z, pr_.w}; } \
        f32x4 gC_[4]; _Pragma("unroll") for (int kt = 0; kt < 4; ++kt) gC_[kt] = *(const LAS f32x4*)(sb_ + 20 * 512 + (16 * kt + 4 * g4) * 4); \
        const v2u vB = VV; v2u sB[4]; \
        _Pragma("unroll") for (int kt = 0; kt < 4; ++kt) sB[kt] = pk4(ST[kt]); \
        f32x4 X = {0.f, 0.f, 0.f, 0.f}, Yt = {0.f, 0.f, 0.f, 0.f}; \
        _Pragma("unroll") for (int kt = 0; kt < 4; ++kt) { X = mfma16k(im[2 * kt], sB[kt], X); Yt = mfma16k(im[2 * kt + 1], sB[kt], Yt); } \
        X = mfma16k(im[16], vB, X); \
        const f32x4 P = mfma16k(im[17], pk4(X), (f32x4){0.f, 0.f, 0.f, 0.f}); const v2u pB = pk4(P); \
        Yt = mfma16k(im[18], pB, Yt); Yt = mfma16k(im[19], vB, Yt); \
        _Pragma("unroll") for (int e = 0; e < 4; ++e) Yo[(size_t)(tokbase + 16 * (dir == 0 ? (C) : nch - 1 - (C)) + 4 * g4 + e) * 512] = h1(Yt[e]); \
        _Pragma("unroll") for (int kt = 0; kt < 4; ++kt) { f32x4 n = ST[kt] * gC_[kt]; n = mfma16k(im[8 + 2 * kt], pB, n); n = mfma16k(im[9 + 2 * kt], vB, n); ST[kt] = n; } } while (0)
    { GRegs R0, R1, R2; v2u vcur;
      SW_GLOAD(R0, 0); SW_GLOAD(R1, 1); SW_GLOAD(R2, 2);
      SW_PARK(R0, 0); vcur = R0.vv;
      __syncthreads();
      for (int c = 0; c < nch; c += 3) {
          { v2u vn = vcur; if (c + 1 < nch) { SW_PARK(R1, c + 1); vn = R1.vv; } if (c + 3 < nch) SW_GLOAD(R0, c + 3); SW_STEP(vcur, c); vcur = vn; __syncthreads(); }
          if (c + 1 < nch) { v2u vn = vcur; if (c + 2 < nch) { SW_PARK(R2, c + 2); vn = R2.vv; } if (c + 4 < nch) SW_GLOAD(R1, c + 4); SW_STEP(vcur, c + 1); vcur = vn; __syncthreads(); }
          if (c + 2 < nch) { v2u vn = vcur; if (c + 3 < nch) { SW_PARK(R0, c + 3); vn = R0.vv; } if (c + 5 < nch) SW_GLOAD(R2, c + 5); SW_STEP(vcur, c + 2); vcur = vn; __syncthreads(); }
      } }
#undef SW_GLOAD
#undef SW_PARK
#undef SW_STEP
    if (!lat) { float* op = a.out + (dir == 0 ? OUT_RF : OUT_RB) + ((size_t)(b * 4 + l) * 8 + head) * 4096 + row * 64 + 4 * g4;
#pragma unroll
        for (int kt = 0; kt < 4; ++kt) *(f32x4*)(op + 16 * kt) = ST[kt]; }
}

constexpr int ATT_KP = 272, ATT_VP = 288, ATT_BUF = 64 * ATT_KP + 64 * ATT_VP;
template <int MODE> __device__ __forceinline__ void att_src(ArgsRef a, unsigned char* ws, int l, int b, int h, int c, int j, int rg, int skey, int sseg, const bf16*& kp, const bf16*& vp) {
    const bf16* F = (const bf16*)(ws + WS_F);
    if (MODE == 0 || MODE == 2) { const size_t ro = (size_t)(b * 256 + 32 * c + skey) * NINP + h * 128 + sseg * 8; kp = F + ro + (MODE == 0 ? C_NAK : C_DFK); vp = F + ro + (MODE == 0 ? C_NAV : C_DFV); }
    else if (MODE == 3) {
        if (c < 32) { kp = (const bf16*)(ws + WS_KR) + (size_t)(b * 1024 + 32 * c + skey) * 512 + h * 128 + sseg * 8; vp = F + (size_t)(NCTX + b * 1024 + 32 * c + skey) * NINP + C_DFV + h * 128 + sseg * 8; }
        else { const size_t ro = ((size_t)(b * 4 + l) * 256 + 32 * (c - 32) + skey) * 512 + h * 128 + sseg * 8; kp = (const bf16*)(ws + WS_CKDF) + ro; vp = (const bf16*)(ws + WS_CVDF) + ro; }
    } else {
        const int nloc = 12;
        if (c < nloc) { const int kr = (rg ? 4 : 0) + c; int kc0 = 16 * j - 8; kc0 = kc0 < 0 ? 0 : (kc0 > 32 ? 32 : kc0);
            const size_t ro = (size_t)(NCTX + b * 1024 + kr * 64 + kc0 + skey) * NINP + h * 128 + sseg * 8; kp = F + ro + C_NAK; vp = F + ro + C_NAV; }
        else { const size_t ro = ((size_t)(b * 4 + l) * 256 + 32 * (c - nloc) + skey) * 512 + h * 128 + sseg * 8; kp = (const bf16*)(ws + WS_CKNA) + ro; vp = (const bf16*)(ws + WS_CVNA) + ro; }
    }
}
template <int MODE> __device__ __forceinline__ void attn_unit(ArgsRef a, unsigned char* ws, int l, int uidx, LAS unsigned char* lds, int tid) {
    constexpr bool DIFF = (MODE == 2 || MODE == 3); constexpr int NS = DIFF ? 2 : 1;
    const int wave = __builtin_amdgcn_readfirstlane(tid >> 6), lane = tid & 63, q = lane & 15, g = lane >> 4, skey = tid >> 4, sseg = tid & 15;
    const bf16* F = (const bf16*)(ws + WS_F);
    int b, h, j = 0, rg = 0, nchunks, orow; const bf16* Qp;
    if (MODE == 0 || MODE == 2) { b = uidx >> 3; h = (uidx >> 1) & 3; const int half = uidx & 1; orow = b * 256 + half * 128 + wave * 16 + q; Qp = F + (size_t)orow * NINP + (MODE == 0 ? C_NAQ : C_DFQ) + h * 128; nchunks = 8; }
    else if (MODE == 3) { b = uidx >> 5; h = (uidx >> 3) & 3; const int qb = uidx & 7; const int lr = b * 1024 + qb * 128 + wave * 16 + q; orow = NCTX + lr; Qp = (const bf16*)(ws + WS_QR) + (size_t)lr * 512 + h * 128; nchunks = 40; }
    else { b = uidx >> 5; h = (uidx >> 3) & 3; j = (uidx >> 1) & 3; rg = uidx & 1; const int r = rg * 8 + wave; orow = NCTX + b * 1024 + r * 64 + 16 * j + q; Qp = F + (size_t)orow * NINP + C_NAQ + h * 128; nchunks = 12 + 8; }
    bf16x8 qf[4];
#pragma unroll
    for (int ks = 0; ks < 4; ++ks) qf[ks] = *(const bf16x8*)(Qp + 32 * ks + 8 * g);
    const float csc = (DIFF ? 0.125f : 0.08838834764831845f) * 1.4426950408889634f;
    float m[NS], ls[NS]; f32x4 o[NS][8];
#pragma unroll
    for (int n = 0; n < NS; ++n) { m[n] = -__builtin_inff(); ls[n] = 0.f;
#pragma unroll
        for (int d = 0; d < 8; ++d) o[n][d] = (f32x4){0.f, 0.f, 0.f, 0.f}; }
    const int nloc = 12, r = rg * 8 + wave, qc = 16 * j + q;
    int rs = r - 4; rs = rs < 0 ? 0 : (rs > 8 ? 8 : rs);
    int kc0 = 16 * j - 8; kc0 = kc0 < 0 ? 0 : (kc0 > 32 ? 32 : kc0);
    int wc0 = qc - 8; wc0 = wc0 < 0 ? 0 : (wc0 > 48 ? 48 : wc0);
    const float* rpb = a.in[13] + (size_t)(l * 4 + h) * 15 * 31;
    if (MODE == 1) { for (int i = tid; i < 15 * 31; i += 512) ((LAS float*)(lds + 2 * ATT_BUF))[i] = rpb[i] * 1.4426950408889634f; }
    v4u kreg, vreg, kreg1, vreg1;
    { const bf16 *kp, *vp; att_src<MODE>(a, ws, l, b, h, 0, j, rg, skey, sseg, kp, vp); kreg = *(const v4u*)kp; vreg = *(const v4u*)vp;
      att_src<MODE>(a, ws, l, b, h, 1, j, rg, skey, sseg, kp, vp); kreg1 = *(const v4u*)kp; vreg1 = *(const v4u*)vp; }
    for (int c2 = 0; c2 < nchunks / 2; ++c2) {
        LAS unsigned char* Kl0 = lds + (c2 & 1) * ATT_BUF; LAS unsigned char* Vl0 = Kl0 + 64 * ATT_KP;
        *(LAS v4u*)(Kl0 + skey * ATT_KP + sseg * 16) = kreg; *(LAS v4u*)(Vl0 + skey * ATT_VP + sseg * 16) = vreg;
        *(LAS v4u*)(Kl0 + (32 + skey) * ATT_KP + sseg * 16) = kreg1; *(LAS v4u*)(Vl0 + (32 + skey) * ATT_VP + sseg * 16) = vreg1;
        __syncthreads();
        if (2 * c2 + 2 < nchunks) { const bf16 *kp, *vp; att_src<MODE>(a, ws, l, b, h, 2 * c2 + 2, j, rg, skey, sseg, kp, vp); kreg = *(const v4u*)kp; vreg = *(const v4u*)vp;
            att_src<MODE>(a, ws, l, b, h, 2 * c2 + 3, j, rg, skey, sseg, kp, vp); kreg1 = *(const v4u*)kp; vreg1 = *(const v4u*)vp; }
#pragma unroll 1
      for (int sub = 0; sub < 2; ++sub) { const int c = 2 * c2 + sub;
        const LAS unsigned char* Kl = Kl0 + sub * 32 * ATT_KP; const LAS unsigned char* Vl = Vl0 + sub * 32 * ATT_VP;
        bool active = true; int kr = 0;
        if (MODE == 1 && c < nloc) { kr = (rg ? 4 : 0) + c; active = (kr >= rs) && (kr < rs + 8); }
        if (active) {
            f32x4 s[NS][2];
#pragma unroll
            for (int n = 0; n < NS; ++n) { s[n][0] = (f32x4){0.f, 0.f, 0.f, 0.f}; s[n][1] = s[n][0]; }
            { bf16x8 ka[2][4];
#pragma unroll
              for (int t = 0; t < 2; ++t)
#pragma unroll
                  for (int ks = 0; ks < 4; ++ks) ka[t][ks] = *(const LAS bf16x8*)(Kl + (16 * t + q) * ATT_KP + (32 * ks + 8 * g) * 2);
#pragma unroll
              for (int t = 0; t < 2; ++t)
#pragma unroll
                  for (int ks = 0; ks < 4; ++ks) { const int n = DIFF ? (ks >> 1) : 0; s[n][t] = mfma16(ka[t][ks], qf[ks], s[n][t]); }
              __builtin_amdgcn_sched_group_barrier(0x100, 4, 1);
#pragma unroll
              for (int k = 0; k < 4; ++k) { __builtin_amdgcn_sched_group_barrier(0x8, 1, 1); __builtin_amdgcn_sched_group_barrier(0x100, 1, 1); }
              __builtin_amdgcn_sched_group_barrier(0x8, 4, 1); }
            const bool biased = (MODE == 1 && c < nloc);
            if (biased) { const LAS float* rrow = (const LAS float*)(lds + 2 * ATT_BUF) + (kr - r + 7) * 31 + 15;
#pragma unroll
                for (int t = 0; t < 2; ++t)
#pragma unroll
                    for (int e = 0; e < 4; ++e) { const int kc = kc0 + 16 * t + 4 * g + e; int rel = kc - qc; rel = rel < -15 ? -15 : (rel > 15 ? 15 : rel);
                        const bool inw = (kc >= wc0) && (kc < wc0 + 16); s[0][t][e] = inw ? __builtin_fmaf(s[0][t][e], csc, rrow[rel]) : -__builtin_inff(); } }
            bf16x8 pb[NS];
#pragma unroll
            for (int n = 0; n < NS; ++n) {
                const float PINF = __builtin_inff();
                const float mx = __builtin_amdgcn_fmed3f(__builtin_amdgcn_fmed3f(__builtin_amdgcn_fmed3f(s[n][0][0], s[n][0][1], PINF), __builtin_amdgcn_fmed3f(s[n][0][2], s[n][0][3], PINF), PINF),
                                                         __builtin_amdgcn_fmed3f(__builtin_amdgcn_fmed3f(s[n][1][0], s[n][1][1], PINF), __builtin_amdgcn_fmed3f(s[n][1][2], s[n][1][3], PINF), PINF), PINF);
                const float mu = biased ? mx : mx * csc;
                if (__any(mu > m[n] + 8.0f)) {
                    const float mnew = fmaxf(m[n], xrow16_max(mu));
                    const float alpha = __builtin_amdgcn_exp2f(m[n] - ((mnew == -__builtin_inff()) ? 0.f : mnew)); m[n] = mnew;
                    ls[n] = ls[n] * alpha;
#pragma unroll
                    for (int d = 0; d < 8; ++d) o[n][d] = o[n][d] * alpha;
                }
                const float muse = (m[n] == -__builtin_inff()) ? 0.f : m[n];
                float p[8]; float psum = 0.f;
                if (biased) {
#pragma unroll
                    for (int e = 0; e < 4; ++e) { p[e] = __builtin_amdgcn_exp2f(s[n][0][e] - muse); p[4 + e] = __builtin_amdgcn_exp2f(s[n][1][e] - muse); psum += p[e] + p[4 + e]; } }
                else {
#pragma unroll
                    for (int e = 0; e < 4; ++e) { p[e] = __builtin_amdgcn_exp2f(__builtin_fmaf(s[n][0][e], csc, -muse)); p[4 + e] = __builtin_amdgcn_exp2f(__builtin_fmaf(s[n][1][e], csc, -muse)); psum += p[e] + p[4 + e]; } }
                ls[n] += psum;
                pb[n] = pack8(p);
            }
            __builtin_amdgcn_s_setprio(1);
            bf16x8 vt[8];
#pragma unroll
            for (int d = 0; d < 8; ++d) {
                const LAS unsigned char* va = Vl + (4 * g + (q >> 2)) * ATT_VP + (16 * d + 4 * (q & 3)) * 2;
                const s16x4 lo = vtr(va), hi = vtr(va + 16 * ATT_VP);
                vt[d] = (bf16x8){lo[0], lo[1], lo[2], lo[3], hi[0], hi[1], hi[2], hi[3]}; }
#pragma unroll
            for (int d = 0; d < 8; ++d)
#pragma unroll
                for (int n = 0; n < NS; ++n) o[n][d] = mfma16(vt[d], pb[n], o[n][d]);
            __builtin_amdgcn_sched_group_barrier(0x100, 8, 0);
#pragma unroll
            for (int k = 0; k < 4; ++k) { __builtin_amdgcn_sched_group_barrier(0x8, NS, 0); __builtin_amdgcn_sched_group_barrier(0x100, 2, 0); }
            __builtin_amdgcn_sched_group_barrier(0x8, 4 * NS, 0);
            __builtin_amdgcn_s_setprio(0);
        }
      }
    }
    bf16* O3 = (bf16*)(ws + WS_O3) + (size_t)orow * 1536 + (DIFF ? 512 : 0) + h * 128 + 4 * g;
    if constexpr (!DIFF) { const float inv = __builtin_amdgcn_rcpf(xrow16_sum(ls[0]));
#pragma unroll
        for (int d = 0; d < 8; ++d) { const f32x4 v = o[0][d] * inv; v2u w; w.x = cvt_pk_bf16(v[0], v[1]); w.y = cvt_pk_bf16(v[2], v[3]); *(v2u*)(O3 + 16 * d) = w; } }
    else { const float lam = ((const float*)(ws + WS_LAM))[l], li = lam_init_of(l);
        const float i0 = __builtin_amdgcn_rcpf(xrow16_sum(ls[0])), i1 = lam * __builtin_amdgcn_rcpf(xrow16_sum(ls[1])); float ss = 0.f;
#pragma unroll
        for (int d = 0; d < 8; ++d) { o[0][d] = o[0][d] * i0 - o[1][d] * i1; ss += (o[0][d][0] * o[0][d][0] + o[0][d][1] * o[0][d][1]) + (o[0][d][2] * o[0][d][2] + o[0][d][3] * o[0][d][3]); }
        ss = xrow16_sum(ss);
        const float rsn = __builtin_amdgcn_rsqf(ss * (1.f / 128.f) + LN_EPS) * (1.0f - li);
        const float* sub = a.in[15] + l * 512 + h * 128 + 4 * g;
#pragma unroll
        for (int d = 0; d < 8; ++d) { const f32x4 v = o[0][d] * rsn * *(const f32x4*)(sub + 16 * d); v2u w; w.x = cvt_pk_bf16(v[0], v[1]); w.y = cvt_pk_bf16(v[2], v[3]); *(v2u*)(O3 + 16 * d) = w; } }
    __syncthreads();
}

__device__ __forceinline__ void rb_wait(gu32* cnt, int ra, int rb, int tid) {
    if (tid == 0) {
        unsigned sp = 0u;
        if (rb > ra + 1) { for (int r = ra; r < rb; ++r) while (__hip_atomic_load(cnt + 64 * r, RLX_AGENT) < pg8::RB_NEED) { __builtin_amdgcn_s_sleep(1); if (++sp > (1u << 22)) break; } }
        else while (__hip_atomic_load(cnt + 64 * ra, RLX_AGENT) < pg8::RB_NEED || __hip_atomic_load(cnt + 64 * rb, RLX_AGENT) < pg8::RB_NEED) { __builtin_amdgcn_s_sleep(1); if (++sp > (1u << 22)) break; }
        __builtin_amdgcn_fence(__ATOMIC_ACQUIRE, "agent");
    }
    __syncthreads();
}

constexpr int MIX_SCL = 32, MIX_A3 = MIX_SCL + 128, MIX_A0 = MIX_A3 + 128, MIX_A1 = MIX_A0 + 128, MIX_A2 = MIX_A1 + 128, MIX_SCC = MIX_A2 + 128, MIX_END = MIX_SCC;
__device__ __forceinline__ void phase_mix(ArgsRef a, unsigned char* ws, int l, LAS unsigned char* lds, int tid, int rep) {
    gu32* head = (gu32*)(ws + WS_CTL) + CW_MIXQ + 64 * (l + 4 * rep);
    volatile LAS int* slot = (volatile LAS int*)(lds + MISC_OFF + 64);
    for (;;) {
        if (tid == 0) slot[0] = (int)__hip_atomic_fetch_add(head, 1u, __ATOMIC_RELAXED, __HIP_MEMORY_SCOPE_AGENT);
        __syncthreads();
        const int u = __builtin_amdgcn_readfirstlane(slot[0]);
        __syncthreads();
        if (u >= MIX_END) break;
        if (u < MIX_SCL) scan_wg(a, ws, l, true, u >> 3, u & 7, lds, tid);
        else if (u < MIX_A3) attn_unit<3>(a, ws, l, u - MIX_SCL, lds, tid);
        else if (u < MIX_A0) attn_unit<0>(a, ws, l, u - MIX_A3, lds, tid);
        else if (u < MIX_A1) attn_unit<1>(a, ws, l, u - MIX_A0, lds, tid);
        else if (u < MIX_A2) attn_unit<2>(a, ws, l, u - MIX_A1, lds, tid);
        else { const int v = u - MIX_A2; scan_wg(a, ws, l, false, v >> 3, v & 7, lds, tid); }
    }
}

__global__ void __launch_bounds__(NWAVES * 64, 2) fwd_kernel(Args args) {
    extern __shared__ __attribute__((aligned(16))) unsigned char lds_raw[];
    LAS unsigned char* lds = (LAS unsigned char*)lds_raw;
    const int tid = threadIdx.x; const int wave_s = __builtin_amdgcn_readfirstlane(tid >> 6);
    const int G = gridDim.x, bid = blockIdx.x, NGW = G * NWAVES;
    for (int u = tid; u < (LDS_BYTES - RING_BYTES) / 4; u += NWAVES * 64) ((LAS unsigned*)(lds + RING_BYTES))[u] = 0u;
    __syncthreads();
    unsigned* barw = (unsigned*)(args.ws + WS_CTL) + CW_BAR;
    XcdBarrier bar; bar.bar = barw; bar.x = 0; bar.st = nullptr;
    if (MK_SINGLE) bar = xcd_barrier_post(barw, (volatile LAS unsigned*)(lds + MISC_OFF) + 8);
    const int lo = args.ph_lo, hi = args.ph_hi;
#ifndef PH_MASK
#define PH_MASK 0xFFFFu
#endif
#define PM(i) (((PH_MASK) >> (i)) & 1u)
#ifndef DUP_MASK
#define DUP_MASK 0u
#endif
#define DUPN(i) ((((DUP_MASK) >> (i)) & 1u) ? 2 : 1)
#define IN(k) (lo <= (k) && (k) < hi)
#define SEAM(k) do { if (MK_SINGLE && IN(k) && IN((k) + 1)) xcd_barrier(bar); } while (0)
#define FRESH() int tid_, bid_ = bid, G_ = G; asm volatile("v_mbcnt_lo_u32_b32 %0, -1, 0\n\tv_mbcnt_hi_u32_b32 %0, -1, %0" : "=v"(tid_)); tid_ += wave_s * 64; const CAS Args* ap_ = (const CAS Args*)__builtin_amdgcn_kernarg_segment_ptr(); asm volatile("" : "+v"(tid_), "+s"(ap_), "+s"(bid_), "+s"(G_)); ArgsRef A_ = *ap_; unsigned char* ws = A_.ws; const int lane_ = tid_ & 63, wave_ = __builtin_amdgcn_readfirstlane(tid_ >> 6), gw_ = bid_ * NWAVES + wave_, NGW_ = G_ * NWAVES; (void)lane_; (void)gw_; (void)NGW_
    if (PM(0) && IN(0)) for (int rep = 0; rep < DUPN(0); ++rep) { FRESH(); phase_ada(A_, ws, lds, tid_, bid_, G_); __syncthreads(); phase_cvt(A_, ws, lds, tid_, bid_, G_); __syncthreads(); }
    SEAM(0);
    if (PM(1) && IN(1)) { FRESH(); phase_ln<0>(A_, ws, 0, gw_, NGW_, lane_); }
    SEAM(1);
    for (int l = 0; l < NL; ++l) {
        const int pb = 2 + 10 * l;
        if (PM(2) && IN(pb + 0)) { FRESH(); pg8::Gemm g{(const pg8::bf16_t*)(ws + WS_H), (const pg8::bf16_t*)(ws + WS_WIN) + (size_t)l * NINP * D, MT, NINP, D}; pg8::DepOrder S; S.init(MT, NINP, G_, bid_);
            S.cnt = (gu32*)(ws + WS_CTL) + CW_RB + 2048 * l; S.lead = (tid_ == 0); S.pend = -1;
            pg8::EpiF E{(pg8::bf16_t*)(ws + WS_F), A_.out, l, ws + WS_GF};
            pg8::gemm_phase<pg8::EpiF, pg8::DepOrder, true, true>(lds, g, S, E, tid_); S.flush(); }
        if (PM(3) && IN(pb + 1)) { FRESH(); gu32* cnt = (gu32*)(ws + WS_CTL) + CW_RB + 2048 * l; gu32* head = (gu32*)(ws + WS_CTL) + CW_PREQ + 64 * l; volatile LAS int* slot = (volatile LAS int*)(lds + MISC_OFF + 64);
            for (;;) {
                if (tid_ == 0) slot[0] = (int)__hip_atomic_fetch_add(head, 1u, __ATOMIC_RELAXED, __HIP_MEMORY_SCOPE_AGENT);
                __syncthreads();
                const int t = __builtin_amdgcn_readfirstlane(slot[0]);
                __syncthreads();
                if (t >= 512) break;
                const int tok0 = t * 16; rb_wait(cnt, (tok0 > 0 ? tok0 - 1 : 0) >> 8, (tok0 + 16 < MT ? tok0 + 16 : MT - 1) >> 8, tid_);
                pre_tile(A_, ws, l, t, lds, tid_); }
            rb_wait(cnt, 16, 32, tid_);
            phase_rope(ws, gw_, NGW_, lane_); }
        SEAM(pb + 1);
        if (PM(4) && IN(pb + 2)) for (int rep = 0; rep < DUPN(4); ++rep) { FRESH(); phase_mix(A_, ws, l, lds, tid_, rep); if (rep + 1 < DUPN(4)) xcd_barrier(bar); }
        SEAM(pb + 2);
        if (PM(5) && IN(pb + 3)) for (int rep = 0; rep < DUPN(5); ++rep) { FRESH(); phase_post(A_, ws, l, gw_, NGW_, lane_); }
        SEAM(pb + 3);
        if (PM(6) && IN(pb + 4)) for (int rep = 0; rep < DUPN(6); ++rep) { FRESH(); pg8::Gemm g{(const pg8::bf16_t*)(ws + WS_O3), (const pg8::bf16_t*)(ws + WS_WBR) + (size_t)l * D * 1536, MT, D, 1536}; pg8::StaticOrder S; S.init(MT, D, G_, bid_);
            pg8::EpiMerge E{ws + WS_GF, (pg8::bf16_t*)(ws + WS_MERGED)};
            pg8::gemm_phase<pg8::EpiMerge, pg8::StaticOrder, true, true, true>(lds, g, S, E, tid_); }
        SEAM(pb + 4);
        if (PM(7) && IN(pb + 5)) for (int rep = 0; rep < DUPN(7); ++rep) { FRESH(); pg8::Gemm g{(const pg8::bf16_t*)(ws + WS_MERGED), (const pg8::bf16_t*)(ws + WS_WO) + (size_t)l * D * D, MT, D, D}; pg8::StaticOrder S; S.init(MT, D, G_, bid_);
            const int gk = l == 0 ? 0 : 2 * l; pg8::EpiRes E{(const pg8::bf16_t*)(ws + (l == 0 ? WS_X : WS_MBUF)), l == 0 ? (const float*)nullptr : (const float*)(ws + WS_ST2), (const float*)(ws + WS_GB) + (size_t)gk * 2 * D, (const float*)(ws + WS_GB) + (size_t)gk * 2 * D + D,
                (const float*)(ws + WS_MOD) + (size_t)l * 5 * 12288 + 2 * D, (pg8::bf16_t*)(ws + WS_MBUF)};
            pg8::gemm_phase<pg8::EpiRes, pg8::StaticOrder, true, true>(lds, g, S, E, tid_); }
        SEAM(pb + 5);
        if (PM(8) && IN(pb + 6)) for (int rep = 0; rep < DUPN(8); ++rep) { FRESH(); phase_ln<1>(A_, ws, l, gw_, NGW_, lane_); }
        SEAM(pb + 6);
        if (PM(9) && IN(pb + 7)) for (int rep = 0; rep < DUPN(9); ++rep) { FRESH(); pg8::Gemm g{(const pg8::bf16_t*)(ws + WS_H), (const pg8::bf16_t*)(ws + WS_WFI) + (size_t)l * NFI * D, MT, NFI, D}; pg8::StaticOrder S; S.init(MT, NFI, G_, bid_);
            pg8::EpiSwiglu E{(pg8::bf16_t*)(ws + WS_F)};
            pg8::gemm_phase<pg8::EpiSwiglu, pg8::StaticOrder, true, true>(lds, g, S, E, tid_); }
        SEAM(pb + 7);
        if (PM(10) && IN(pb + 8)) for (int rep = 0; rep < DUPN(10); ++rep) { FRESH(); pg8::Gemm g{(const pg8::bf16_t*)(ws + WS_F), (const pg8::bf16_t*)(ws + WS_WFO) + (size_t)l * D * FF, MT, D, FF}; pg8::StaticOrder S; S.init(MT, D, G_, bid_);
            const int gk = 1 + 2 * l; pg8::EpiRes E{(const pg8::bf16_t*)(ws + WS_MBUF), (const float*)(ws + WS_ST1), (const float*)(ws + WS_GB) + (size_t)gk * 2 * D, (const float*)(ws + WS_GB) + (size_t)gk * 2 * D + D,
                (const float*)(ws + WS_MOD) + (size_t)l * 5 * 12288 + 5 * D, (pg8::bf16_t*)(ws + WS_MBUF)};
            pg8::gemm_phase<pg8::EpiRes, pg8::StaticOrder, true, true>(lds, g, S, E, tid_); }
        SEAM(pb + 8);
        if (PM(11) && IN(pb + 9)) for (int rep = 0; rep < DUPN(11); ++rep) { FRESH(); if (l < NL - 1) phase_ln<2>(A_, ws, l, gw_, NGW_, lane_); else phase_ln<3>(A_, ws, l, gw_, NGW_, lane_); }
        SEAM(pb + 9);
    }
#undef FRESH
#undef IN
#undef SEAM
}
constexpr int N_PHASES = 2 + 10 * NL;

extern "C" void kernel_launch(void* const* d_in, const int* in_sizes, int n_in, void* d_out, int out_size, void* d_ws, size_t ws_size, hipStream_t stream) {
    static int grid = 0;
    if (grid == 0) {
        if (n_in != 35 || out_size != (int)OUT_TOTAL || ws_size < WS_END) { fprintf(stderr, "kernel_launch: unexpected problem: n_in %d out %d ws %zu (need %zu)\n", n_in, out_size, ws_size, (size_t)WS_END); grid = -1; return; }
        int dev = 0, cus = 0, per_cu = 0;
        if (hipGetDevice(&dev) != hipSuccess || hipDeviceGetAttribute(&cus, hipDeviceAttributeMultiprocessorCount, dev) != hipSuccess) { grid = -1; return; }
        if (hipFuncSetAttribute((const void*)fwd_kernel, hipFuncAttributeMaxDynamicSharedMemorySize, LDS_BYTES) != hipSuccess) { fprintf(stderr, "kernel_launch: hipFuncSetAttribute failed\n"); grid = -1; return; }
        if (hipOccupancyMaxActiveBlocksPerMultiprocessor(&per_cu, (const void*)fwd_kernel, NWAVES * 64, LDS_BYTES) != hipSuccess || per_cu < 1) fprintf(stderr, "kernel_launch: occupancy query says %d\n", per_cu);
        (void)hipGetLastError();
        grid = cus;
    }
    if (grid < 0) return;
    (void)hipMemsetAsync((char*)d_ws + WS_CTL, 0, CTL_ZERO_BYTES, stream);
    Args a{};
    for (int i = 0; i < 35; ++i) a.in[i] = (const float*)d_in[i];
    a.out = (float*)d_out; a.ws = (unsigned char*)d_ws; a.l_lo = 0; a.l_hi = NL;
    if (MK_SINGLE) { a.ph_lo = 0; a.ph_hi = N_PHASES; hipLaunchKernelGGL(fwd_kernel, dim3(grid), dim3(NWAVES * 64), LDS_BYTES, stream, a); }
    else for (int p = 0; p < N_PHASES; ++p) { a.ph_lo = p; a.ph_hi = p + 1; hipLaunchKernelGGL(fwd_kernel, dim3(grid), dim3(NWAVES * 64), LDS_BYTES, stream, a); }
}
```
